# Optimizing an MI355X kernel written in HIP

```python
import math
import jax, jax.numpy as jnp
from jax import lax
import numpy as np


D_MODEL = 1024
BATCH = 8
SEQ = 2048
DEPTH = 1
DEC_BATCH = 128
DEC_SEQ = 1
PAST_LEN = 2048
PAGE_SIZE = 128

NSA_HEADS = 8
NSA_KV_HEADS = 2
NSA_GROUP = NSA_HEADS // NSA_KV_HEADS
HEAD_DIM = 64
CMP_BLOCK = 32
SEL_BLOCK = 64
TOP_N = 16
WINDOW = 512
N_KV_SLOTS = 4
QBLK = 64
SCALE = HEAD_DIM ** -0.5
NSA_WIDTH = NSA_HEADS * HEAD_DIM
KV_WIDTH = NSA_KV_HEADS * HEAD_DIM
HG_HEADS = 4
HG_DIM = 128
HG_WIDTH = HG_HEADS * HG_DIM
HG_CHUNK = 64
HG_SCALE = HG_DIM ** -0.5
REL_BUCKETS = 32
REL_MAX_DIST = 128
D_FF = 2816
CONV_W = 3
EPS = 1e-6
SPLITS = (NSA_WIDTH, 6 * KV_WIDTH, 3 * NSA_HEADS, HG_WIDTH, HG_WIDTH, HG_WIDTH, HG_WIDTH, 2 * D_MODEL)
SPLIT_IDX = tuple(int(v) for v in np.cumsum(SPLITS)[:-1])
C_IN = sum(SPLITS)

kernel_name = 'nsa_hgrn2_convffn_hybrid_step'


def rms_norm(x, g):
    xf = x.astype(jnp.float32)
    y = xf * lax.rsqrt(jnp.mean(xf * xf, axis=-1, keepdims=True) + EPS)
    return (y * g.astype(jnp.float32)).astype(x.dtype)


def rel_bucket(dist):
    n = jnp.maximum(dist, 0)
    exact = REL_BUCKETS // 2
    big = exact + (jnp.log(jnp.maximum(n, 1).astype(jnp.float32) / exact)
                   / math.log(REL_MAX_DIST / exact) * (REL_BUCKETS - exact)).astype(jnp.int32)
    return jnp.where(n < exact, n, jnp.minimum(big, REL_BUCKETS - 1))


def masked_softmax(s, mask):
    s = jnp.where(mask, s.astype(jnp.float32), -jnp.inf)
    m = jnp.max(s, axis=-1, keepdims=True)
    m = jnp.where(jnp.isfinite(m), m, 0.0)
    e = jnp.where(mask, jnp.exp(s - m), 0.0)
    den = jnp.sum(e, axis=-1, keepdims=True)
    return e / jnp.where(den > 0, den, 1.0)


def compress_block(rows, w1, w2):
    h = jax.nn.gelu(jnp.einsum('bnjgd,jde->bnge', rows.astype(jnp.float32), w1.astype(jnp.float32)))
    return jnp.einsum('bnge,ef->bngf', h, w2.astype(jnp.float32))


def nsa_attention(q, gates, kv_all, win_all, pos0, rel_table, k_cmp_g,
                  phi_k_w1, phi_k_w2, phi_v_w1, phi_v_w2):
    B, L = q.shape[0], q.shape[1]
    G, R, HD = NSA_KV_HEADS, NSA_GROUP, HEAD_DIM
    T = kv_all.shape[1]
    Tp = -(-T // SEL_BLOCK) * SEL_BLOCK
    kv_all = jnp.pad(kv_all, ((0, 0), (0, Tp - T), (0, 0), (0, 0), (0, 0)))
    n_cmp, n_sel = Tp // CMP_BLOCK, Tp // SEL_BLOCK
    n_top = min(TOP_N, n_sel)
    cmp_rows = kv_all[:, :, :2].reshape(B, n_cmp, CMP_BLOCK, 2, G, HD)
    ck = rms_norm(compress_block(cmp_rows[:, :, :, 0], phi_k_w1, phi_k_w2), k_cmp_g)
    cv = compress_block(cmp_rows[:, :, :, 1], phi_v_w1, phi_v_w2)
    c_end = (jnp.arange(n_cmp) + 1) * CMP_BLOCK - 1
    sel_k = kv_all[:, :, 2].reshape(B, n_sel, SEL_BLOCK, G, HD).transpose(0, 3, 1, 2, 4)
    sel_v = kv_all[:, :, 3].reshape(B, n_sel, SEL_BLOCK, G, HD).transpose(0, 3, 1, 2, 4)
    n_past_win = win_all.shape[1] - L
    win = jnp.pad(win_all, ((0, 0), (WINDOW - n_past_win, 0), (0, 0), (0, 0), (0, 0)))
    tab = rel_table.astype(jnp.float32).reshape(REL_BUCKETS, G, R)
    bi = jnp.arange(B)[:, None, None, None]
    gi = jnp.arange(G)[None, :, None, None]
    js = jnp.arange(n_sel)
    qb = QBLK if L % QBLK == 0 else L
    nqb = L // qb
    q_blocks = q.reshape(B, nqb, qb, G, R, HD).swapaxes(0, 1)
    g_blocks = gates.reshape(B, nqb, qb, G, R, 3).swapaxes(0, 1)

    def one_block(args):
        qc, gc, s0 = args
        qc = qc.astype(jnp.float32)
        qpos = pos0 + s0 + jnp.arange(qb)
        s_c = jnp.einsum('bqgrd,bngd->bgrqn', qc, ck) * SCALE
        s_c = s_c + tab[rel_bucket(qpos[:, None] - c_end[None])].transpose(2, 3, 0, 1)
        p_c = masked_softmax(s_c, c_end[None] <= qpos[:, None])
        o_c = jnp.einsum('bgrqn,bngd->bqgrd', p_c, cv)
        imp = p_c.sum(axis=2).reshape(B, G, qb, n_sel, SEL_BLOCK // CMP_BLOCK).sum(-1)
        cur = (qpos // SEL_BLOCK)[:, None]
        valid = js[None] <= cur
        forced = valid & ((js[None] == 0) | (js[None] >= cur - 1))
        score = jnp.where(forced, jnp.inf, jnp.where(valid, imp, -jnp.inf))
        top_v, top_i = lax.top_k(score, n_top)
        k_g = sel_k[bi, gi, top_i]
        v_g = sel_v[bi, gi, top_i].reshape(B, G, qb, n_top * SEL_BLOCK, HD)
        kpos = top_i[..., None] * SEL_BLOCK + jnp.arange(SEL_BLOCK)
        dist_s = qpos[:, None, None] - kpos
        m_s = (top_v > -jnp.inf)[..., None] & (dist_s >= 0)
        b_s = jnp.moveaxis(tab[rel_bucket(dist_s), gi[..., None]], -1, 2)
        s_s = jnp.einsum('bqgrd,bgqnjd->bgrqnj', qc, k_g) * SCALE + b_s
        n_keys = n_top * SEL_BLOCK
        p_s = masked_softmax(s_s.reshape(B, G, R, qb, n_keys), m_s.reshape(B, G, 1, qb, n_keys))
        o_s = jnp.einsum('bgrql,bgqld->bqgrd', p_s, v_g)
        w_rows = lax.dynamic_slice_in_dim(win, s0, qb + WINDOW, axis=1)
        kpos_w = pos0 + s0 - WINDOW + jnp.arange(qb + WINDOW)
        dist_w = qpos[:, None] - kpos_w[None]
        m_w = (dist_w >= 0) & (dist_w <= WINDOW) & (kpos_w[None] >= 0)
        s_w = jnp.einsum('bqgrd,bkgd->bgrqk', qc, w_rows[:, :, 0]) * SCALE
        s_w = s_w + tab[rel_bucket(dist_w)].transpose(2, 3, 0, 1)
        p_w = masked_softmax(s_w, m_w)
        o_w = jnp.einsum('bgrqk,bkgd->bqgrd', p_w, w_rows[:, :, 1])
        return gc[..., 0:1] * o_c + gc[..., 1:2] * o_s + gc[..., 2:3] * o_w

    o = lax.map(one_block, (q_blocks, g_blocks, jnp.arange(nqb) * qb))
    return o.swapaxes(0, 1).reshape(B, L, NSA_WIDTH)


def hgrn2_chunked(q, k, v, g_log, S0):
    B, L, H, _ = q.shape
    C = min(HG_CHUNK, L)
    Lp = -(-L // C) * C
    pw = ((0, 0), (0, Lp - L), (0, 0), (0, 0))
    q, k, v, g_log = (jnp.pad(a.astype(jnp.float32), pw) for a in (q, k, v, g_log))
    nc = Lp // C
    to_chunks = lambda a: a.reshape(B, nc, C, H, a.shape[-1]).swapaxes(0, 1)
    tri = jnp.tril(jnp.ones((C, C), dtype=bool))[None, :, :, None, None]

    def step(S, inp):
        qc, kc, vc, gc = inp
        b = jnp.cumsum(gc, axis=1)
        diff = b[:, :, None] - b[:, None, :]
        decay = jnp.where(tri, jnp.exp(jnp.where(tri, diff, 0.0)), 0.0)
        A = jnp.einsum('bthk,bshk,btshk->bhts', qc, kc, decay)
        o = jnp.einsum('bhts,bshv->bthv', A, vc) + jnp.einsum('bthk,bhkv->bthv', qc * jnp.exp(b), S)
        b_last = b[:, -1]
        S = jnp.exp(b_last)[..., None] * S + jnp.einsum('bshk,bshv->bhkv', kc * jnp.exp(b_last[:, None] - b), vc)
        return S, o

    S, o = lax.scan(step, S0.astype(jnp.float32), (to_chunks(q), to_chunks(k), to_chunks(v), to_chunks(g_log)))
    return o.swapaxes(0, 1).reshape(B, Lp, H, -1)[:, :L], S


def trunk_layer(x, past_kv, past_win, hg_state, conv_state, lb, rel_table,
                norm1_g, w_in, q_norm_g, k_norm_g, phi_k_w1, phi_k_w2, phi_v_w1, phi_v_w2,
                hg_norm_g, w_nsa_out, w_hg_out, w_o, norm2_g, w_gate, w_up, conv_w, conv_b, w_down):
    B, L, _ = x.shape
    pos0 = past_kv.shape[1]
    xn = rms_norm(x, norm1_g)
    z = xn @ w_in
    q, kv, nsa_gl, hq, hf, hi, hg, mg = jnp.split(z, SPLIT_IDX, axis=-1)
    q = rms_norm(q.reshape(B, L, NSA_HEADS, HEAD_DIM), q_norm_g)
    kv = kv.reshape(B, L, 6, NSA_KV_HEADS, HEAD_DIM)
    new_kv = jnp.stack([kv[:, :, 0], kv[:, :, 1], rms_norm(kv[:, :, 2], k_norm_g[1]), kv[:, :, 3]], axis=2)
    new_win = jnp.stack([rms_norm(kv[:, :, 4], k_norm_g[2]), kv[:, :, 5]], axis=2)
    win_all = jnp.concatenate([past_win, new_win], axis=1)
    gates = jax.nn.sigmoid(nsa_gl.astype(jnp.float32)).reshape(B, L, NSA_HEADS, 3)
    o_nsa = nsa_attention(q, gates, jnp.concatenate([past_kv, new_kv], axis=1), win_all, pos0, rel_table,
                          k_norm_g[0], phi_k_w1, phi_k_w2, phi_v_w1, phi_v_w2)
    f = lb + (1.0 - lb) * jax.nn.sigmoid(hf.astype(jnp.float32))
    hs = (B, L, HG_HEADS, HG_DIM)
    o_hg, S_new = hgrn2_chunked((hq.astype(jnp.float32) * HG_SCALE).reshape(hs), (1.0 - f).reshape(hs),
                                hi.reshape(hs), jnp.log(f).reshape(hs), hg_state)
    o_hg = rms_norm(o_hg, hg_norm_g) * jax.nn.silu(hg.astype(jnp.float32)).reshape(hs)
    ga, gb = jnp.split(mg, 2, axis=-1)
    y_a = o_nsa.astype(x.dtype) @ w_nsa_out
    y_b = o_hg.reshape(B, L, HG_WIDTH).astype(x.dtype) @ w_hg_out
    x = x + (jax.nn.sigmoid(ga) * y_a + jax.nn.sigmoid(gb) * y_b) @ w_o
    xn2 = rms_norm(x, norm2_g)
    ext = jnp.concatenate([conv_state.astype(xn2.dtype), xn2 @ w_gate], axis=1)
    c = conv_b + sum(conv_w[j] * ext[:, j:j + L] for j in range(CONV_W))
    x = x + (jax.nn.silu(c) * (xn2 @ w_up)) @ w_down
    new_win_state = win_all[:, -min(WINDOW, win_all.shape[1]):]
    return x, new_kv, new_win_state, S_new, ext[:, -(CONV_W - 1):]


def setup_inputs(seed: int = 0) -> dict:
    key = jax.random.key(seed)
    ks = iter(jax.random.split(key, 40))
    nrm = lambda shape, scale: jax.random.normal(next(ks), shape, jnp.float32) * scale
    gain = lambda shape: 1.0 + nrm(shape, 0.02)
    n_pages = PAST_LEN // PAGE_SIZE
    n_used = DEC_BATCH * n_pages
    n_phys = (n_used * 5 + 3) // 4
    kvh = (NSA_KV_HEADS, HEAD_DIM)
    x_prompt = nrm((BATCH, SEQ, D_MODEL), 1.0)
    x_sample = nrm((DEC_BATCH, DEC_SEQ, D_MODEL), 1.0)
    cache_kv = nrm((DEPTH, n_phys, PAGE_SIZE, N_KV_SLOTS) + kvh, 1.0)
    page_table = jax.random.permutation(next(ks), n_phys)[:n_used].reshape(DEC_BATCH, n_pages).astype(jnp.int32)
    state_kv_win = nrm((DEPTH, DEC_BATCH, min(WINDOW, PAST_LEN), 2) + kvh, 1.0)
    state_hgrn = nrm((DEPTH, DEC_BATCH, HG_HEADS, HG_DIM, HG_DIM), 0.5)
    state_conv = nrm((DEPTH, DEC_BATCH, CONV_W - 1, D_FF), 1.0)
    return {
        'x_prompt': x_prompt, 'x_sample': x_sample, 'cache_kv': cache_kv, 'page_table': page_table,
        'state_kv_win': state_kv_win, 'state_hgrn': state_hgrn, 'state_conv': state_conv,
        'rel_table': nrm((REL_BUCKETS, NSA_HEADS), 0.5),
        'hg_lb_logits': nrm((DEPTH + 1, HG_WIDTH), 0.5),
        'norm1_g': gain((DEPTH, D_MODEL)),
        'w_in': nrm((DEPTH, D_MODEL, C_IN), D_MODEL ** -0.5),
        'q_norm_g': gain((DEPTH, HEAD_DIM)),
        'k_norm_g': gain((DEPTH, 3, HEAD_DIM)),
        'phi_k_w1': nrm((DEPTH, CMP_BLOCK, HEAD_DIM, HEAD_DIM), (CMP_BLOCK * HEAD_DIM) ** -0.5),
        'phi_k_w2': nrm((DEPTH, HEAD_DIM, HEAD_DIM), HEAD_DIM ** -0.5),
        'phi_v_w1': nrm((DEPTH, CMP_BLOCK, HEAD_DIM, HEAD_DIM), (CMP_BLOCK * HEAD_DIM) ** -0.5),
        'phi_v_w2': nrm((DEPTH, HEAD_DIM, HEAD_DIM), HEAD_DIM ** -0.5),
        'hg_norm_g': gain((DEPTH, HG_DIM)),
        'w_nsa_out': nrm((DEPTH, NSA_WIDTH, D_MODEL), NSA_WIDTH ** -0.5),
        'w_hg_out': nrm((DEPTH, HG_WIDTH, D_MODEL), HG_WIDTH ** -0.5),
        'w_o': nrm((DEPTH, D_MODEL, D_MODEL), D_MODEL ** -0.5),
        'norm2_g': gain((DEPTH, D_MODEL)),
        'w_gate': nrm((DEPTH, D_MODEL, D_FF), D_MODEL ** -0.5),
        'w_up': nrm((DEPTH, D_MODEL, D_FF), D_MODEL ** -0.5),
        'conv_w': nrm((DEPTH, CONV_W, D_FF), CONV_W ** -0.5),
        'conv_b': nrm((DEPTH, D_FF), 0.02),
        'w_down': nrm((DEPTH, D_FF, D_MODEL), D_FF ** -0.5),
    }


def reference(x_prompt, x_sample, cache_kv, page_table, state_kv_win, state_hgrn, state_conv,
              rel_table, hg_lb_logits, norm1_g, w_in, q_norm_g, k_norm_g, phi_k_w1, phi_k_w2,
              phi_v_w1, phi_v_w2, hg_norm_g, w_nsa_out, w_hg_out, w_o, norm2_g, w_gate, w_up,
              conv_w, conv_b, w_down):
    lbs = jnp.cumsum(jax.nn.softmax(hg_lb_logits.astype(jnp.float32), axis=0), axis=0)
    Bp, Bs = x_prompt.shape[0], x_sample.shape[0]
    n_pages = page_table.shape[1]
    slot_shape = (N_KV_SLOTS, NSA_KV_HEADS, HEAD_DIM)
    yp, ys = x_prompt, x_sample
    kvp, kvs, wnp, wns, hgp, hgs, cvp, cvs = [], [], [], [], [], [], [], []
    for l in range(DEPTH):
        lw = (norm1_g[l], w_in[l], q_norm_g[l], k_norm_g[l], phi_k_w1[l], phi_k_w2[l], phi_v_w1[l],
              phi_v_w2[l], hg_norm_g[l], w_nsa_out[l], w_hg_out[l], w_o[l], norm2_g[l], w_gate[l],
              w_up[l], conv_w[l], conv_b[l], w_down[l])
        yp, a, b, c, d = trunk_layer(
            yp, jnp.zeros((Bp, 0) + slot_shape, yp.dtype),
            jnp.zeros((Bp, 0, 2, NSA_KV_HEADS, HEAD_DIM), yp.dtype),
            jnp.zeros((Bp, HG_HEADS, HG_DIM, HG_DIM), jnp.float32),
            jnp.zeros((Bp, CONV_W - 1, D_FF), yp.dtype), lbs[l], rel_table, *lw)
        kvp.append(a); wnp.append(b); hgp.append(c); cvp.append(d)
        past = cache_kv[l][page_table].reshape((Bs, n_pages * cache_kv.shape[2]) + slot_shape)
        ys, a, b, c, d = trunk_layer(ys, past, state_kv_win[l], state_hgrn[l], state_conv[l],
                                     lbs[l], rel_table, *lw)
        kvs.append(a); wns.append(b); hgs.append(c); cvs.append(d)
    return (yp, ys, jnp.stack(kvp), jnp.stack(kvs), jnp.stack(wnp), jnp.stack(wns),
            jnp.stack(hgp), jnp.stack(hgs), jnp.stack(cvp), jnp.stack(cvs))
```

```cpp
#include <hip/hip_runtime.h>
#include <cstdio>
#include <cstdint>
#include <cmath>
namespace pg8 {
#define PG8_LAS __attribute__((address_space(3)))
typedef unsigned short bf16_t;
typedef short bf16x8 __attribute__((ext_vector_type(8)));
typedef float f32x4 __attribute__((ext_vector_type(4)));
typedef unsigned u32x4 __attribute__((ext_vector_type(4)));
constexpr int BM = 256, BK = 64, HALF = 128, HTB = HALF * BK * 2  , STAGE_BYTES = 8 * HTB, NXCD = 8, WGM = 8;

__host__ __device__ __forceinline__ int lds_byte(int r, int c) { const int st = (r >> 4) * 2 + (c >> 5), rr = r & 15, cc = c & 31, ob = rr * 64 + cc * 2; return st * 1024 + (ob ^ (((ob >> 9) & 1) << 5)); }
__host__ __device__ __forceinline__ void stage_rc(int b, int& R, int& C) { const int st = b / 1024, sb = b % 1024, swz = sb ^ (((sb >> 9) & 1) << 5); R = (st >> 1) * 16 + swz / 64; C = (st & 1) * 32 + (swz % 64) / 2; }
__host__ __device__ __forceinline__ int perm32(int rho) { const int n = rho >> 4, i = rho & 15; return 8 * (i >> 2) + 4 * n + (i & 3); }

struct Unit { int pm, pn; };
struct Gemm { const bf16_t* A; const bf16_t* Bt; int M, N, K; };

struct StaticOrder {
    int nM, nN, nwg, G, c;
    __host__ __device__ void init(int M, int N, int G_, int c_) { nM = M / BM; nN = N / BM; nwg = nM * nN; G = G_; c = c_; }
    __host__ __device__ bool next(int i, Unit& u) const {
        const long L = (long)i * G + c; if (L >= nwg) return false;
        int wgid = (int)L; { const int q = nwg / NXCD, r = nwg % NXCD, xcd = wgid % NXCD, off = wgid / NXCD; wgid = (xcd < r ? xcd * (q + 1) : r * (q + 1) + (xcd - r) * q) + off; }
        const int nig = WGM * nN, gid = wgid / nig, fm = gid * WGM, gsz = (nM - fm) < WGM ? (nM - fm) : WGM;
        u.pm = fm + ((wgid % nig) % gsz); u.pn = (wgid % nig) / gsz; return true;
    }
    __device__ __forceinline__ void a_ready(const Unit&) const {}
    __device__ __forceinline__ void done(const Unit&) const {}
};

template <class Epi, class Sched, bool ALIGN_EPI = false, bool SP2 = false>
__device__ __forceinline__ void gemm_phase(PG8_LAS unsigned char* lds, const Gemm g, const Sched& S, const Epi& E) {
    const int tid = threadIdx.x, wid = __builtin_amdgcn_readfirstlane(tid >> 6), lane = tid & 63, wr = wid >> 2, wc = wid & 3, fr = lane & 15, fq = lane >> 4;
    const int K = g.K, nt = K / BK;
    unsigned voffA[2], voffB[2];
#pragma unroll
    for (int i = 0; i < 2; ++i) { int R, C; stage_rc(tid * 16 + i * 8192, R, C); const int Rb = Epi::PERM ? ((R & ~31) + perm32(R & 31)) : R;
        voffA[i] = (unsigned)(R * K + C) * 2u; voffB[i] = (unsigned)(Rb * K + C) * 2u; }
    const size_t kstep = (size_t)(BK * 2);
    const size_t hstep = (size_t)HALF * K * 2;
    const size_t tstep = 2 * hstep;
    const unsigned ldsw = (unsigned)wid * 1024u;
    const int aoff = lds_byte(wr * 64 + fr, fq * 8), boff = lds_byte(wc * 32 + fr, fq * 8);
#define PG8_SA(b, h) (((b) * 2 + (h)) * HTB)
#define PG8_SB(b, h) ((4 + (b) * 2 + (h)) * HTB)
#define PG8_STAGE(bufoff, gbase, voff) do { _Pragma("unroll") for (int _i = 0; _i < 2; ++_i) \
        __builtin_amdgcn_global_load_lds((const unsigned*)((const char*)(gbase) + (voff)[_i]), (PG8_LAS unsigned*)(lds + (bufoff) + ldsw + _i * 8192), 16, 0, 0); } while (0)
#define PG8_LDA(dst, b, h) do { _Pragma("unroll") for (int m = 0; m < 4; ++m) _Pragma("unroll") for (int k = 0; k < 2; ++k) dst[m][k] = *(const PG8_LAS bf16x8*)(lds + PG8_SA(b, h) + aoff + m * 2048 + k * 1024); } while (0)
#define PG8_LDB(dst, b, h) do { _Pragma("unroll") for (int n = 0; n < 2; ++n) _Pragma("unroll") for (int k = 0; k < 2; ++k) dst[n][k] = *(const PG8_LAS bf16x8*)(lds + PG8_SB(b, h) + boff + n * 2048 + k * 1024); } while (0)
#define PG8_MMA(ai, bj, At, Bt) do { __builtin_amdgcn_s_setprio(1); _Pragma("unroll") for (int m = 0; m < 4; ++m) _Pragma("unroll") for (int n = 0; n < 2; ++n) _Pragma("unroll") for (int k = 0; k < 2; ++k) \
        acc[ai][bj][m][n] = __builtin_amdgcn_mfma_f32_16x16x32_bf16(Bt[n][k], At[m][k], acc[ai][bj][m][n], 0, 0, 0); __builtin_amdgcn_s_setprio(0); } while (0)
#define PG8_WAIT_V(n) asm volatile("s_waitcnt vmcnt(" #n ")" ::: "memory")
#define PG8_WAIT_L(n) asm volatile("s_waitcnt lgkmcnt(" #n ")" ::: "memory")
#define PG8_BAR __builtin_amdgcn_s_barrier()
#define PG8_SCHED __builtin_amdgcn_sched_barrier(0)
    Unit cur, nxt; int ui = 0;
    if (!S.next(0, cur)) return;
    f32x4 acc[2][2][4][2];
#pragma unroll
    for (int a = 0; a < 2; ++a)
#pragma unroll
        for (int b = 0; b < 2; ++b)
#pragma unroll
            for (int m = 0; m < 4; ++m)
#pragma unroll
                for (int n = 0; n < 2; ++n) acc[a][b][m][n] = (f32x4){0.f, 0.f, 0.f, 0.f};
    bf16x8 At[4][2], B0[2][2], B1[2][2];
    const char* cA = (const char*)g.A + (size_t)cur.pm * tstep; const char* cB = (const char*)g.Bt + (size_t)cur.pn * tstep;
    S.a_ready(cur);
    if constexpr (SP2) {
        PG8_STAGE(PG8_SB(0, 0), cB, voffB); PG8_STAGE(PG8_SB(0, 1), cB + hstep, voffB); PG8_STAGE(PG8_SA(0, 0), cA, voffA); PG8_STAGE(PG8_SA(0, 1), cA + hstep, voffA);
        if (wr == 1) PG8_BAR;
        PG8_WAIT_V(2); PG8_BAR;
        PG8_STAGE(PG8_SB(1, 0), cB + kstep, voffB); PG8_STAGE(PG8_SA(1, 0), cA + kstep, voffA); PG8_STAGE(PG8_SB(1, 1), cB + hstep + kstep, voffB);
        PG8_WAIT_V(6); PG8_BAR;
    } else {
        PG8_STAGE(PG8_SB(0, 0), cB, voffB); PG8_STAGE(PG8_SA(0, 0), cA, voffA); PG8_STAGE(PG8_SB(0, 1), cB + hstep, voffB); PG8_STAGE(PG8_SA(0, 1), cA + hstep, voffA);
        if (wr == 1) PG8_BAR;
        PG8_WAIT_V(4); PG8_BAR;
        PG8_STAGE(PG8_SB(1, 0), cB + kstep, voffB); PG8_STAGE(PG8_SA(1, 0), cA + kstep, voffA); PG8_STAGE(PG8_SB(1, 1), cB + hstep + kstep, voffB);
        PG8_WAIT_V(6); PG8_BAR;
    }
    for (;;) {
        const bool has_next = S.next(ui + 1, nxt);
        const char* nA = has_next ? (const char*)g.A + (size_t)nxt.pm * tstep : cA; const char* nB = has_next ? (const char*)g.Bt + (size_t)nxt.pn * tstep : cB;
        for (int t = 0; t < nt; t += 2) {
            const bool last = (t == nt - 2);
            const char* a1 = cA + (size_t)(t + 1) * kstep;
            const char* a2 = last ? nA : cA + (size_t)(t + 2) * kstep; const char* b2 = last ? nB : cB + (size_t)(t + 2) * kstep;
            const char* a3 = a2 + kstep; const char* b3 = b2 + kstep;
            if (last && has_next) S.a_ready(nxt);
            if constexpr (SP2) {
            PG8_LDB(B0, 0, 0); PG8_LDB(B1, 0, 1); PG8_SCHED; PG8_LDA(At, 0, 0); PG8_STAGE(PG8_SA(1, 1), a1 + hstep, voffA);
            PG8_WAIT_V(8); PG8_WAIT_L(0); PG8_BAR; PG8_MMA(0, 0, At, B0); PG8_MMA(0, 1, At, B1); PG8_BAR; PG8_SCHED;
            PG8_LDA(At, 0, 1); PG8_STAGE(PG8_SB(0, 0), b2, voffB); PG8_STAGE(PG8_SB(0, 1), b2 + hstep, voffB); PG8_STAGE(PG8_SA(0, 0), a2, voffA);
            PG8_WAIT_V(8); PG8_WAIT_L(0); PG8_BAR; PG8_MMA(1, 0, At, B0); PG8_MMA(1, 1, At, B1); PG8_BAR; PG8_SCHED;
            PG8_LDB(B0, 1, 0); PG8_LDB(B1, 1, 1); PG8_SCHED; PG8_LDA(At, 1, 0); PG8_STAGE(PG8_SA(0, 1), a2 + hstep, voffA);
            PG8_WAIT_V(8); PG8_WAIT_L(0); PG8_BAR; PG8_MMA(0, 0, At, B0); PG8_MMA(0, 1, At, B1); PG8_BAR; PG8_SCHED;
            PG8_LDA(At, 1, 1); PG8_STAGE(PG8_SB(1, 0), b3, voffB); PG8_STAGE(PG8_SB(1, 1), b3 + hstep, voffB); PG8_STAGE(PG8_SA(1, 0), a3, voffA);
            PG8_WAIT_V(8); PG8_WAIT_L(0); PG8_BAR; PG8_MMA(1, 0, At, B0); PG8_MMA(1, 1, At, B1); PG8_BAR; PG8_SCHED;
            } else {
            PG8_LDB(B0, 0, 0); PG8_SCHED; PG8_LDA(At, 0, 0); PG8_STAGE(PG8_SA(1, 1), a1 + hstep, voffA);
            PG8_WAIT_L(8); PG8_BAR; PG8_WAIT_L(0); PG8_MMA(0, 0, At, B0); PG8_BAR; PG8_SCHED;
            PG8_LDB(B1, 0, 1); PG8_STAGE(PG8_SB(0, 0), b2, voffB);
            PG8_BAR; PG8_WAIT_L(0); PG8_MMA(0, 1, At, B1); PG8_BAR;
            PG8_LDA(At, 0, 1); PG8_STAGE(PG8_SA(0, 0), a2, voffA);
            PG8_BAR; PG8_WAIT_L(0); PG8_MMA(1, 0, At, B0); PG8_BAR; PG8_SCHED;
            PG8_STAGE(PG8_SB(0, 1), b2 + hstep, voffB);
            PG8_WAIT_V(6); PG8_BAR; PG8_MMA(1, 1, At, B1); PG8_BAR;
            PG8_LDB(B0, 1, 0); PG8_SCHED; PG8_LDA(At, 1, 0); PG8_STAGE(PG8_SA(0, 1), a2 + hstep, voffA);
            PG8_WAIT_L(8); PG8_BAR; PG8_WAIT_L(0); PG8_MMA(0, 0, At, B0); PG8_BAR; PG8_SCHED;
            PG8_LDB(B1, 1, 1); PG8_STAGE(PG8_SB(1, 0), b3, voffB);
            PG8_BAR; PG8_WAIT_L(0); PG8_MMA(0, 1, At, B1); PG8_BAR;
            PG8_LDA(At, 1, 1); PG8_STAGE(PG8_SA(1, 0), a3, voffA);
            PG8_BAR; PG8_WAIT_L(0); PG8_MMA(1, 0, At, B0); PG8_BAR; PG8_SCHED;
            PG8_STAGE(PG8_SB(1, 1), b3 + hstep, voffB);
            PG8_WAIT_V(6); PG8_BAR; PG8_MMA(1, 1, At, B1); PG8_BAR;
            }
        }
        if constexpr (ALIGN_EPI) { if (wr == 0) PG8_BAR; }
        if constexpr (!Epi::AFTER_DRAIN) { E(acc, cur, wr, wc, fr, fq); S.done(cur); }
        if (!has_next) break;
#pragma unroll
        for (int a = 0; a < 2; ++a)
#pragma unroll
            for (int b = 0; b < 2; ++b)
#pragma unroll
                for (int m = 0; m < 4; ++m)
#pragma unroll
                    for (int n = 0; n < 2; ++n) acc[a][b][m][n] = (f32x4){0.f, 0.f, 0.f, 0.f};
        cur = nxt; cA = nA; cB = nB; ++ui;
        if constexpr (ALIGN_EPI) { if (wr == 1) PG8_BAR; }
    }
    PG8_WAIT_V(0);
    if constexpr (!ALIGN_EPI) { if (wr == 0) PG8_BAR; }
    PG8_BAR;
    if constexpr (Epi::AFTER_DRAIN) { E.fused(acc, cur, wr, wc, fr, fq, lds, wid, lane); S.done(cur); }
#undef PG8_SA
#undef PG8_SB
#undef PG8_STAGE
#undef PG8_LDA
#undef PG8_LDB
#undef PG8_MMA
#undef PG8_WAIT_V
#undef PG8_WAIT_L
#undef PG8_BAR
#undef PG8_SCHED
}
}
#define GAS __attribute__((address_space(1)))
#define LAS __attribute__((address_space(3)))
typedef unsigned short bf16;
typedef unsigned v4u __attribute__((ext_vector_type(4)));
typedef float f32x4 __attribute__((ext_vector_type(4)));
typedef short bf16x8 __attribute__((ext_vector_type(8)));
typedef GAS unsigned gu32;
typedef GAS unsigned long long gu64;
#define RLX_AGENT __ATOMIC_RELAXED, __HIP_MEMORY_SCOPE_AGENT
#define LDS_WAIT() asm volatile("s_waitcnt lgkmcnt(0)" ::: "memory")
#define VM_WAIT() asm volatile("s_waitcnt vmcnt(0)" ::: "memory")
__device__ __forceinline__ unsigned long long rt() { return __builtin_amdgcn_s_memrealtime(); }
__device__ __forceinline__ unsigned f2bf(float f) { unsigned u = __builtin_bit_cast(unsigned, f); return (u + 0x7fffu + ((u >> 16) & 1u)) >> 16; }
__device__ __forceinline__ unsigned pk2(float lo, float hi) { return f2bf(lo) | (f2bf(hi) << 16); }

#define XB_TMO      128
#define XB_XCNT(j)  (256  + 64 * (j))
#define XB_XSUB(j)  (1280 + 64 * (j))
#define XB_XGEN(j)  (2304 + 64 * (j))
#define XB_TOP      3328
#define XB_TOPGEN   3392
#define XCD_BAR_WORDS 3456
#define XB_SPIN_CAP (1u << 18)

__device__ __forceinline__ unsigned xb_ld(unsigned* p)              { return __hip_atomic_load(p, __ATOMIC_RELAXED, __HIP_MEMORY_SCOPE_AGENT); }
__device__ __forceinline__ unsigned xb_add(unsigned* p, unsigned v) { return __hip_atomic_fetch_add(p, v, __ATOMIC_RELAXED, __HIP_MEMORY_SCOPE_AGENT); }
__device__ __forceinline__ unsigned xb_xcc_id() { return (unsigned)__builtin_amdgcn_s_getreg((3 << 11) | 20) & 0xFu; }
#define XB_SPIN(cond, bar) do { unsigned _sp = 0; while (cond) { __builtin_amdgcn_s_sleep(1); \
    if ((++_sp & 255u) == 0u) { if (xb_ld(&(bar)[XB_TMO])) break; if (_sp > XB_SPIN_CAP) { atomicAdd(&(bar)[XB_TMO], 1u); break; } } } } while (0)

struct XcdBarrier {
    unsigned* bar; unsigned x;
    volatile LAS unsigned* st;
};

__device__ __forceinline__ XcdBarrier xcd_barrier_post(unsigned* bar, volatile LAS unsigned* st) {
    XcdBarrier b; b.bar = bar; b.x = xb_xcc_id(); b.st = st;
    if (threadIdx.x == 0) (void)xb_add(&bar[XB_XCNT(b.x)], 1u);
    return b;
}
__device__ __forceinline__ void xcd_barrier_complete(unsigned* bar, unsigned x, unsigned& nloc, unsigned& nx) {
    const unsigned G = gridDim.x * gridDim.y * gridDim.z;
    unsigned sum, cnt, mine, sp = 0u;
    for (;;) {
        sum = 0u; cnt = 0u; mine = 0u;
#pragma unroll
        for (unsigned j = 0; j < 16; ++j) { const unsigned c = xb_ld(&bar[XB_XCNT(j)]); sum += c; cnt += (c > 0u) ? 1u : 0u; mine = (j == x) ? c : mine; }
        if (sum == G) break;
        __builtin_amdgcn_s_sleep(1);
        if ((++sp & 255u) == 0u) { if (xb_ld(&bar[XB_TMO])) break; if (sp > XB_SPIN_CAP) { atomicAdd(&bar[XB_TMO], 1u); break; } }
    }
    nloc = mine > 0u ? mine : 1u; nx = cnt > 0u ? cnt : 1u;
}

__device__ __forceinline__ void xcd_barrier(const XcdBarrier& b) {
    asm volatile("s_waitcnt vmcnt(0)" ::: "memory");
    __syncthreads();
    if (threadIdx.x == 0) {
        unsigned* bar = b.bar;
        __builtin_amdgcn_s_waitcnt(0);
        unsigned nloc = b.st[0], nx = b.st[1];
        if (nloc == 0u) { xcd_barrier_complete(bar, b.x, nloc, nx); b.st[0] = nloc; b.st[1] = nx; }
        const unsigned old = xb_add(&bar[XB_XSUB(b.x)], 1u);
        const unsigned gen = old / nloc;
        if (old + 1u == (gen + 1u) * nloc) {
            __builtin_amdgcn_fence(__ATOMIC_RELEASE, "agent");
            asm volatile("s_waitcnt vmcnt(0)" ::: "memory");
            const unsigned og = xb_add(&bar[XB_TOP], 1u);
            const unsigned tg = og / nx;
            if (og + 1u == (tg + 1u) * nx) xb_add(&bar[XB_TOPGEN], 1u);
            else XB_SPIN(xb_ld(&bar[XB_TOPGEN]) == tg, bar);
            __builtin_amdgcn_fence(__ATOMIC_ACQUIRE, "agent");
            xb_add(&bar[XB_XGEN(b.x)], 1u);
            asm volatile("s_waitcnt vmcnt(0)" ::: "memory");
        } else {
            XB_SPIN(xb_ld(&bar[XB_XGEN(b.x)]) == gen, bar);
            __builtin_amdgcn_fence(__ATOMIC_ACQUIRE, "agent");
            asm volatile("s_waitcnt vmcnt(0)" ::: "memory");
        }
    }
    __syncthreads();
}

constexpr int NWAVES = 8, NTHREADS = 512;
constexpr int DM = 1024, BATCH_P = 8, SEQ = 2048, MP = BATCH_P * SEQ  , BS = 128  ;
constexpr int MROWS = MP + BS  , MPAD = 16640  ;
constexpr int NH = 8, NG = 2, NR = 4, HD = 64, NSAW = 512, KVW = 128;
constexpr int HGH = 4, HGD = 128, HGW = 512;
constexpr int DFF = 2816, CIN = 5400, NIN = 5632  ;
constexpr int PAST = 2048, PAGE = 128, NPAGES = 16, WIN = 512;
constexpr float EPS = 1e-6f, LOG2E = 1.4426950408889634f;
constexpr float QSCALE = 0.125f * LOG2E;
constexpr float HG_SCALE = 0.08838834764831845f;

constexpr size_t OFF_Y = 0, OFF_KV = 16908288, OFF_WINP = 25362432, OFF_WINS = 26411008, OFF_HGP = 43188224, OFF_HGS = 43712512,
                 OFF_CVP = 52101120, OFF_CVS = 52146176, OUT_TOTAL = 52867072;

typedef unsigned short bf16_t;
typedef short bf16x8 __attribute__((ext_vector_type(8)));
typedef short s16x4 __attribute__((ext_vector_type(4)));
typedef float f32x4 __attribute__((ext_vector_type(4)));
typedef float f32x2 __attribute__((ext_vector_type(2)));
typedef float f32x16 __attribute__((ext_vector_type(16)));
typedef unsigned u32x4 __attribute__((ext_vector_type(4)));
typedef unsigned u32x2 __attribute__((ext_vector_type(2)));
#define DI __device__ __forceinline__

DI float bf2f(unsigned short b) { return __builtin_bit_cast(float, (unsigned)b << 16); }
DI float bflo(unsigned w) { return __builtin_bit_cast(float, w << 16); }
DI float bfhi(unsigned w) { return __builtin_bit_cast(float, w & 0xffff0000u); }
DI float sigmoidf_(float x) { return 1.f / (1.f + __expf(-x)); }
DI float siluf_(float x) { return x / (1.f + __expf(-x)); }
DI float wave_sum(float v) {
#pragma unroll
    for (int o = 1; o < 64; o <<= 1) v += __shfl_xor(v, o);
    return v;
}
DI bf16x8 pack8(const float* v) { u32x4 p; p.x = pk2(v[0], v[1]); p.y = pk2(v[2], v[3]); p.z = pk2(v[4], v[5]); p.w = pk2(v[6], v[7]); return __builtin_bit_cast(bf16x8, p); }
DI bf16x8 pack8v(f32x4 a, f32x4 b) { u32x4 p; p.x = pk2(a[0], a[1]); p.y = pk2(a[2], a[3]); p.z = pk2(b[0], b[1]); p.w = pk2(b[2], b[3]); return __builtin_bit_cast(bf16x8, p); }
#define MFMA16(a, b, c) __builtin_amdgcn_mfma_f32_16x16x32_bf16((a), (b), (c), 0, 0, 0)
#define MFMA32(a, b, c) __builtin_amdgcn_mfma_f32_32x32x16_bf16((a), (b), (c), 0, 0, 0)
#define LAS __attribute__((address_space(3)))
typedef short v4i16_t __attribute__((ext_vector_type(4)));
DI s16x4 tr_read(const LAS void* p) { return __builtin_bit_cast(s16x4, __builtin_amdgcn_ds_read_tr16_b64_v4i16((LAS v4i16_t*)p)); }
DI bf16x8 cat44(s16x4 lo, s16x4 hi) { return __builtin_shufflevector(lo, hi, 0, 1, 2, 3, 4, 5, 6, 7); }

constexpr size_t MiB = 1u << 20;
constexpr size_t WS_CTL = 0, CTL_ZERO_BYTES = 1 * MiB;
constexpr size_t WS_WIN = 2 * MiB;
constexpr size_t WS_WA = 14 * MiB, WS_WB = 15 * MiB;
constexpr size_t WS_WO = 16 * MiB;
constexpr size_t WS_WG = 18 * MiB, WS_WU = 24 * MiB, WS_WD = 30 * MiB;
constexpr size_t WS_W1K = 36 * MiB, WS_W1V = 37 * MiB;
constexpr size_t WS_XN = 40 * MiB;
constexpr size_t WS_Q = 76 * MiB;
constexpr size_t WS_KVB = 94 * MiB;
constexpr size_t WS_HQ = 112 * MiB, WS_HI = 130 * MiB, WS_HGT = 148 * MiB;
constexpr size_t WS_GL = 166 * MiB;
constexpr size_t WS_MG = 200 * MiB;
constexpr size_t WS_GATES = 266 * MiB;
constexpr size_t WS_CKP = 268 * MiB, WS_CVP = 269 * MiB;
constexpr size_t WS_CKS = 270 * MiB, WS_CVS = 275 * MiB;
constexpr size_t WS_SLOC = 280 * MiB;
constexpr size_t WS_GD = 297 * MiB;
constexpr size_t WS_ONSA = 298 * MiB, WS_OHG = 316 * MiB;
constexpr size_t WS_T = 334 * MiB;
constexpr size_t WS_MB = 400 * MiB;
constexpr size_t WS_SSQ = 434 * MiB;
constexpr size_t WS_G = 436 * MiB;
constexpr size_t WS_H = 527 * MiB;
constexpr size_t WS_END = 618 * MiB;
constexpr int CW_BAR = 4096;

constexpr int RING_BYTES = 131072;
constexpr int MISC_OFF = RING_BYTES;
constexpr int XTRA_OFF = RING_BYTES + 256;
constexpr int LDS_BYTES = 147456;

struct KParams {
    const float* in[27];
    const int* page_table;
    float* out;
    unsigned char* ws;
    int ph_lo, ph_hi;
};

DI void p0_transpose_item(const float* W, int K, int N, bf16_t* WT, int prow0, int src_col0, int nvalid, int k0, LAS float* scr, int lane) {
#pragma unroll 8
    for (int i = 0; i < 32; ++i) { const int kk = 2 * i + (lane >> 5), c = lane & 31;
        scr[kk * 33 + c] = (c < nvalid) ? W[(size_t)(k0 + kk) * N + src_col0 + c] : 0.f; }
    asm volatile("s_waitcnt lgkmcnt(0)" ::: "memory");
    const int c = lane & 7;
#pragma unroll
    for (int j = 0; j < 4; ++j) { const int n = (lane >> 3) + 8 * j; const LAS float* s = scr + (8 * c) * 33 + n;
        u32x4 o; o.x = pk2(s[0 * 33], s[1 * 33]); o.y = pk2(s[2 * 33], s[3 * 33]); o.z = pk2(s[4 * 33], s[5 * 33]); o.w = pk2(s[6 * 33], s[7 * 33]);
        *(u32x4*)(WT + (size_t)(prow0 + n) * K + k0 + 8 * c) = o; }
    asm volatile("s_waitcnt lgkmcnt(0)" ::: "memory");
}
DI void inproj_src(int p0, int& src, int& nvalid) {
    const int pn = p0 >> 8, within = p0 & 255, bj = within >> 7, wc = (within >> 5) & 3;
    nvalid = 32;
    if (pn < 5) src = 64 * (4 * pn + wc) + 32 * bj;
    else if (pn < 21) src = p0 + 24;
    else { src = 1280; nvalid = (within < 32) ? 24 : 0; }
}
DI void rms_row_to_bf16(const float* xrow, const float* g, bf16_t* orow, int lane) {
    const f32x4* xr = (const f32x4*)xrow + lane; const f32x4* gr = (const f32x4*)g + lane;
    f32x4 v[4]; float s = 0.f;
#pragma unroll
    for (int j = 0; j < 4; ++j) { v[j] = xr[64 * j]; s += (v[j].x * v[j].x + v[j].y * v[j].y) + (v[j].z * v[j].z + v[j].w * v[j].w); }
    const float rs = 1.f / sqrtf(wave_sum(s) * (1.f / DM) + EPS);
    unsigned long long* o8 = (unsigned long long*)orow + lane;
#pragma unroll
    for (int j = 0; j < 4; ++j) { const f32x4 gg = gr[64 * j];
        o8[64 * j] = (unsigned long long)pk2(v[j].x * rs * gg.x, v[j].y * rs * gg.y) | ((unsigned long long)pk2(v[j].z * rs * gg.z, v[j].w * rs * gg.w) << 32); }
}
struct P0Args {
    const float *w_in, *w_a, *w_b, *w_o, *w_g, *w_u, *w_d, *w1k, *w1v, *xp, *xs, *g1;
    bf16_t *WIN, *WA, *WB, *WO, *WG, *WU, *WD, *W1K, *W1V, *XN;
};
DI void p0_prologue(const P0Args& a, LAS unsigned char* lds, int gw, int NGW, int lane, int wave) {
    LAS float* scr = (LAS float*)(lds + wave * 16384);
    constexpr int I_IN = 16 * (NIN / 32), I_A = 8 * 32, I_O = 16 * 32, I_G = 16 * (DFF / 32), I_D = (DFF / 64) * 32, I_W1 = 32 * 2;
    constexpr int NITEMS = I_IN + 2 * I_A + I_O + 2 * I_G + I_D + 2 * I_W1;
    for (int it = gw; it < NITEMS; it += NGW) {
        int r = it;
        if (r < I_IN) { const int nb = NIN / 32, kb = r / nb, pb = r % nb; int src, nv; inproj_src(pb * 32, src, nv);
            p0_transpose_item(a.w_in, DM, CIN, a.WIN, pb * 32, src, nv, kb * 64, scr, lane); continue; } r -= I_IN;
        if (r < I_A) { const int kb = r / 32, pb = r % 32; p0_transpose_item(a.w_a, NSAW, DM, a.WA, pb * 32, pb * 32, 32, kb * 64, scr, lane); continue; } r -= I_A;
        if (r < I_A) { const int kb = r / 32, pb = r % 32; p0_transpose_item(a.w_b, HGW, DM, a.WB, pb * 32, pb * 32, 32, kb * 64, scr, lane); continue; } r -= I_A;
        if (r < I_O) { const int kb = r / 32, pb = r % 32; p0_transpose_item(a.w_o, DM, DM, a.WO, pb * 32, pb * 32, 32, kb * 64, scr, lane); continue; } r -= I_O;
        if (r < I_G) { const int nb = DFF / 32, kb = r / nb, pb = r % nb; p0_transpose_item(a.w_g, DM, DFF, a.WG, pb * 32, pb * 32, 32, kb * 64, scr, lane); continue; } r -= I_G;
        if (r < I_G) { const int nb = DFF / 32, kb = r / nb, pb = r % nb; p0_transpose_item(a.w_u, DM, DFF, a.WU, pb * 32, pb * 32, 32, kb * 64, scr, lane); continue; } r -= I_G;
        if (r < I_D) { const int kb = r / 32, pb = r % 32; p0_transpose_item(a.w_d, DFF, DM, a.WD, pb * 32, pb * 32, 32, kb * 64, scr, lane); continue; } r -= I_D;
        if (r < I_W1) { const int kb = r / 2, pb = r % 2; p0_transpose_item(a.w1k, 2048, 64, a.W1K, pb * 32, pb * 32, 32, kb * 64, scr, lane); continue; } r -= I_W1;
        { const int kb = r / 2, pb = r % 2; p0_transpose_item(a.w1v, 2048, 64, a.W1V, pb * 32, pb * 32, 32, kb * 64, scr, lane); }
    }
    for (int m = gw; m < MROWS; m += NGW) {
        const float* xr = (m < MP) ? a.xp + (size_t)m * DM : a.xs + (size_t)(m - MP) * DM;
        rms_row_to_bf16(xr, a.g1, a.XN + (size_t)m * DM, lane);
    }
}

typedef const f32x4 (&AccRef)[2][2][4][2];
DI void st_bf4(bf16_t* p, f32x4 v) { u32x2 w; w.x = pk2(v[0], v[1]); w.y = pk2(v[2], v[3]); *(u32x2*)p = w; }
DI f32x4 ld_bf4(const bf16_t* p) { const u32x2 w = *(const u32x2*)p; return (f32x4){bflo(w.x), bfhi(w.x), bflo(w.y), bfhi(w.y)}; }
DI f32x4 sig4(f32x4 v) { return (f32x4){sigmoidf_(v[0]), sigmoidf_(v[1]), sigmoidf_(v[2]), sigmoidf_(v[3])}; }

struct EpiInProj {
    static constexpr bool PERM = false, AFTER_DRAIN = false;
    bf16_t *Q, *KVB, *HQ, *HI, *HGT, *MG; float *GL, *GATES, *out; const float *qg, *kg, *lbl;
    DI void operator()(AccRef acc, const pg8::Unit& u, int wr, int wc, int fr, int fq) const {
        const int pn = u.pn, rbase = u.pm * 256 + wr * 64 + fr;
        if (pn < 5) {
            const int hu = 4 * pn + wc;
#pragma unroll
            for (int ai = 0; ai < 2; ++ai)
#pragma unroll
                for (int m = 0; m < 4; ++m) {
                    const int row = rbase + ai * 128 + m * 16;
                    float ss = 0.f;
#pragma unroll
                    for (int bj = 0; bj < 2; ++bj)
#pragma unroll
                        for (int n = 0; n < 2; ++n) { const f32x4 x = acc[ai][bj][m][n]; ss += (x[0] * x[0] + x[1] * x[1]) + (x[2] * x[2] + x[3] * x[3]); }
                    ss += __shfl_xor(ss, 16); ss += __shfl_xor(ss, 32);
                    if (row >= MROWS) continue;
                    const float rs = 1.f / sqrtf(ss * (1.f / 64.f) + EPS);
                    if (hu < 8) {
#pragma unroll
                        for (int bj = 0; bj < 2; ++bj)
#pragma unroll
                            for (int n = 0; n < 2; ++n) { const int d = 32 * bj + 16 * n + 4 * fq; const f32x4 g4 = *(const f32x4*)(qg + d);
                                st_bf4(Q + (size_t)row * NSAW + hu * 64 + d, acc[ai][bj][m][n] * g4 * (rs * QSCALE)); }
                    } else {
                        const int uu = hu - 8, slot = uu >> 1, g = uu & 1; const bool normed = (slot == 2 || slot == 4);
                        const float* gain = kg + (slot == 2 ? 64 : 128);
                        float* fdst;
                        if (slot < 4) fdst = out + OFF_KV + ((size_t)row * 4 + slot) * 128 + g * 64;
                        else if (row < MP) { const int b = row >> 11, t = row & 2047; fdst = (t >= SEQ - WIN) ? out + OFF_WINP + (((size_t)b * WIN + (t - (SEQ - WIN))) * 2 + (slot - 4)) * 128 + g * 64 : nullptr; }
                        else fdst = out + OFF_WINS + (((size_t)(row - MP) * WIN + (WIN - 1)) * 2 + (slot - 4)) * 128 + g * 64;
#pragma unroll
                        for (int bj = 0; bj < 2; ++bj)
#pragma unroll
                            for (int n = 0; n < 2; ++n) { const int d = 32 * bj + 16 * n + 4 * fq; f32x4 v = acc[ai][bj][m][n];
                                if (normed) v = v * *(const f32x4*)(gain + d) * rs;
                                if (fdst) *(f32x4*)(fdst + d) = v;
                                if (slot >= 2) st_bf4(KVB + (size_t)row * 512 + (slot - 2) * 128 + g * 64 + d, v); }
                    }
                }
        } else if (pn < 21) {
            const int kind = (pn < 13) ? ((pn - 5) >> 1) : 4, cb = (pn < 13) ? 256 * ((pn - 5) & 1) : 256 * (pn - 13);
#pragma unroll
            for (int ai = 0; ai < 2; ++ai)
#pragma unroll
                for (int m = 0; m < 4; ++m) {
                    const int row = rbase + ai * 128 + m * 16;
                    if (row >= MROWS) continue;
#pragma unroll
                    for (int bj = 0; bj < 2; ++bj)
#pragma unroll
                        for (int n = 0; n < 2; ++n) { const int c = cb + 128 * bj + 32 * wc + 16 * n + 4 * fq; const f32x4 x = acc[ai][bj][m][n];
                            if (kind == 0) st_bf4(HQ + (size_t)row * HGW + c, x * HG_SCALE);
                            else if (kind == 1) { const f32x4 l0 = *(const f32x4*)(lbl + c), l1 = *(const f32x4*)(lbl + HGW + c); f32x4 o;
#pragma unroll
                                for (int j = 0; j < 4; ++j) { const float lb = 1.f / (1.f + expf(l1[j] - l0[j])); const float f = lb + (1.f - lb) * (1.f / (1.f + expf(-x[j]))); o[j] = logf(f); }
                                *(f32x4*)(GL + (size_t)row * HGW + c) = o; }
                            else if (kind == 2) st_bf4(HI + (size_t)row * HGW + c, x);
                            else if (kind == 3) st_bf4(HGT + (size_t)row * HGW + c, x);
                            else st_bf4(MG + (size_t)row * 2048 + c, x); }
                }
        } else {
            if (wc == 0) {
#pragma unroll
                for (int ai = 0; ai < 2; ++ai)
#pragma unroll
                    for (int m = 0; m < 4; ++m) {
                        const int row = rbase + ai * 128 + m * 16;
                        if (row >= MROWS) continue;
                        *(f32x4*)(GATES + (size_t)row * 24 + 4 * fq) = sig4(acc[ai][0][m][0]);
                        if (fq < 2) *(f32x4*)(GATES + (size_t)row * 24 + 16 + 4 * fq) = sig4(acc[ai][0][m][1]);
                    }
            }
        }
    }
};

struct EpiMergeB {
    static constexpr bool PERM = false, AFTER_DRAIN = false;
    const bf16_t* MG; float* T;
    DI void operator()(AccRef acc, const pg8::Unit& u, int wr, int wc, int fr, int fq) const {
        const int rbase = u.pm * 256 + wr * 64 + fr, cbase = u.pn * 256 + 32 * wc + 4 * fq;
#pragma unroll
        for (int ai = 0; ai < 2; ++ai)
#pragma unroll
            for (int m = 0; m < 4; ++m) { const int row = rbase + ai * 128 + m * 16; if (row >= MROWS) continue;
#pragma unroll
                for (int bj = 0; bj < 2; ++bj)
#pragma unroll
                    for (int n = 0; n < 2; ++n) { const int c = cbase + 128 * bj + 16 * n;
                        *(f32x4*)(T + (size_t)row * DM + c) = sig4(ld_bf4(MG + (size_t)row * 2048 + DM + c)) * acc[ai][bj][m][n]; } }
    }
};
struct EpiMergeA {
    static constexpr bool PERM = false, AFTER_DRAIN = false;
    const bf16_t* MG; const float* T; bf16_t* MB;
    DI void operator()(AccRef acc, const pg8::Unit& u, int wr, int wc, int fr, int fq) const {
        const int rbase = u.pm * 256 + wr * 64 + fr, cbase = u.pn * 256 + 32 * wc + 4 * fq;
#pragma unroll
        for (int ai = 0; ai < 2; ++ai)
#pragma unroll
            for (int m = 0; m < 4; ++m) { const int row = rbase + ai * 128 + m * 16; if (row >= MROWS) continue;
#pragma unroll
                for (int bj = 0; bj < 2; ++bj)
#pragma unroll
                    for (int n = 0; n < 2; ++n) { const int c = cbase + 128 * bj + 16 * n;
                        const f32x4 v = sig4(ld_bf4(MG + (size_t)row * 2048 + c)) * acc[ai][bj][m][n] + *(const f32x4*)(T + (size_t)row * DM + c);
                        st_bf4(MB + (size_t)row * DM + c, v); } }
    }
};
struct EpiWo {
    static constexpr bool PERM = false, AFTER_DRAIN = false;
    const float *xp, *xs, *g2; float* Y; bf16_t* X1G; float* SSQ;
    DI void operator()(AccRef acc, const pg8::Unit& u, int wr, int wc, int fr, int fq) const {
        const int rbase = u.pm * 256 + wr * 64 + fr, cbase = u.pn * 256 + 32 * wc + 4 * fq;
#pragma unroll
        for (int ai = 0; ai < 2; ++ai)
#pragma unroll
            for (int m = 0; m < 4; ++m) { const int row = rbase + ai * 128 + m * 16; const bool ok = row < MROWS;
                const float* xr = (row < MP) ? xp + (size_t)row * DM : xs + (size_t)(row - MP) * DM;
                float ss = 0.f;
#pragma unroll
                for (int bj = 0; bj < 2; ++bj)
#pragma unroll
                    for (int n = 0; n < 2; ++n) { const int c = cbase + 128 * bj + 16 * n;
                        if (ok) { const f32x4 v = *(const f32x4*)(xr + c) + acc[ai][bj][m][n];
                            ss += (v[0] * v[0] + v[1] * v[1]) + (v[2] * v[2] + v[3] * v[3]);
                            *(f32x4*)(Y + (size_t)row * DM + c) = v;
                            st_bf4(X1G + (size_t)row * DM + c, v * *(const f32x4*)(g2 + c)); } }
                ss += __shfl_xor(ss, 16); ss += __shfl_xor(ss, 32);
                if (ok && fq == 0) SSQ[(size_t)row * 16 + u.pn * 4 + wc] = ss; }
    }
};
DI float row_rstd(const float* SSQ, int row) {
    const f32x4* p = (const f32x4*)(SSQ + (size_t)row * 16); const f32x4 a = p[0], b = p[1], c = p[2], d = p[3];
    const float s = ((a[0] + a[1]) + (a[2] + a[3])) + ((b[0] + b[1]) + (b[2] + b[3])) + ((c[0] + c[1]) + (c[2] + c[3])) + ((d[0] + d[1]) + (d[2] + d[3]));
    return 1.f / sqrtf(s * (1.f / DM) + EPS);
}
struct EpiGate {
    static constexpr bool PERM = false, AFTER_DRAIN = false;
    const float* SSQ; bf16_t* G; float* out; const float* state_conv;
    DI void operator()(AccRef acc, const pg8::Unit& u, int wr, int wc, int fr, int fq) const {
        const int rbase = u.pm * 256 + wr * 64 + fr, cbase = u.pn * 256 + 32 * wc + 4 * fq;
#pragma unroll
        for (int ai = 0; ai < 2; ++ai)
#pragma unroll
            for (int m = 0; m < 4; ++m) { const int row = rbase + ai * 128 + m * 16; if (row >= MROWS) continue;
                const float rs = row_rstd(SSQ, row);
                float* cdst = nullptr; const float* ccopy = nullptr; float* cdst2 = nullptr;
                if (row < MP) { const int b = row >> 11, t = row & 2047; if (t >= SEQ - 2) cdst = out + OFF_CVP + ((size_t)b * 2 + (t - (SEQ - 2))) * DFF; }
                else { const int bs = row - MP; cdst = out + OFF_CVS + ((size_t)bs * 2 + 1) * DFF; cdst2 = out + OFF_CVS + ((size_t)bs * 2) * DFF; ccopy = state_conv + ((size_t)bs * 2 + 1) * DFF; }
#pragma unroll
                for (int bj = 0; bj < 2; ++bj)
#pragma unroll
                    for (int n = 0; n < 2; ++n) { const int c = cbase + 128 * bj + 16 * n; const f32x4 v = acc[ai][bj][m][n] * rs;
                        st_bf4(G + (size_t)row * DFF + c, v);
                        if (cdst) *(f32x4*)(cdst + c) = v;
                        if (cdst2) *(f32x4*)(cdst2 + c) = *(const f32x4*)(ccopy + c); } }
    }
};
struct EpiUp {
    static constexpr bool PERM = false, AFTER_DRAIN = false;
    const float* SSQ; const bf16_t* G; bf16_t* H; const float *state_conv, *cw, *cb;
    DI void operator()(AccRef acc, const pg8::Unit& u, int wr, int wc, int fr, int fq) const {
        const int rbase = u.pm * 256 + wr * 64 + fr, cbase = u.pn * 256 + 32 * wc + 4 * fq;
#pragma unroll
        for (int ai = 0; ai < 2; ++ai)
#pragma unroll
            for (int m = 0; m < 4; ++m) { const int row = rbase + ai * 128 + m * 16; if (row >= MROWS) continue;
                const float rs = row_rstd(SSQ, row);
                const int t = (row < MP) ? (row & 2047) : 0; const int bs = row - MP;
#pragma unroll
                for (int bj = 0; bj < 2; ++bj)
#pragma unroll
                    for (int n = 0; n < 2; ++n) { const int c = cbase + 128 * bj + 16 * n;
                        const f32x4 g0 = ld_bf4(G + (size_t)row * DFF + c); f32x4 g1 = (f32x4){0.f, 0.f, 0.f, 0.f}, g2 = g1;
                        if (row < MP) { if (t >= 1) g1 = ld_bf4(G + (size_t)(row - 1) * DFF + c); if (t >= 2) g2 = ld_bf4(G + (size_t)(row - 2) * DFF + c); }
                        else { g1 = *(const f32x4*)(state_conv + ((size_t)bs * 2 + 1) * DFF + c); g2 = *(const f32x4*)(state_conv + ((size_t)bs * 2) * DFF + c); }
                        const f32x4 cv = *(const f32x4*)(cb + c) + *(const f32x4*)(cw + c) * g2 + *(const f32x4*)(cw + DFF + c) * g1 + *(const f32x4*)(cw + 2 * DFF + c) * g0;
                        const f32x4 up = acc[ai][bj][m][n] * rs;
                        st_bf4(H + (size_t)row * DFF + c, (f32x4){siluf_(cv[0]) * up[0], siluf_(cv[1]) * up[1], siluf_(cv[2]) * up[2], siluf_(cv[3]) * up[3]}); } }
    }
};
struct EpiDown {
    static constexpr bool PERM = false, AFTER_DRAIN = false;
    float* Y;
    DI void operator()(AccRef acc, const pg8::Unit& u, int wr, int wc, int fr, int fq) const {
        const int rbase = u.pm * 256 + wr * 64 + fr, cbase = u.pn * 256 + 32 * wc + 4 * fq;
#pragma unroll
        for (int ai = 0; ai < 2; ++ai)
#pragma unroll
            for (int m = 0; m < 4; ++m) { const int row = rbase + ai * 128 + m * 16; if (row >= MROWS) continue;
#pragma unroll
                for (int bj = 0; bj < 2; ++bj)
#pragma unroll
                    for (int n = 0; n < 2; ++n) { const int c = cbase + 128 * bj + 16 * n; float* p = Y + (size_t)row * DM + c; *(f32x4*)p = *(const f32x4*)p + acc[ai][bj][m][n]; } }
    }
};

DI int crow(int reg, int hi) { return (reg & 3) + 8 * (reg >> 2) + 4 * hi; }
constexpr int A_KT = 0, A_KSTR = 144, A_KBYTES = 64 * A_KSTR;
constexpr int A_VT = 2 * A_KBYTES, A_VSTR = 192, A_VBYTES = 64 * A_VSTR;
constexpr int A_LUT = A_VT + 2 * A_VBYTES;
constexpr int A_IMP = A_LUT + 4 * 132 * 4;
constexpr int A_TOT = A_IMP + 4 * 64 * 33 * 4;
constexpr int A_SELM = A_TOT + 64 * 33 * 4;
constexpr int A_WS = A_SELM + 512;
constexpr int A_OACC = A_WS + 8 * 64 * 4;
constexpr int A_END = A_OACC + 8 * 32 * 64 * 2;
static_assert(A_END <= RING_BYTES, "attention LDS");

DI float swap_max(float v) { auto rr = __builtin_amdgcn_permlane32_swap(__float_as_uint(v), __float_as_uint(v), false, false); return fmaxf(__uint_as_float(rr[0]), __uint_as_float(rr[1])); }
DI float swap_sum(float v) { auto rr = __builtin_amdgcn_permlane32_swap(__float_as_uint(v), __float_as_uint(v), false, false); return __uint_as_float(rr[0]) + __uint_as_float(rr[1]); }

DI void build_lut(LAS float* lut, const float* rel_table, int g, int tid) {
    for (int e = tid; e < 4 * 129; e += NTHREADS) { const int r = e / 129, dd = e % 129;
        int bk; if (dd < 16) bk = dd; else { bk = 16 + (int)(logf((float)dd / 16.f) / 2.0794415416798357f * 16.f); bk = bk > 31 ? 31 : bk; }
        lut[r * 132 + dd] = rel_table[bk * NH + 4 * g + r] * LOG2E; }
}

struct AttnCtx {
    LAS unsigned char* lds; int tid, lane, wave, r32, hi, r, qh;
    bf16x8 qr[4];
    float m_run, l_run; f32x16 o[2];
};
DI void tile_fetch(const bf16_t* Ksrc, const bf16_t* Vsrc, int stride, int tid, u32x4& kreg, u32x4& vreg) {
    const int key = tid >> 3, ch = tid & 7;
    kreg = *(const u32x4*)(Ksrc + (size_t)key * stride + ch * 8); vreg = *(const u32x4*)(Vsrc + (size_t)key * stride + ch * 8);
}
DI void tile_store(LAS unsigned char* lds, int buf, int tid, const u32x4& kreg, const u32x4& vreg) {
    const int key = tid >> 3, ch = tid & 7;
    *(LAS u32x4*)(lds + A_KT + buf * A_KBYTES + key * A_KSTR + ch * 16) = kreg;
    *(LAS u32x4*)(lds + A_VT + buf * A_VBYTES + key * A_VSTR + ch * 16) = vreg;
}
DI void qk_tile(const AttnCtx& c, int buf, f32x16& p0, f32x16& p1) {
    const LAS unsigned char* kb = c.lds + A_KT + buf * A_KBYTES + c.r32 * A_KSTR + c.hi * 16;
#pragma unroll
    for (int k = 0; k < 16; ++k) { p0[k] = 0.f; p1[k] = 0.f; }
#pragma unroll
    for (int d0 = 0; d0 < 4; ++d0) {
        const bf16x8 a0 = *(const LAS bf16x8*)(kb + d0 * 32), a1 = *(const LAS bf16x8*)(kb + 32 * A_KSTR + d0 * 32);
        p0 = MFMA32(a0, c.qr[d0], p0); p1 = MFMA32(a1, c.qr[d0], p1);
    }
}
DI void pv_tile(AttnCtx& c, int buf, const f32x16& e0, const f32x16& e1) {
    const int q = (c.lane & 15) >> 2, p = c.lane & 3, blk = (c.lane >> 4) & 1;
    const LAS unsigned char* vb = c.lds + A_VT + buf * A_VBYTES + (4 * c.hi + q) * A_VSTR + (16 * blk + 4 * p) * 2;
#pragma unroll
    for (int kh = 0; kh < 2; ++kh)
#pragma unroll
        for (int s = 0; s < 2; ++s) {
            __builtin_amdgcn_sched_barrier(0);
            float t[8];
#pragma unroll
            for (int j = 0; j < 8; ++j) t[j] = kh ? e1[8 * s + j] : e0[8 * s + j];
            const bf16x8 pa = pack8(t);
#pragma unroll
            for (int d0 = 0; d0 < 2; ++d0) {
                const LAS unsigned char* vp = vb + (32 * kh + 16 * s) * A_VSTR + d0 * 64;
                const bf16x8 vf = cat44(tr_read(vp), tr_read(vp + 8 * A_VSTR));
                c.o[d0] = MFMA32(pa, vf, c.o[d0]);
            }
        }
}
DI void softmax_pv(AttnCtx& c, int buf, f32x16& s0, f32x16& s1) {
    float mt = -INFINITY;
#pragma unroll
    for (int k = 0; k < 16; ++k) mt = fmaxf(mt, fmaxf(s0[k], s1[k]));
    mt = swap_max(mt);
    const float m_new = fmaxf(c.m_run, mt), alpha = exp2f(c.m_run - m_new);
    c.m_run = m_new;
    float sum = 0.f;
#pragma unroll
    for (int k = 0; k < 16; ++k) { s0[k] = exp2f(s0[k] - m_new); s1[k] = exp2f(s1[k] - m_new); sum += s0[k] + s1[k]; }
    c.l_run = c.l_run * alpha + sum;
    if (__any(alpha != 1.f)) {
        LAS float* wsf = (LAS float*)(c.lds + A_WS) + c.wave * 64;
        if (c.hi == 0) wsf[c.r32] = alpha;
        asm volatile("s_waitcnt lgkmcnt(0)" ::: "memory");
#pragma unroll
        for (int k = 0; k < 16; ++k) { const float a = wsf[crow(k, c.hi)]; c.o[0][k] *= a; c.o[1][k] *= a; }
        asm volatile("s_waitcnt lgkmcnt(0)" ::: "memory");
    }
    pv_tile(c, buf, s0, s1);
}
template <bool FIRST>
DI void branch_finish(AttnCtx& c, float gate) {
    const float lt = swap_sum(c.l_run);
    const float fac = lt > 0.f ? gate / lt : 0.f;
    LAS float* wsf = (LAS float*)(c.lds + A_WS) + c.wave * 64;
    if (c.hi == 0) wsf[c.r32] = fac;
    asm volatile("s_waitcnt lgkmcnt(0)" ::: "memory");
    int sofs = c.wave * 2048 + c.r32; asm volatile("" : "+v"(sofs));
    LAS bf16_t* oa = (LAS bf16_t*)(c.lds + A_OACC) + sofs;
#pragma unroll
    for (int k = 0; k < 16; ++k) { const float a = wsf[crow(k, c.hi)];
#pragma unroll
        for (int d0 = 0; d0 < 2; ++d0) { LAS bf16_t* p = oa + crow(k, c.hi) * 64 + 32 * d0; float v = c.o[d0][k] * a; if (!FIRST) v += bf2f(*p); *p = (bf16_t)f2bf(v); } }
    asm volatile("s_waitcnt lgkmcnt(0)" ::: "memory");
#pragma unroll
    for (int k = 0; k < 16; ++k) { c.o[0][k] = 0.f; c.o[1][k] = 0.f; }
    c.m_run = -1e30f; c.l_run = 0.f;
}

struct AttnArgs { const bf16_t *Q, *KVB, *CKP, *CVP; const float *GATES, *rel_table; bf16_t* ONSA; };

DI void attn_prompt_unit(const AttnArgs& A, LAS unsigned char* lds, int b, int g, int i, int tid, int lane, int wave) {
    AttnCtx c; c.lds = lds; c.tid = tid; c.lane = lane; c.wave = wave; c.r32 = lane & 31; c.hi = lane >> 5; c.r = wave >> 1; c.qh = wave & 1;
    const int u = 32 * c.qh + c.r32, h = 4 * g + c.r;
    const size_t qrow = (size_t)b * SEQ + 64 * i + u;
    LAS float* lut = (LAS float*)(lds + A_LUT) + c.r * 132;
    LAS float* IMP = (LAS float*)(lds + A_IMP); LAS float* TOT = (LAS float*)(lds + A_TOT); LAS unsigned* SELM = (LAS unsigned*)(lds + A_SELM);
#pragma unroll
    for (int d0 = 0; d0 < 4; ++d0) c.qr[d0] = *(const bf16x8*)(A.Q + qrow * NSAW + h * 64 + 16 * d0 + 8 * c.hi);
    const float* gatep = A.GATES + qrow * 24 + h * 3;
#pragma unroll
    for (int k = 0; k < 16; ++k) { c.o[0][k] = 0.f; c.o[1][k] = 0.f; }
    c.m_run = -1e30f; c.l_run = 0.f;
    u32x4 kreg, vreg;
    const float bias_far = lut[128];

    tile_fetch(A.CKP + (size_t)(b * 2 + g) * 4096, A.CVP + (size_t)(b * 2 + g) * 4096, 64, tid, kreg, vreg);
    __syncthreads();
    tile_store(lds, 0, tid, kreg, vreg);
    __syncthreads();
    {
        f32x16 s0, s1; qk_tile(c, 0, s0, s1);
        const int qpos = 64 * i + u;
#pragma unroll
        for (int k = 0; k < 16; ++k) {
            const int n0 = crow(k, c.hi), n1 = n0 + 32; const int d0 = qpos - (32 * n0 + 31), d1 = qpos - (32 * n1 + 31);
            s0[k] = d0 >= 0 ? s0[k] + lut[d0 > 128 ? 128 : d0] : -INFINITY;
            s1[k] = d1 >= 0 ? s1[k] + lut[d1 > 128 ? 128 : d1] : -INFINITY;
        }
        softmax_pv(c, 0, s0, s1);
        const float lt = swap_sum(c.l_run), inv = lt > 0.f ? 1.f / lt : 0.f;
        int iofs = (c.r * 64 + u) * 33 + 2 * c.hi; asm volatile("" : "+v"(iofs));
#pragma unroll
        for (int k = 0; k < 16; k += 2) {
            IMP[iofs + (crow(k, 0) >> 1)] = (s0[k] + s0[k + 1]) * inv;
            IMP[iofs + 16 + (crow(k, 0) >> 1)] = (s1[k] + s1[k + 1]) * inv;
        }
        branch_finish<true>(c, gatep[0]);
    }
    __syncthreads();
    {
        const int uq = tid >> 3, sub = tid & 7;
        unsigned mbits = 0u;
        if (i < 16) { mbits = (i >= 31) ? 0xffffffffu : ((1u << (i + 1)) - 1u); }
        else {
#pragma unroll
            for (int jj = 0; jj < 4; ++jj) { const int j = sub * 4 + jj;
                TOT[uq * 33 + j] = (IMP[(0 * 64 + uq) * 33 + j] + IMP[(1 * 64 + uq) * 33 + j]) + (IMP[(2 * 64 + uq) * 33 + j] + IMP[(3 * 64 + uq) * 33 + j]); }
        }
        __syncthreads();
        if (i >= 16) {
            const int ntop = 16 - 3;
#pragma unroll
            for (int jj = 0; jj < 4; ++jj) { const int j = sub * 4 + jj;
                if (j > i) continue;
                if (j == 0 || j >= i - 1) { mbits |= 1u << j; continue; }
                const float mine = TOT[uq * 33 + j]; int cnt = 0;
                for (int j2 = 1; j2 < i - 1; ++j2) { const float o2 = TOT[uq * 33 + j2]; cnt += (o2 > mine || (o2 == mine && j2 < j)) ? 1 : 0; }
                if (cnt < ntop) mbits |= 1u << j; }
            mbits |= __shfl_xor(mbits, 1); mbits |= __shfl_xor(mbits, 2); mbits |= __shfl_xor(mbits, 4);
        }
        if (sub == 0) SELM[uq] = mbits;
    }
    __syncthreads();
    const unsigned selm = SELM[u];
    unsigned umask = selm;
    { unsigned t = selm; for (int o = 1; o < 32; o <<= 1) t |= __shfl_xor(t, o); if (c.r32 == 0 && c.hi == 0 && c.r == 0) SELM[64 + c.qh] = t; }
    __syncthreads();
    umask = SELM[64] | SELM[65];
    umask = __builtin_amdgcn_readfirstlane(umask);
    __syncthreads();

    {
        const bf16_t* Kb = A.KVB + (size_t)b * SEQ * 512 + 0 * 128 + g * 64; const bf16_t* Vb = Kb + 128;
        unsigned rem = umask & ((i >= 31) ? 0xffffffffu : ((1u << (i + 1)) - 1u));
        int j = __builtin_ctz(rem); rem &= rem - 1u;
        tile_fetch(Kb + (size_t)64 * j * 512, Vb + (size_t)64 * j * 512, 512, tid, kreg, vreg);
        int buf = 0;
        for (;;) {
            tile_store(lds, buf, tid, kreg, vreg);
            __syncthreads();
            const int jn = rem ? __builtin_ctz(rem) : -1; if (rem) rem &= rem - 1u;
            if (jn >= 0) tile_fetch(Kb + (size_t)64 * jn * 512, Vb + (size_t)64 * jn * 512, 512, tid, kreg, vreg);
            if (__any((selm >> j) & 1u)) {
                f32x16 s0, s1; qk_tile(c, buf, s0, s1);
                const bool sel = (selm >> j) & 1u;
                if (i - j >= 3) {
#pragma unroll
                    for (int k = 0; k < 16; ++k) { s0[k] = sel ? s0[k] + bias_far : -INFINITY; s1[k] = sel ? s1[k] + bias_far : -INFINITY; }
                } else {
                    const int dbase = 64 * (i - j) + u;
#pragma unroll
                    for (int k = 0; k < 16; ++k) { const int d0 = dbase - crow(k, c.hi), d1 = d0 - 32;
                        s0[k] = (sel && d0 >= 0) ? s0[k] + lut[d0 > 128 ? 128 : d0] : -INFINITY;
                        s1[k] = (sel && d1 >= 0) ? s1[k] + lut[d1 > 128 ? 128 : d1] : -INFINITY; }
                }
                softmax_pv(c, buf, s0, s1);
            }
            if (jn < 0) break;
            j = jn; buf ^= 1;
        }
        branch_finish<false>(c, gatep[1]);
    }
    __syncthreads();
    {
        const bf16_t* Kb = A.KVB + (size_t)b * SEQ * 512 + 2 * 128 + g * 64; const bf16_t* Vb = Kb + 128;
        int j = i - 8 < 0 ? 0 : i - 8;
        tile_fetch(Kb + (size_t)64 * j * 512, Vb + (size_t)64 * j * 512, 512, tid, kreg, vreg);
        int buf = 0;
        for (;;) {
            tile_store(lds, buf, tid, kreg, vreg);
            __syncthreads();
            if (j < i) tile_fetch(Kb + (size_t)64 * (j + 1) * 512, Vb + (size_t)64 * (j + 1) * 512, 512, tid, kreg, vreg);
            {
                f32x16 s0, s1; qk_tile(c, buf, s0, s1);
                const int dbase = 64 * (i - j) + u;
                if (i - j >= 3 && i - j < 8) {
#pragma unroll
                    for (int k = 0; k < 16; ++k) { s0[k] += bias_far; s1[k] += bias_far; }
                } else {
#pragma unroll
                    for (int k = 0; k < 16; ++k) { const int d0 = dbase - crow(k, c.hi), d1 = d0 - 32;
                        s0[k] = (d0 >= 0 && d0 <= WIN) ? s0[k] + lut[d0 > 128 ? 128 : d0] : -INFINITY;
                        s1[k] = (d1 >= 0 && d1 <= WIN) ? s1[k] + lut[d1 > 128 ? 128 : d1] : -INFINITY; }
                }
                softmax_pv(c, buf, s0, s1);
            }
            if (j >= i) break;
            ++j; buf ^= 1;
        }
        branch_finish<false>(c, gatep[2]);
    }
    {
        const LAS bf16_t* stg = (const LAS bf16_t*)(lds + A_OACC) + wave * 2048;
        bf16_t* ob = A.ONSA + ((size_t)b * SEQ + 64 * i + 32 * c.qh) * NSAW + h * 64;
#pragma unroll
        for (int i4 = 0; i4 < 4; ++i4) { const int rw = i4 * 8 + (lane >> 3), ch = lane & 7;
            const u32x4 v = *(const LAS u32x4*)(stg + rw * 64 + ch * 8); *(u32x4*)(ob + (size_t)rw * NSAW + ch * 8) = v; }
    }
}

constexpr int H_QT = 0, H_QSTR = 272;
constexpr int H_KS = H_QT + 64 * H_QSTR;
constexpr int H_KT = H_KS + 64 * H_QSTR, H_KTSTR = 144;
constexpr int H_VL = H_KT + 128 * H_KTSTR, H_VSTR = 288;
constexpr int H_AT = H_VL + 64 * H_VSTR, H_ASTR = 144;
constexpr int H_BC = H_AT + 64 * H_ASTR, H_BSTR = 132;
constexpr int H_PT = H_BC + 64 * H_BSTR * 4;
constexpr int H_BR = H_PT + 4 * 128 * 4;
constexpr int H_DB = H_BR + 4 * 128 * 4;
constexpr int H_SS = H_DB + 128 * 4;
constexpr int H_END = H_SS + 8 * 64 * 4;
static_assert(H_END <= RING_BYTES, "hgrn LDS");

DI float ex2(float x) { return __builtin_amdgcn_exp2f(x); }

struct HgArgs { const bf16_t *HQ, *HI, *HGT; const float *GL, *hgn; float *SLOC, *GD; bf16_t* OHG; float* out; };

template <bool WITH_OUT>
DI void hgrn_unit(const HgArgs& A, LAS unsigned char* lds, int unit, int tid, int lane, int wave) {
    const int bh = unit >> 3, grp = unit & 7, b = bh >> 2, h = bh & 3;
    const int gq = lane >> 4, l15 = lane & 15;
    f32x4 acc[8];
#pragma unroll
    for (int kt = 0; kt < 8; ++kt) acc[kt] = (f32x4){0.f, 0.f, 0.f, 0.f};
    if (WITH_OUT) {
        for (int g2 = 0; g2 < grp; ++g2) {
            int lofs = (4 * gq) * 128 + 16 * wave + l15; asm volatile("" : "+v"(lofs));
            const float* sl = A.SLOC + (size_t)(bh * 8 + g2) * 16384 + lofs; const float* gd = A.GD + (size_t)(bh * 8 + g2) * 128 + 4 * gq;
#pragma unroll
            for (int kt = 0; kt < 8; ++kt) { const f32x4 g4 = *(const f32x4*)(gd + 16 * kt);
#pragma unroll
                for (int r = 0; r < 4; ++r) acc[kt][r] = acc[kt][r] * __expf(g4[r]) + sl[(16 * kt + r) * 128]; }
        }
        for (int e = tid; e < 64 * H_ASTR / 4; e += NTHREADS) ((LAS unsigned*)(lds + H_AT))[e] = 0u;
    }
    const int kch = tid & 127, part = tid >> 7;
    float gdsum = 0.f;
    for (int ch = 0; ch < 4; ++ch) {
        const size_t row0 = (size_t)b * SEQ + 256 * grp + 64 * ch;
        __syncthreads();
        const float* glp = A.GL + (row0 + 16 * part) * HGW + h * 128 + kch;
        const bf16_t* hqp = A.HQ + (row0 + 16 * part) * HGW + h * 128 + kch;
        float run = 0.f;
#pragma unroll 4
        for (int t = 0; t < 16; ++t) run += glp[(size_t)t * HGW];
        ((LAS float*)(lds + H_PT))[part * 128 + kch] = run;
        { const int s = tid >> 3, c8 = tid & 7;
#pragma unroll
          for (int q2 = 0; q2 < 2; ++q2) { const u32x4 v = *(const u32x4*)(A.HI + (row0 + s) * HGW + h * 128 + (c8 + 8 * q2) * 8);
              *(LAS u32x4*)(lds + H_VL + s * H_VSTR + (c8 + 8 * q2) * 16) = v; } }
        __syncthreads();
        float off = 0.f, btot = 0.f;
        { const LAS float* pt = (const LAS float*)(lds + H_PT);
#pragma unroll
          for (int p2 = 0; p2 < 4; ++p2) { const float v = pt[p2 * 128 + kch]; if (p2 < part) off += v; btot += v; } }
        const float bref = off + run;
        if (part == 0) { ((LAS float*)(lds + H_DB))[kch] = __expf(btot); gdsum += btot; }
        if (WITH_OUT) ((LAS float*)(lds + H_BR))[part * 128 + kch] = bref;
        { float bt = off;
#pragma unroll 1
          for (int t4 = 0; t4 < 4; ++t4) {
              unsigned kw[2];
#pragma unroll
              for (int t1 = 0; t1 < 4; ++t1) { const int tl = 4 * t4 + t1, tt = 16 * part + tl;
                  const float gl = glp[(size_t)tl * HGW]; bt += gl;
                  const float kkv = 1.f - __expf(gl);
                  const unsigned hv = f2bf(kkv * __expf(btot - bt));
                  if (t1 & 1) kw[t1 >> 1] |= hv << 16; else kw[t1 >> 1] = hv;
                  if (WITH_OUT) {
                      const float qv = bf2f(hqp[(size_t)tl * HGW]);
                      *(LAS bf16_t*)(lds + H_QT + tt * H_QSTR + kch * 2) = (bf16_t)f2bf(qv * __expf(bt));
                      *(LAS bf16_t*)(lds + H_KS + tt * H_QSTR + kch * 2) = (bf16_t)f2bf(kkv * __expf(bref - bt));
                      ((LAS float*)(lds + H_BC))[tt * H_BSTR + kch] = bt;
                  } }
              *(LAS u32x2*)(lds + H_KT + kch * H_KTSTR + part * 32 + t4 * 8) = (u32x2){kw[0], kw[1]}; } }
        __syncthreads();
        if (WITH_OUT) {
            for (int tile = wave; tile < 10; tile += 8) {
                int it, js; { int rem = tile; it = 0; while (rem > it) { rem -= it + 1; ++it; } js = rem; }
                f32x4 a4 = (f32x4){0.f, 0.f, 0.f, 0.f};
                const int trow = 16 * it + l15, srow = 16 * js + l15;
#pragma unroll 1
                for (int ks = 0; ks < 4; ++ks) {
                    const int k0 = 32 * ks + 8 * gq;
                    const u32x4 qraw = *(const u32x4*)(A.HQ + (row0 + trow) * HGW + h * 128 + k0);
                    const LAS float* bp = (const LAS float*)(lds + H_BC) + trow * H_BSTR + k0; const LAS float* rp = (const LAS float*)(lds + H_BR) + js * 128 + k0;
                    const f32x4 b0 = *(const LAS f32x4*)bp, b1 = *(const LAS f32x4*)(bp + 4), r0 = *(const LAS f32x4*)rp, r1 = *(const LAS f32x4*)(rp + 4);
                    float qd[8];
                    qd[0] = bflo(qraw.x) * __expf(b0[0] - r0[0]); qd[1] = bfhi(qraw.x) * __expf(b0[1] - r0[1]); qd[2] = bflo(qraw.y) * __expf(b0[2] - r0[2]); qd[3] = bfhi(qraw.y) * __expf(b0[3] - r0[3]);
                    qd[4] = bflo(qraw.z) * __expf(b1[0] - r1[0]); qd[5] = bfhi(qraw.z) * __expf(b1[1] - r1[1]); qd[6] = bflo(qraw.w) * __expf(b1[2] - r1[2]); qd[7] = bfhi(qraw.w) * __expf(b1[3] - r1[3]);
                    const bf16x8 af = pack8(qd);
                    const bf16x8 bfv = *(const LAS bf16x8*)(lds + H_KS + srow * H_QSTR + k0 * 2);
                    a4 = MFMA16(af, bfv, a4);
                }
#pragma unroll
                for (int r = 0; r < 4; ++r) { const int tl = 4 * gq + r; float v = a4[r]; if (it == js && l15 > tl) v = 0.f;
                    *(LAS bf16_t*)(lds + H_AT + (16 * it + tl) * H_ASTR + (16 * js + l15) * 2) = (bf16_t)f2bf(v); }
            }
            __syncthreads();
        }
        bf16x8 vf[2];
        { const int q = l15 >> 2, p = l15 & 3;
#pragma unroll
          for (int ks = 0; ks < 2; ++ks) { const LAS unsigned char* vp = lds + H_VL + (32 * ks + 4 * gq + q) * H_VSTR + (16 * wave + 4 * p) * 2;
              vf[ks] = cat44(tr_read(vp), tr_read(vp + 16 * H_VSTR)); } }
        if (WITH_OUT) {
            f32x4 o[4];
#pragma unroll
            for (int it = 0; it < 4; ++it) { o[it] = (f32x4){0.f, 0.f, 0.f, 0.f};
                const int trow = 16 * it + l15;
#pragma unroll
                for (int ks = 0; ks < 2; ++ks) { const LAS unsigned char* ap = lds + H_AT + trow * H_ASTR + (32 * ks + 4 * gq) * 2;
                    const bf16x8 af = cat44(*(const LAS s16x4*)ap, *(const LAS s16x4*)(ap + 32)); o[it] = MFMA16(af, vf[ks], o[it]); } }
#pragma unroll
            for (int ks = 0; ks < 4; ++ks) {
                const bf16x8 sf = pack8v(acc[2 * ks], acc[2 * ks + 1]);
#pragma unroll
                for (int it = 0; it < 4; ++it) { const LAS unsigned char* qp = lds + H_QT + (16 * it + l15) * H_QSTR + (32 * ks + 4 * gq) * 2;
                    const bf16x8 af = cat44(*(const LAS s16x4*)qp, *(const LAS s16x4*)(qp + 32)); o[it] = MFMA16(af, sf, o[it]); } }
            LAS float* SS = (LAS float*)(lds + H_SS);
#pragma unroll
            for (int it = 0; it < 4; ++it)
#pragma unroll
                for (int r = 0; r < 4; ++r) { float s = o[it][r] * o[it][r]; s += __shfl_xor(s, 1); s += __shfl_xor(s, 2); s += __shfl_xor(s, 4); s += __shfl_xor(s, 8);
                    if (l15 == 0) SS[wave * 64 + 16 * it + 4 * gq + r] = s; }
            __syncthreads();
            if (tid < 64) { float tot = 0.f;
#pragma unroll
                for (int w2 = 0; w2 < 8; ++w2) tot += SS[w2 * 64 + tid];
                ((LAS float*)(lds + H_PT))[tid] = 1.f / sqrtf(tot * (1.f / 128.f) + EPS); }
            __syncthreads();
            const float gn = A.hgn[16 * wave + l15];
#pragma unroll
            for (int it = 0; it < 4; ++it) {
                const f32x4 rs4 = *(const LAS f32x4*)((const LAS float*)(lds + H_PT) + 16 * it + 4 * gq);
#pragma unroll
                for (int r = 0; r < 4; ++r) { const int t = 16 * it + 4 * gq + r;
                    const size_t idx = (row0 + t) * HGW + h * 128 + 16 * wave + l15;
                    const float gate = bf2f(A.HGT[idx]);
                    A.OHG[idx] = (bf16_t)f2bf(o[it][r] * rs4[r] * gn * siluf_(gate)); } }
        }
        { const LAS float* DB = (const LAS float*)(lds + H_DB);
#pragma unroll
          for (int kt = 0; kt < 8; ++kt) { const f32x4 d4 = *(const LAS f32x4*)(DB + 16 * kt + 4 * gq); acc[kt] = acc[kt] * d4;
#pragma unroll
              for (int ks = 0; ks < 2; ++ks) { const LAS unsigned char* kp = lds + H_KT + (16 * kt + l15) * H_KTSTR + (32 * ks + 4 * gq) * 2;
                  const bf16x8 af = cat44(*(const LAS s16x4*)kp, *(const LAS s16x4*)(kp + 32)); acc[kt] = MFMA16(af, vf[ks], acc[kt]); } } }
    }
    if (!WITH_OUT) {
        int lofs = (4 * gq) * 128 + 16 * wave + l15; asm volatile("" : "+v"(lofs));
        float* sl = A.SLOC + (size_t)unit * 16384 + lofs;
#pragma unroll
        for (int kt = 0; kt < 8; ++kt)
#pragma unroll
            for (int r = 0; r < 4; ++r) sl[(16 * kt + r) * 128] = acc[kt][r];
        if (part == 0) A.GD[(size_t)unit * 128 + kch] = gdsum;
    } else if (grp == 7) {
        int lofs = (4 * gq) * 128 + 16 * wave + l15; asm volatile("" : "+v"(lofs));
        float* so = A.out + OFF_HGP + (size_t)bh * 16384 + lofs;
#pragma unroll
        for (int kt = 0; kt < 8; ++kt)
#pragma unroll
            for (int r = 0; r < 4; ++r) so[(16 * kt + r) * 128] = acc[kt][r];
    }
}

DI float gelu_tanh(float x) { const float uu = 0.7978845608028654f * (x + 0.044715f * x * x * x); const float t = 1.f - 2.f / (__expf(2.f * uu) + 1.f); return 0.5f * x * (1.f + t); }
struct CmpArgs { const float *cache, *kvout; const int* page_table; const bf16_t *W1K, *W1V; const float *w2k, *w2v, *kg0; float *CKS, *CVS; bf16_t *CKP, *CVP; };
DI void compress_item(const CmpArgs& A, LAS unsigned char* lds, int item, int tid, int lane, int wave) {
    const bool sample = item < 2048; const int it2 = sample ? item : item - 2048;
    const int bb = it2 >> 4, g = (it2 >> 3) & 1, kv = (it2 >> 2) & 1, rt = it2 & 3;
    const int nl = lane & 15, gq = lane >> 4, n = 16 * rt + nl;
    const bf16_t* W1 = kv ? A.W1V : A.W1K;
    f32x4 acc[4];
#pragma unroll
    for (int nt = 0; nt < 4; ++nt) acc[nt] = (f32x4){0.f, 0.f, 0.f, 0.f};
    f32x4 av[4][2][2];
#pragma unroll
    for (int jj = 0; jj < 4; ++jj) { const int t = 32 * n + 4 * wave + jj;
        const float* rp = sample ? A.cache + ((size_t)A.page_table[bb * NPAGES + (t >> 7)] * PAGE + (t & 127)) * 512 : A.kvout + ((size_t)bb * SEQ + t) * 512;
        rp += kv * 128 + g * 64 + 8 * gq;
#pragma unroll
        for (int k2 = 0; k2 < 2; ++k2) { av[jj][k2][0] = *(const f32x4*)(rp + 32 * k2); av[jj][k2][1] = *(const f32x4*)(rp + 32 * k2 + 4); } }
#pragma unroll
    for (int jj = 0; jj < 4; ++jj)
#pragma unroll
        for (int k2 = 0; k2 < 2; ++k2) { const bf16x8 af = pack8v(av[jj][k2][0], av[jj][k2][1]); const int kof = (4 * wave + jj) * 64 + 32 * k2 + 8 * gq;
#pragma unroll
            for (int nt = 0; nt < 4; ++nt) { const bf16x8 bfv = *(const bf16x8*)(W1 + (size_t)(16 * nt + nl) * 2048 + kof); acc[nt] = MFMA16(af, bfv, acc[nt]); } }
    LAS float* part = (LAS float*)lds; LAS float* hb = (LAS float*)(lds + 32768);
#pragma unroll
    for (int nt = 0; nt < 4; ++nt)
#pragma unroll
        for (int r = 0; r < 4; ++r) part[wave * 1024 + (4 * gq + r) * 64 + 16 * nt + nl] = acc[nt][r];
    __syncthreads();
    const int row = tid >> 5, e2 = (tid & 31) * 2;
    { float h0 = 0.f, h1 = 0.f;
#pragma unroll
      for (int w2 = 0; w2 < 8; ++w2) { const f32x2 v = *(const LAS f32x2*)(part + w2 * 1024 + row * 64 + e2); h0 += v.x; h1 += v.y; }
      hb[row * 64 + e2] = gelu_tanh(h0); hb[row * 64 + e2 + 1] = gelu_tanh(h1); }
    __syncthreads();
    const float* w2 = kv ? A.w2v : A.w2k;
    float o0 = 0.f, o1 = 0.f;
#pragma unroll 8
    for (int e = 0; e < 64; ++e) { const float hv = hb[row * 64 + e]; const f32x2 w = *(const f32x2*)(w2 + e * 64 + e2); o0 += hv * w.x; o1 += hv * w.y; }
    if (kv == 0) { float ss = o0 * o0 + o1 * o1;
#pragma unroll
        for (int o = 1; o < 32; o <<= 1) ss += __shfl_xor(ss, o);
        const float rs = 1.f / sqrtf(ss * (1.f / 64.f) + EPS); o0 *= rs * A.kg0[e2]; o1 *= rs * A.kg0[e2 + 1]; }
    const int nn = 16 * rt + row;
    if (sample) { float* dst = (kv ? A.CVS : A.CKS) + ((size_t)(bb * 2 + g) * 64 + nn) * 64 + e2; *(f32x2*)dst = (f32x2){o0, o1}; }
    else { bf16_t* dst = (kv ? A.CVP : A.CKP) + ((size_t)(bb * 2 + g) * 64 + nn) * 64 + e2; *(unsigned*)dst = pk2(o0, o1); }
}

struct HsArgs { const float *S0, *GL, *hgn; const bf16_t *HQ, *HI, *HGT; bf16_t* OHG; float* out; };
DI void hgrn_sample_unit(const HsArgs& A, LAS unsigned char* lds, int unit, int tid, int lane, int wave) {
    const int bs = unit >> 2, h = unit & 3; const size_t row = (size_t)MP + bs;
    const int vq = tid & 31, kg = tid >> 5;
    const float* S0 = A.S0 + (size_t)unit * 16384; float* S1 = A.out + OFF_HGS + (size_t)unit * 16384;
    const f32x4 vv = ld_bf4(A.HI + row * HGW + h * 128 + 4 * vq);
    f32x4 o = (f32x4){0.f, 0.f, 0.f, 0.f};
    f32x4 s[8];
#pragma unroll
    for (int i2 = 0; i2 < 8; ++i2) s[i2] = *(const f32x4*)(S0 + (size_t)(kg + 16 * i2) * 128 + 4 * vq);
#pragma unroll
    for (int i2 = 0; i2 < 8; ++i2) { const int k = kg + 16 * i2;
        const float f = __expf(A.GL[row * HGW + h * 128 + k]), qk = bf2f(A.HQ[row * HGW + h * 128 + k]);
        const f32x4 sn = s[i2] * f + vv * (1.f - f);
        *(f32x4*)(S1 + (size_t)k * 128 + 4 * vq) = sn; o += sn * qk; }
    LAS float* red = (LAS float*)lds; LAS float* ov = red + 16 * 128;
    __syncthreads();
    *(LAS f32x4*)(red + kg * 128 + 4 * vq) = o;
    __syncthreads();
    if (tid < 128) { float t = 0.f;
#pragma unroll
        for (int k2 = 0; k2 < 16; ++k2) t += red[k2 * 128 + tid];
        ov[tid] = t; }
    __syncthreads();
    if (wave == 0) { const float a = ov[lane], b2 = ov[lane + 64]; const float ss = wave_sum(a * a + b2 * b2); const float rs = 1.f / sqrtf(ss * (1.f / 128.f) + EPS);
        const size_t idx = row * HGW + h * 128;
        A.OHG[idx + lane] = (bf16_t)f2bf(a * rs * A.hgn[lane] * siluf_(bf2f(A.HGT[idx + lane])));
        A.OHG[idx + lane + 64] = (bf16_t)f2bf(b2 * rs * A.hgn[lane + 64] * siluf_(bf2f(A.HGT[idx + lane + 64]))); }
}

constexpr int D_SC = 0;
constexpr int D_LUT = D_SC + 4 * 1024 * 4;
constexpr int D_RED = D_LUT + 4 * 132 * 4;
constexpr int D_MISC = D_RED + 32 * 256 * 4;
constexpr int D_OUT = D_MISC + 256;
struct DecArgs { const bf16_t* Q; const float *GATES, *rel_table, *cache, *skw, *CKS, *CVS; const int* page_table; float* out; bf16_t* ONSA; };

#define DEC_SCORE_PASS(nkeys, KP, DIST, COPYK) do { \
    _Pragma("nounroll") for (int k0_ = 0; k0_ < (nkeys); k0_ += 128) { f32x4 kv_[4]; \
        _Pragma("unroll") for (int u_ = 0; u_ < 4; ++u_) { const int kk = k0_ + 32 * u_ + ks; if (kk < (nkeys)) kv_[u_] = *(const f32x4*)((KP) + 4 * l16); else kv_[u_] = (f32x4){0.f, 0.f, 0.f, 0.f}; } \
        _Pragma("unroll") for (int u_ = 0; u_ < 4; ++u_) { const int kk = k0_ + 32 * u_ + ks; \
            float d_[4]; _Pragma("unroll") for (int r_ = 0; r_ < 4; ++r_) { const f32x4 p_ = kv_[u_] * qv[r_]; d_[r_] = (p_[0] + p_[1]) + (p_[2] + p_[3]); } \
            _Pragma("unroll") for (int o_ = 1; o_ < 16; o_ <<= 1) { _Pragma("unroll") for (int r_ = 0; r_ < 4; ++r_) d_[r_] += __shfl_xor(d_[r_], o_); } \
            if (kk < (nkeys)) { COPYK; if (l16 < 4) { const int dd_ = (DIST); SC[l16 * 1024 + kk] = d_[l16 == 0 ? 0 : (l16 == 1 ? 1 : (l16 == 2 ? 2 : 3))] + LUT[l16 * 132 + (dd_ > 128 ? 128 : dd_)]; } } } } } while (0)
#define DEC_SOFTMAX(nkeys) do { __syncthreads(); if (wave < 4) { float m_ = -INFINITY; for (int kk = lane; kk < (nkeys); kk += 64) m_ = fmaxf(m_, SC[wave * 1024 + kk]); \
        _Pragma("unroll") for (int o_ = 1; o_ < 64; o_ <<= 1) m_ = fmaxf(m_, __shfl_xor(m_, o_)); float s_ = 0.f; \
        for (int kk = lane; kk < (nkeys); kk += 64) { const float e_ = ex2(SC[wave * 1024 + kk] - m_); SC[wave * 1024 + kk] = e_; s_ += e_; } \
        s_ = wave_sum(s_); if (lane == 0) MISCF[wave] = s_; } __syncthreads(); } while (0)
#define DEC_PV_PASS(nkeys, VP, COPYV, GATE) do { f32x4 oa_[4]; _Pragma("unroll") for (int r_ = 0; r_ < 4; ++r_) oa_[r_] = (f32x4){0.f, 0.f, 0.f, 0.f}; \
    _Pragma("nounroll") for (int k0_ = 0; k0_ < (nkeys); k0_ += 128) { f32x4 vv_[4]; \
        _Pragma("unroll") for (int u_ = 0; u_ < 4; ++u_) { const int kk = k0_ + 32 * u_ + ks; if (kk < (nkeys)) vv_[u_] = *(const f32x4*)((VP) + 4 * l16); else vv_[u_] = (f32x4){0.f, 0.f, 0.f, 0.f}; } \
        _Pragma("unroll") for (int u_ = 0; u_ < 4; ++u_) { const int kk = k0_ + 32 * u_ + ks; if (kk < (nkeys)) { COPYV; _Pragma("unroll") for (int r_ = 0; r_ < 4; ++r_) oa_[r_] += vv_[u_] * SC[r_ * 1024 + kk]; } } } \
    _Pragma("unroll") for (int r_ = 0; r_ < 4; ++r_) *(LAS f32x4*)(RED + (ks * 4 + r_) * 64 + 4 * l16) = oa_[r_]; \
    __syncthreads(); \
    if (tid < 256) { const int r_ = tid >> 6, d_ = tid & 63; float t_ = 0.f; _Pragma("unroll 8") for (int s_ = 0; s_ < 32; ++s_) t_ += RED[(s_ * 4 + r_) * 64 + d_]; \
        const float L_ = MISCF[r_]; OUTB[tid] += (L_ > 0.f ? (GATE) / L_ : 0.f) * t_; } \
    __syncthreads(); } while (0)

DI void decode_unit(const DecArgs& A, LAS unsigned char* lds, int unit, int tid, int lane, int wave) {
    const int bs = unit >> 1, g = unit & 1; const size_t row = (size_t)MP + bs;
    const int l16 = tid & 15, ks = tid >> 4;
    LAS float* SC = (LAS float*)(lds + D_SC); LAS float* LUT = (LAS float*)(lds + D_LUT); LAS float* RED = (LAS float*)(lds + D_RED);
    LAS float* MISCF = (LAS float*)(lds + D_MISC); LAS int* SELB = (LAS int*)(lds + D_MISC + 64); LAS float* OUTB = (LAS float*)(lds + D_OUT);
    __syncthreads();
    build_lut(LUT, A.rel_table, g, tid);
    f32x4 qv[4];
#pragma unroll
    for (int r = 0; r < 4; ++r) qv[r] = ld_bf4(A.Q + row * NSAW + (4 * g + r) * 64 + 4 * l16);
    float gate0 = 0.f, gate1 = 0.f, gate2 = 0.f;
    if (tid < 256) { const int r = tid >> 6; const float* gp = A.GATES + row * 24 + (4 * g + r) * 3;
        gate0 = gp[0]; gate1 = gp[1]; gate2 = gp[2];
        OUTB[tid] = 0.f; }
    __syncthreads();
    { const float* CK = A.CKS + (size_t)(bs * 2 + g) * 4096; const float* CV = A.CVS + (size_t)(bs * 2 + g) * 4096;
      DEC_SCORE_PASS(64, CK + (size_t)kk * 64, PAST - (32 * kk + 31), (void)0);
      DEC_SOFTMAX(64);
      if (wave == 0) { float imp = 0.f;
          if (lane < 32) {
#pragma unroll
              for (int r = 0; r < 4; ++r) imp += (SC[r * 1024 + 2 * lane] + SC[r * 1024 + 2 * lane + 1]) / MISCF[r]; }
          const bool cand = lane >= 1 && lane <= 30; int cnt = 0;
          for (int j2 = 1; j2 <= 30; ++j2) { const float o2 = __shfl(imp, j2); cnt += (cand && (o2 > imp || (o2 == imp && j2 < lane))) ? 1 : 0; }
          const bool sel = (lane == 0) || (lane == 31) || (cand && cnt < 13);
          const unsigned long long bal = __ballot(sel);
          if (sel) SELB[__builtin_popcountll(bal & ((1ull << lane) - 1ull))] = lane; }
      DEC_PV_PASS(64, CV + (size_t)kk * 64, (void)0, gate0);
    }
    { const int* pt = A.page_table + bs * NPAGES;
      const float* newk = A.out + OFF_KV + (row * 4 + 2) * 128 + g * 64; const float* newv = A.out + OFF_KV + (row * 4 + 3) * 128 + g * 64;
#define SEL_T(kk) (64 * SELB[(kk) >> 6] + ((kk) & 63))
#define SEL_ROW(kk) (A.cache + ((size_t)pt[SEL_T(kk) >> 7] * PAGE + (SEL_T(kk) & 127)) * 512)
      DEC_SCORE_PASS(961, ((kk) < 960 ? SEL_ROW(kk) + 2 * 128 + g * 64 : newk), ((kk) < 960 ? PAST - SEL_T(kk) : 0), (void)0);
      DEC_SOFTMAX(961);
      DEC_PV_PASS(961, ((kk) < 960 ? SEL_ROW(kk) + 3 * 128 + g * 64 : newv), (void)0, gate1);
#undef SEL_T
#undef SEL_ROW
    }
    { const float* wk = A.skw + (size_t)bs * WIN * 256 + g * 64; float* wo = A.out + OFF_WINS + (size_t)bs * WIN * 256 + g * 64;
      const float* newk = wo + (size_t)(WIN - 1) * 256; const float* newv = newk + 128;
      DEC_SCORE_PASS(513, ((kk) < 512 ? wk + (size_t)(kk) * 256 : newk), (WIN - (kk)), { if (kk >= 1 && kk < 512) *(f32x4*)(wo + (size_t)(kk - 1) * 256 + 4 * l16) = kv_[u_]; });
      DEC_SOFTMAX(513);
      DEC_PV_PASS(513, ((kk) < 512 ? wk + (size_t)(kk) * 256 + 128 : newv), { if (kk >= 1 && kk < 512) *(f32x4*)(wo + (size_t)(kk - 1) * 256 + 128 + 4 * l16) = vv_[u_]; }, gate2);
    }
    if (tid < 256) A.ONSA[row * NSAW + (4 * g) * 64 + tid] = (bf16_t)f2bf(OUTB[tid]);
}

DI void phase_2a(const KParams& P, LAS unsigned char* lds, int vcu, int G, int tid, int lane, int wave) {
    unsigned char* ws = P.ws;
    { CmpArgs A{P.in[2], P.out + OFF_KV, P.page_table, (const bf16_t*)(ws + WS_W1K), (const bf16_t*)(ws + WS_W1V), P.in[14], P.in[16], P.in[12],
                (float*)(ws + WS_CKS), (float*)(ws + WS_CVS), (bf16_t*)(ws + WS_CKP), (bf16_t*)(ws + WS_CVP)};
#ifndef NO_CMP
      for (int item = vcu; item < 2048 + 128; item += G) { __syncthreads(); compress_item(A, lds, item, tid, lane, wave); }
#endif
    }
    __syncthreads();
    { HgArgs A{(const bf16_t*)(ws + WS_HQ), (const bf16_t*)(ws + WS_HI), (const bf16_t*)(ws + WS_HGT), (const float*)(ws + WS_GL), P.in[17],
               (float*)(ws + WS_SLOC), (float*)(ws + WS_GD), (bf16_t*)(ws + WS_OHG), P.out};
#ifndef NO_HG1
      for (int u = vcu; u < 256; u += G) hgrn_unit<false>(A, lds, u, tid, lane, wave);
#endif
    }
    __syncthreads();
    { HsArgs A{P.in[5], (const float*)(ws + WS_GL), P.in[17], (const bf16_t*)(ws + WS_HQ), (const bf16_t*)(ws + WS_HI), (const bf16_t*)(ws + WS_HGT), (bf16_t*)(ws + WS_OHG), P.out};
#ifndef NO_HGS
      for (int u = vcu; u < 512; u += G) hgrn_sample_unit(A, lds, u, tid, lane, wave);
#endif
    }
}
DI void phase_2b(const KParams& P, LAS unsigned char* lds, int vcu, int G, int tid, int lane, int wave) {
    unsigned char* ws = P.ws;
    { AttnArgs A{(const bf16_t*)(ws + WS_Q), (const bf16_t*)(ws + WS_KVB), (const bf16_t*)(ws + WS_CKP), (const bf16_t*)(ws + WS_CVP), (const float*)(ws + WS_GATES), P.in[7], (bf16_t*)(ws + WS_ONSA)};
#ifndef NO_ATT
      for (int pu = vcu; pu < 256; pu += G) { const int b = pu >> 5, g = (pu >> 4) & 1, i0 = pu & 15;
          __syncthreads();
          build_lut((LAS float*)(lds + A_LUT), A.rel_table, g, tid);
          __syncthreads();
          attn_prompt_unit(A, lds, b, g, 31 - i0, tid, lane, wave);
          attn_prompt_unit(A, lds, b, g, i0, tid, lane, wave); }
#endif
    }
    __syncthreads();
    { HgArgs A{(const bf16_t*)(ws + WS_HQ), (const bf16_t*)(ws + WS_HI), (const bf16_t*)(ws + WS_HGT), (const float*)(ws + WS_GL), P.in[17],
               (float*)(ws + WS_SLOC), (float*)(ws + WS_GD), (bf16_t*)(ws + WS_OHG), P.out};
#ifndef NO_HG3
      for (int u = vcu; u < 256; u += G) hgrn_unit<true>(A, lds, u, tid, lane, wave);
#endif
    }
    __syncthreads();
    { DecArgs A{(const bf16_t*)(ws + WS_Q), (const float*)(ws + WS_GATES), P.in[7], P.in[2], P.in[4], (const float*)(ws + WS_CKS), (const float*)(ws + WS_CVS), P.page_table, P.out, (bf16_t*)(ws + WS_ONSA)};
#ifndef NO_DEC
      for (int u = vcu; u < 256; u += G) decode_unit(A, lds, u, tid, lane, wave);
#endif
    }
}

#ifndef MK_SINGLE
#define MK_SINGLE 1
#endif
constexpr int N_PHASES = 9;
__global__ void __launch_bounds__(NTHREADS, 2) hybrid_fwd(KParams P) {
    extern __shared__ __attribute__((aligned(16))) unsigned char lds_raw[];
    LAS unsigned char* lds = (LAS unsigned char*)lds_raw;
    volatile LAS unsigned* MISC = (volatile LAS unsigned*)(lds + MISC_OFF);
    const int tid = threadIdx.x, lane = tid & 63, wave = __builtin_amdgcn_readfirstlane(tid >> 6);
    const int G = gridDim.x, bx = blockIdx.x;
    const int vcu = (G % 8 == 0) ? (bx % 8) * (G / 8) + bx / 8 : bx;
    unsigned char* ws = P.ws;
    if (tid < 64) MISC[tid] = 0u;
    __syncthreads();
    XcdBarrier bar; bar.bar = (unsigned*)(ws + WS_CTL) + CW_BAR; bar.x = 0; bar.st = nullptr;
    const int lo = P.ph_lo, hi = P.ph_hi;
    if (hi - lo > 1) bar = xcd_barrier_post((unsigned*)(ws + WS_CTL) + CW_BAR, MISC + 8);
#define IN(k) (lo <= (k) && (k) < hi)
#define SEAM(k) do { if (IN(k) && IN((k) + 1)) xcd_barrier(bar); } while (0)
    float* out = P.out;
    bf16_t* WIN_ = (bf16_t*)(ws + WS_WIN); bf16_t* WA_ = (bf16_t*)(ws + WS_WA); bf16_t* WB_ = (bf16_t*)(ws + WS_WB); bf16_t* WO_ = (bf16_t*)(ws + WS_WO);
    bf16_t* WG_ = (bf16_t*)(ws + WS_WG); bf16_t* WU_ = (bf16_t*)(ws + WS_WU); bf16_t* WD_ = (bf16_t*)(ws + WS_WD);
    bf16_t* W1K_ = (bf16_t*)(ws + WS_W1K); bf16_t* W1V_ = (bf16_t*)(ws + WS_W1V);
    bf16_t* XN_ = (bf16_t*)(ws + WS_XN); bf16_t* Q_ = (bf16_t*)(ws + WS_Q); bf16_t* KVB_ = (bf16_t*)(ws + WS_KVB);
    bf16_t* HQ_ = (bf16_t*)(ws + WS_HQ); bf16_t* HI_ = (bf16_t*)(ws + WS_HI); bf16_t* HGT_ = (bf16_t*)(ws + WS_HGT);
    float* GL_ = (float*)(ws + WS_GL); bf16_t* MG_ = (bf16_t*)(ws + WS_MG); float* GATES_ = (float*)(ws + WS_GATES);
    bf16_t* CKP_ = (bf16_t*)(ws + WS_CKP); bf16_t* CVP_ = (bf16_t*)(ws + WS_CVP); float* CKS_ = (float*)(ws + WS_CKS); float* CVS_ = (float*)(ws + WS_CVS);
    float* SLOC_ = (float*)(ws + WS_SLOC); float* GD_ = (float*)(ws + WS_GD);
    bf16_t* ONSA_ = (bf16_t*)(ws + WS_ONSA); bf16_t* OHG_ = (bf16_t*)(ws + WS_OHG);
    float* T_ = (float*)(ws + WS_T); bf16_t* MB_ = (bf16_t*)(ws + WS_MB); float* SSQ_ = (float*)(ws + WS_SSQ);
    bf16_t* GB_ = (bf16_t*)(ws + WS_G); bf16_t* HB_ = (bf16_t*)(ws + WS_H);

    if (IN(0)) {
        P0Args a{P.in[10], P.in[18], P.in[19], P.in[20], P.in[22], P.in[23], P.in[26], P.in[13], P.in[15], P.in[0], P.in[1], P.in[9],
                 WIN_, WA_, WB_, WO_, WG_, WU_, WD_, W1K_, W1V_, XN_};
        p0_prologue(a, lds, vcu * NWAVES + wave, G * NWAVES, lane, wave);
    }
    SEAM(0);
    if (IN(1)) {
        pg8::Gemm g{XN_, WIN_, MPAD, NIN, DM}; pg8::StaticOrder S; S.init(MPAD, NIN, G, bx);
        EpiInProj E{Q_, KVB_, HQ_, HI_, HGT_, MG_, GL_, GATES_, out, P.in[11], P.in[12], P.in[8]};
        pg8::gemm_phase<EpiInProj, pg8::StaticOrder, true, true>(lds, g, S, E);
    }
    SEAM(1);
    if (IN(2)) { phase_2a(P, lds, vcu, G, tid, lane, wave); }
    SEAM(2);
    if (IN(3)) { phase_2b(P, lds, vcu, G, tid, lane, wave); }
    SEAM(3);
    if (IN(4)) {
        { pg8::Gemm g{OHG_, WB_, MPAD, DM, HGW}; pg8::StaticOrder S; S.init(MPAD, DM, G, bx); EpiMergeB E{MG_, T_};
          pg8::gemm_phase<EpiMergeB, pg8::StaticOrder, true, true>(lds, g, S, E); }
        { pg8::Gemm g{ONSA_, WA_, MPAD, DM, NSAW}; pg8::StaticOrder S; S.init(MPAD, DM, G, bx); EpiMergeA E{MG_, T_, MB_};
          pg8::gemm_phase<EpiMergeA, pg8::StaticOrder, true, true>(lds, g, S, E); }
    }
    SEAM(4);
    if (IN(5)) {
        pg8::Gemm g{MB_, WO_, MPAD, DM, DM}; pg8::StaticOrder S; S.init(MPAD, DM, G, bx);
        EpiWo E{P.in[0], P.in[1], P.in[21], out + OFF_Y, XN_, SSQ_};
        pg8::gemm_phase<EpiWo, pg8::StaticOrder, true, true>(lds, g, S, E);
    }
    SEAM(5);
    if (IN(6)) {
        pg8::Gemm g{XN_, WG_, MPAD, DFF, DM}; pg8::StaticOrder S; S.init(MPAD, DFF, G, bx);
        EpiGate E{SSQ_, GB_, out, P.in[6]};
        pg8::gemm_phase<EpiGate, pg8::StaticOrder, true, true>(lds, g, S, E);
    }
    SEAM(6);
    if (IN(7)) {
        pg8::Gemm g{XN_, WU_, MPAD, DFF, DM}; pg8::StaticOrder S; S.init(MPAD, DFF, G, bx);
        EpiUp E{SSQ_, GB_, HB_, P.in[6], P.in[24], P.in[25]};
        pg8::gemm_phase<EpiUp, pg8::StaticOrder, true, true>(lds, g, S, E);
    }
    SEAM(7);
    if (IN(8)) {
        pg8::Gemm g{HB_, WD_, MPAD, DM, DFF}; pg8::StaticOrder S; S.init(MPAD, DM, G, bx);
        EpiDown E{out + OFF_Y};
        pg8::gemm_phase<EpiDown, pg8::StaticOrder, true, true>(lds, g, S, E);
    }
#undef IN
#undef SEAM
}

extern "C" void kernel_launch(void* const* d_in, const int* in_sizes, int n_in, void* d_out, int out_size, void* d_ws, size_t ws_size, hipStream_t stream) {
    static int grid = 0;
    if (grid == 0) {
        if (n_in != 27 || (size_t)out_size != OUT_TOTAL || ws_size < WS_END) {
            fprintf(stderr, "kernel_launch: unexpected problem: n_in %d out %d ws %zu (need %zu)\n", n_in, out_size, ws_size, (size_t)WS_END); grid = -1; return; }
        int dev = 0, cus = 0, per_cu = 0;
        if (hipGetDevice(&dev) != hipSuccess || hipDeviceGetAttribute(&cus, hipDeviceAttributeMultiprocessorCount, dev) != hipSuccess) { grid = -1; return; }
        if (hipFuncSetAttribute((const void*)hybrid_fwd, hipFuncAttributeMaxDynamicSharedMemorySize, LDS_BYTES) != hipSuccess) { fprintf(stderr, "kernel_launch: hipFuncSetAttribute failed\n"); grid = -1; return; }
        if (hipOccupancyMaxActiveBlocksPerMultiprocessor(&per_cu, (const void*)hybrid_fwd, NTHREADS, LDS_BYTES) != hipSuccess || per_cu < 1) {
            fprintf(stderr, "kernel_launch: occupancy query reports %d workgroups per CU\n", per_cu); }
        (void)hipGetLastError();
        grid = cus;
    }
    if (grid < 0) return;
    (void)hipMemsetAsync((char*)d_ws + WS_CTL, 0, CTL_ZERO_BYTES, stream);
    KParams p{};
    for (int i = 0; i < 27; ++i) p.in[i] = (const float*)d_in[i];
    p.page_table = (const int*)d_in[3]; p.out = (float*)d_out; p.ws = (unsigned char*)d_ws;
#if MK_SINGLE
    p.ph_lo = 0; p.ph_hi = N_PHASES;
    hipLaunchKernelGGL(hybrid_fwd, dim3(grid), dim3(NTHREADS), LDS_BYTES, stream, p);
#else
    for (int k = 0; k < N_PHASES; ++k) { p.ph_lo = k; p.ph_hi = k + 1; hipLaunchKernelGGL(hybrid_fwd, dim3(grid), dim3(NTHREADS), LDS_BYTES, stream, p); }
#endif
}
```

```cpp
#include <hip/hip_runtime.h>
#include <cstdio>
#include <cstdint>
#include <cmath>
namespace pg8 {
#define PG8_LAS __attribute__((address_space(3)))
typedef unsigned short bf16_t;
typedef short bf16x8 __attribute__((ext_vector_type(8)));
typedef float f32x4 __attribute__((ext_vector_type(4)));
typedef unsigned u32x4 __attribute__((ext_vector_type(4)));
constexpr int BM = 256, BK = 64, HALF = 128, HTB = HALF * BK * 2  , STAGE_BYTES = 8 * HTB, NXCD = 8, WGM = 8;

__host__ __device__ __forceinline__ int lds_byte(int r, int c) { const int st = (r >> 4) * 2 + (c >> 5), rr = r & 15, cc = c & 31, ob = rr * 64 + cc * 2; return st * 1024 + (ob ^ (((ob >> 9) & 1) << 5)); }
__host__ __device__ __forceinline__ void stage_rc(int b, int& R, int& C) { const int st = b / 1024, sb = b % 1024, swz = sb ^ (((sb >> 9) & 1) << 5); R = (st >> 1) * 16 + swz / 64; C = (st & 1) * 32 + (swz % 64) / 2; }
__host__ __device__ __forceinline__ int perm32(int rho) { const int n = rho >> 4, i = rho & 15; return 8 * (i >> 2) + 4 * n + (i & 3); }

struct Unit { int pm, pn; };
struct Gemm { const bf16_t* A; const bf16_t* Bt; int M, N, K; };

struct StaticOrder {
    int nM, nN, nwg, G, c;
    __host__ __device__ void init(int M, int N, int G_, int c_) { nM = M / BM; nN = N / BM; nwg = nM * nN; G = G_; c = c_; }
    __host__ __device__ bool next(int i, Unit& u) const {
        const long L = (long)i * G + c; if (L >= nwg) return false;
        int wgid = (int)L; { const int q = nwg / NXCD, r = nwg % NXCD, xcd = wgid % NXCD, off = wgid / NXCD; wgid = (xcd < r ? xcd * (q + 1) : r * (q + 1) + (xcd - r) * q) + off; }
        const int nig = WGM * nN, gid = wgid / nig, fm = gid * WGM, gsz = (nM - fm) < WGM ? (nM - fm) : WGM;
        u.pm = fm + ((wgid % nig) % gsz); u.pn = (wgid % nig) / gsz; return true;
    }
    __device__ __forceinline__ void a_ready(const Unit&) const {}
    __device__ __forceinline__ void done(const Unit&) const {}
};

template <class Epi, class Sched, bool ALIGN_EPI = false, bool SP2 = false>
__device__ __forceinline__ void gemm_phase(PG8_LAS unsigned char* lds, const Gemm g, const Sched& S, const Epi& E) {
    const int tid = threadIdx.x, wid = __builtin_amdgcn_readfirstlane(tid >> 6), lane = tid & 63, wr = wid >> 2, wc = wid & 3, fr = lane & 15, fq = lane >> 4;
    const int K = g.K, nt = K / BK;
    unsigned voffA[2], voffB[2];
#pragma unroll
    for (int i = 0; i < 2; ++i) { int R, C; stage_rc(tid * 16 + i * 8192, R, C); const int Rb = Epi::PERM ? ((R & ~31) + perm32(R & 31)) : R;
        voffA[i] = (unsigned)(R * K + C) * 2u; voffB[i] = (unsigned)(Rb * K + C) * 2u; }
    const size_t kstep = (size_t)(BK * 2);
    const size_t hstep = (size_t)HALF * K * 2;
    const size_t tstep = 2 * hstep;
    const unsigned ldsw = (unsigned)wid * 1024u;
    const int aoff = lds_byte(wr * 64 + fr, fq * 8), boff = lds_byte(wc * 32 + fr, fq * 8);
#define PG8_SA(b, h) (((b) * 2 + (h)) * HTB)
#define PG8_SB(b, h) ((4 + (b) * 2 + (h)) * HTB)
#define PG8_STAGE(bufoff, gbase, voff) do { _Pragma("unroll") for (int _i = 0; _i < 2; ++_i) \
        __builtin_amdgcn_global_load_lds((const unsigned*)((const char*)(gbase) + (voff)[_i]), (PG8_LAS unsigned*)(lds + (bufoff) + ldsw + _i * 8192), 16, 0, 0); } while (0)
#define PG8_LDA(dst, b, h) do { _Pragma("unroll") for (int m = 0; m < 4; ++m) _Pragma("unroll") for (int k = 0; k < 2; ++k) dst[m][k] = *(const PG8_LAS bf16x8*)(lds + PG8_SA(b, h) + aoff + m * 2048 + k * 1024); } while (0)
#define PG8_LDB(dst, b, h) do { _Pragma("unroll") for (int n = 0; n < 2; ++n) _Pragma("unroll") for (int k = 0; k < 2; ++k) dst[n][k] = *(const PG8_LAS bf16x8*)(lds + PG8_SB(b, h) + boff + n * 2048 + k * 1024); } while (0)
#define PG8_MMA(ai, bj, At, Bt) do { __builtin_amdgcn_s_setprio(1); _Pragma("unroll") for (int m = 0; m < 4; ++m) _Pragma("unroll") for (int n = 0; n < 2; ++n) _Pragma("unroll") for (int k = 0; k < 2; ++k) \
        acc[ai][bj][m][n] = __builtin_amdgcn_mfma_f32_16x16x32_bf16(Bt[n][k], At[m][k], acc[ai][bj][m][n], 0, 0, 0); __builtin_amdgcn_s_setprio(0); } while (0)
#define PG8_WAIT_V(n) asm volatile("s_waitcnt vmcnt(" #n ")" ::: "memory")
#define PG8_WAIT_L(n) asm volatile("s_waitcnt lgkmcnt(" #n ")" ::: "memory")
#define PG8_BAR __builtin_amdgcn_s_barrier()
#define PG8_SCHED __builtin_amdgcn_sched_barrier(0)
    Unit cur, nxt; int ui = 0;
    if (!S.next(0, cur)) return;
    f32x4 acc[2][2][4][2];
#pragma unroll
    for (int a = 0; a < 2; ++a)
#pragma unroll
        for (int b = 0; b < 2; ++b)
#pragma unroll
            for (int m = 0; m < 4; ++m)
#pragma unroll
                for (int n = 0; n < 2; ++n) acc[a][b][m][n] = (f32x4){0.f, 0.f, 0.f, 0.f};
    bf16x8 At[4][2], B0[2][2], B1[2][2];
    const char* cA = (const char*)g.A + (size_t)cur.pm * tstep; const char* cB = (const char*)g.Bt + (size_t)cur.pn * tstep;
    S.a_ready(cur);
    if constexpr (SP2) {
        PG8_STAGE(PG8_SB(0, 0), cB, voffB); PG8_STAGE(PG8_SB(0, 1), cB + hstep, voffB); PG8_STAGE(PG8_SA(0, 0), cA, voffA); PG8_STAGE(PG8_SA(0, 1), cA + hstep, voffA);
        if (wr == 1) PG8_BAR;
        PG8_WAIT_V(2); PG8_BAR;
        PG8_STAGE(PG8_SB(1, 0), cB + kstep, voffB); PG8_STAGE(PG8_SA(1, 0), cA + kstep, voffA); PG8_STAGE(PG8_SB(1, 1), cB + hstep + kstep, voffB);
        PG8_WAIT_V(6); PG8_BAR;
    } else {
        PG8_STAGE(PG8_SB(0, 0), cB, voffB); PG8_STAGE(PG8_SA(0, 0), cA, voffA); PG8_STAGE(PG8_SB(0, 1), cB + hstep, voffB); PG8_STAGE(PG8_SA(0, 1), cA + hstep, voffA);
        if (wr == 1) PG8_BAR;
        PG8_WAIT_V(4); PG8_BAR;
        PG8_STAGE(PG8_SB(1, 0), cB + kstep, voffB); PG8_STAGE(PG8_SA(1, 0), cA + kstep, voffA); PG8_STAGE(PG8_SB(1, 1), cB + hstep + kstep, voffB);
        PG8_WAIT_V(6); PG8_BAR;
    }
    for (;;) {
        const bool has_next = S.next(ui + 1, nxt);
        const char* nA = has_next ? (const char*)g.A + (size_t)nxt.pm * tstep : cA; const char* nB = has_next ? (const char*)g.Bt + (size_t)nxt.pn * tstep : cB;
        for (int t = 0; t < nt; t += 2) {
            const bool last = (t == nt - 2);
            const char* a1 = cA + (size_t)(t + 1) * kstep;
            const char* a2 = last ? nA : cA + (size_t)(t + 2) * kstep; const char* b2 = last ? nB : cB + (size_t)(t + 2) * kstep;
            const char* a3 = a2 + kstep; const char* b3 = b2 + kstep;
            if (last && has_next) S.a_ready(nxt);
            if constexpr (SP2) {
            PG8_LDB(B0, 0, 0); PG8_LDB(B1, 0, 1); PG8_SCHED; PG8_LDA(At, 0, 0); PG8_STAGE(PG8_SA(1, 1), a1 + hstep, voffA);
            PG8_WAIT_V(8); PG8_WAIT_L(0); PG8_BAR; PG8_MMA(0, 0, At, B0); PG8_MMA(0, 1, At, B1); PG8_BAR; PG8_SCHED;
            PG8_LDA(At, 0, 1); PG8_STAGE(PG8_SB(0, 0), b2, voffB); PG8_STAGE(PG8_SB(0, 1), b2 + hstep, voffB); PG8_STAGE(PG8_SA(0, 0), a2, voffA);
            PG8_WAIT_V(8); PG8_WAIT_L(0); PG8_BAR; PG8_MMA(1, 0, At, B0); PG8_MMA(1, 1, At, B1); PG8_BAR; PG8_SCHED;
            PG8_LDB(B0, 1, 0); PG8_LDB(B1, 1, 1); PG8_SCHED; PG8_LDA(At, 1, 0); PG8_STAGE(PG8_SA(0, 1), a2 + hstep, voffA);
            PG8_WAIT_V(8); PG8_WAIT_L(0); PG8_BAR; PG8_MMA(0, 0, At, B0); PG8_MMA(0, 1, At, B1); PG8_BAR; PG8_SCHED;
            PG8_LDA(At, 1, 1); PG8_STAGE(PG8_SB(1, 0), b3, voffB); PG8_STAGE(PG8_SB(1, 1), b3 + hstep, voffB); PG8_STAGE(PG8_SA(1, 0), a3, voffA);
            PG8_WAIT_V(8); PG8_WAIT_L(0); PG8_BAR; PG8_MMA(1, 0, At, B0); PG8_MMA(1, 1, At, B1); PG8_BAR; PG8_SCHED;
            } else {
            PG8_LDB(B0, 0, 0); PG8_SCHED; PG8_LDA(At, 0, 0); PG8_STAGE(PG8_SA(1, 1), a1 + hstep, voffA);
            PG8_WAIT_L(8); PG8_BAR; PG8_WAIT_L(0); PG8_MMA(0, 0, At, B0); PG8_BAR; PG8_SCHED;
            PG8_LDB(B1, 0, 1); PG8_STAGE(PG8_SB(0, 0), b2, voffB);
            PG8_BAR; PG8_WAIT_L(0); PG8_MMA(0, 1, At, B1); PG8_BAR;
            PG8_LDA(At, 0, 1); PG8_STAGE(PG8_SA(0, 0), a2, voffA);
            PG8_BAR; PG8_WAIT_L(0); PG8_MMA(1, 0, At, B0); PG8_BAR; PG8_SCHED;
            PG8_STAGE(PG8_SB(0, 1), b2 + hstep, voffB);
            PG8_WAIT_V(6); PG8_BAR; PG8_MMA(1, 1, At, B1); PG8_BAR;
            PG8_LDB(B0, 1, 0); PG8_SCHED; PG8_LDA(At, 1, 0); PG8_STAGE(PG8_SA(0, 1), a2 + hstep, voffA);
            PG8_WAIT_L(8); PG8_BAR; PG8_WAIT_L(0); PG8_MMA(0, 0, At, B0); PG8_BAR; PG8_SCHED;
            PG8_LDB(B1, 1, 1); PG8_STAGE(PG8_SB(1, 0), b3, voffB);
            PG8_BAR; PG8_WAIT_L(0); PG8_MMA(0, 1, At, B1); PG8_BAR;
            PG8_LDA(At, 1, 1); PG8_STAGE(PG8_SA(1, 0), a3, voffA);
            PG8_BAR; PG8_WAIT_L(0); PG8_MMA(1, 0, At, B0); PG8_BAR; PG8_SCHED;
            PG8_STAGE(PG8_SB(1, 1), b3 + hstep, voffB);
            PG8_WAIT_V(6); PG8_BAR; PG8_MMA(1, 1, At, B1); PG8_BAR;
            }
        }
        if constexpr (ALIGN_EPI) { if (wr == 0) PG8_BAR; }
        if constexpr (!Epi::AFTER_DRAIN) { E(acc, cur, wr, wc, fr, fq); S.done(cur); }
        if (!has_next) break;
#pragma unroll
        for (int a = 0; a < 2; ++a)
#pragma unroll
            for (int b = 0; b < 2; ++b)
#pragma unroll
                for (int m = 0; m < 4; ++m)
#pragma unroll
                    for (int n = 0; n < 2; ++n) acc[a][b][m][n] = (f32x4){0.f, 0.f, 0.f, 0.f};
        cur = nxt; cA = nA; cB = nB; ++ui;
        if constexpr (ALIGN_EPI) { if (wr == 1) PG8_BAR; }
    }
    PG8_WAIT_V(0);
    if constexpr (!ALIGN_EPI) { if (wr == 0) PG8_BAR; }
    PG8_BAR;
    if constexpr (Epi::AFTER_DRAIN) { E.fused(acc, cur, wr, wc, fr, fq, lds, wid, lane); S.done(cur); }
#undef PG8_SA
#undef PG8_SB
#undef PG8_STAGE
#undef PG8_LDA
#undef PG8_LDB
#undef PG8_MMA
#undef PG8_WAIT_V
#undef PG8_WAIT_L
#undef PG8_BAR
#undef PG8_SCHED
}
}
#define GAS __attribute__((address_space(1)))
#define LAS __attribute__((address_space(3)))
typedef unsigned short bf16;
typedef unsigned v4u __attribute__((ext_vector_type(4)));
typedef float f32x4 __attribute__((ext_vector_type(4)));
typedef short bf16x8 __attribute__((ext_vector_type(8)));
typedef GAS unsigned gu32;
typedef GAS unsigned long long gu64;
#define RLX_AGENT __ATOMIC_RELAXED, __HIP_MEMORY_SCOPE_AGENT
#define LDS_WAIT() asm volatile("s_waitcnt lgkmcnt(0)" ::: "memory")
#define VM_WAIT() asm volatile("s_waitcnt vmcnt(0)" ::: "memory")
__device__ __forceinline__ unsigned long long rt() { return __builtin_amdgcn_s_memrealtime(); }
__device__ __forceinline__ unsigned f2bf(float f) { unsigned u = __builtin_bit_cast(unsigned, f); return (u + 0x7fffu + ((u >> 16) & 1u)) >> 16; }
__device__ __forceinline__ unsigned pk2(float lo, float hi) { return f2bf(lo) | (f2bf(hi) << 16); }

#define XB_TMO      128
#define XB_XCNT(j)  (256  + 64 * (j))
#define XB_XSUB(j)  (1280 + 64 * (j))
#define XB_XGEN(j)  (2304 + 64 * (j))
#define XB_TOP      3328
#define XB_TOPGEN   3392
#define XCD_BAR_WORDS 3456
#define XB_SPIN_CAP (1u << 18)

__device__ __forceinline__ unsigned xb_ld(unsigned* p)              { return __hip_atomic_load(p, __ATOMIC_RELAXED, __HIP_MEMORY_SCOPE_AGENT); }
__device__ __forceinline__ unsigned xb_add(unsigned* p, unsigned v) { return __hip_atomic_fetch_add(p, v, __ATOMIC_RELAXED, __HIP_MEMORY_SCOPE_AGENT); }
__device__ __forceinline__ unsigned xb_xcc_id() { return (unsigned)__builtin_amdgcn_s_getreg((3 << 11) | 20) & 0xFu; }
#define XB_SPIN(cond, bar) do { unsigned _sp = 0; while (cond) { __builtin_amdgcn_s_sleep(1); \
    if ((++_sp & 255u) == 0u) { if (xb_ld(&(bar)[XB_TMO])) break; if (_sp > XB_SPIN_CAP) { atomicAdd(&(bar)[XB_TMO], 1u); break; } } } } while (0)

struct XcdBarrier {
    unsigned* bar; unsigned x;
    volatile LAS unsigned* st;
};

__device__ __forceinline__ XcdBarrier xcd_barrier_post(unsigned* bar, volatile LAS unsigned* st) {
    XcdBarrier b; b.bar = bar; b.x = xb_xcc_id(); b.st = st;
    if (threadIdx.x == 0) (void)xb_add(&bar[XB_XCNT(b.x)], 1u);
    return b;
}
__device__ __forceinline__ void xcd_barrier_complete(unsigned* bar, unsigned x, unsigned& nloc, unsigned& nx) {
    const unsigned G = gridDim.x * gridDim.y * gridDim.z;
    unsigned sum, cnt, mine, sp = 0u;
    for (;;) {
        sum = 0u; cnt = 0u; mine = 0u;
#pragma unroll
        for (unsigned j = 0; j < 16; ++j) { const unsigned c = xb_ld(&bar[XB_XCNT(j)]); sum += c; cnt += (c > 0u) ? 1u : 0u; mine = (j == x) ? c : mine; }
        if (sum == G) break;
        __builtin_amdgcn_s_sleep(1);
        if ((++sp & 255u) == 0u) { if (xb_ld(&bar[XB_TMO])) break; if (sp > XB_SPIN_CAP) { atomicAdd(&bar[XB_TMO], 1u); break; } }
    }
    nloc = mine > 0u ? mine : 1u; nx = cnt > 0u ? cnt : 1u;
}

__device__ __forceinline__ void xcd_barrier(const XcdBarrier& b) {
    asm volatile("s_waitcnt vmcnt(0)" ::: "memory");
    __syncthreads();
    if (threadIdx.x == 0) {
        unsigned* bar = b.bar;
        __builtin_amdgcn_s_waitcnt(0);
        unsigned nloc = b.st[0], nx = b.st[1];
        if (nloc == 0u) { xcd_barrier_complete(bar, b.x, nloc, nx); b.st[0] = nloc; b.st[1] = nx; }
        const unsigned old = xb_add(&bar[XB_XSUB(b.x)], 1u);
        const unsigned gen = old / nloc;
        if (old + 1u == (gen + 1u) * nloc) {
            __builtin_amdgcn_fence(__ATOMIC_RELEASE, "agent");
            asm volatile("s_waitcnt vmcnt(0)" ::: "memory");
            const unsigned og = xb_add(&bar[XB_TOP], 1u);
            const unsigned tg = og / nx;
            if (og + 1u == (tg + 1u) * nx) xb_add(&bar[XB_TOPGEN], 1u);
            else XB_SPIN(xb_ld(&bar[XB_TOPGEN]) == tg, bar);
            __builtin_amdgcn_fence(__ATOMIC_ACQUIRE, "agent");
            xb_add(&bar[XB_XGEN(b.x)], 1u);
            asm volatile("s_waitcnt vmcnt(0)" ::: "memory");
        } else {
            XB_SPIN(xb_ld(&bar[XB_XGEN(b.x)]) == gen, bar);
            __builtin_amdgcn_fence(__ATOMIC_ACQUIRE, "agent");
            asm volatile("s_waitcnt vmcnt(0)" ::: "memory");
        }
    }
    __syncthreads();
}

constexpr int NWAVES = 8, NTHREADS = 512;
constexpr int DM = 1024, BATCH_P = 8, SEQ = 2048, MP = BATCH_P * SEQ  , BS = 128  ;
constexpr int MROWS = MP + BS  , MPAD = 16640  ;
constexpr int NH = 8, NG = 2, NR = 4, HD = 64, NSAW = 512, KVW = 128;
constexpr int HGH = 4, HGD = 128, HGW = 512;
constexpr int DFF = 2816, CIN = 5400, NIN = 5632  ;
constexpr int PAST = 2048, PAGE = 128, NPAGES = 16, WIN = 512;
constexpr float EPS = 1e-6f, LOG2E = 1.4426950408889634f;
constexpr float QSCALE = 0.125f * LOG2E;
constexpr float HG_SCALE = 0.08838834764831845f;

constexpr size_t OFF_Y = 0, OFF_KV = 16908288, OFF_WINP = 25362432, OFF_WINS = 26411008, OFF_HGP = 43188224, OFF_HGS = 43712512,
                 OFF_CVP = 52101120, OFF_CVS = 52146176, OUT_TOTAL = 52867072;

typedef unsigned short bf16_t;
typedef short bf16x8 __attribute__((ext_vector_type(8)));
typedef short s16x4 __attribute__((ext_vector_type(4)));
typedef float f32x4 __attribute__((ext_vector_type(4)));
typedef float f32x2 __attribute__((ext_vector_type(2)));
typedef float f32x16 __attribute__((ext_vector_type(16)));
typedef unsigned u32x4 __attribute__((ext_vector_type(4)));
typedef unsigned u32x2 __attribute__((ext_vector_type(2)));
#define DI __device__ __forceinline__

typedef __bf16 hw_bf16x2 __attribute__((ext_vector_type(2)));
DI unsigned pkbf(float lo, float hi) { const f32x2 v = {lo, hi}; return __builtin_bit_cast(unsigned, __builtin_convertvector(v, hw_bf16x2)); }
#define pk2 pkbf
DI float bf2f(unsigned short b) { return __builtin_bit_cast(float, (unsigned)b << 16); }
DI float bflo(unsigned w) { return __builtin_bit_cast(float, w << 16); }
DI float bfhi(unsigned w) { return __builtin_bit_cast(float, w & 0xffff0000u); }
DI float sigmoidf_(float x) { return __builtin_amdgcn_rcpf(1.f + __expf(-x)); }
DI float siluf_(float x) { return x * __builtin_amdgcn_rcpf(1.f + __expf(-x)); }
template <int CTRL> DI float dppf(float x) { return __int_as_float(__builtin_amdgcn_update_dpp(0, __float_as_int(x), CTRL, 0xf, 0xf, true)); }
template <int CTRL> DI unsigned dppu(unsigned x) { return (unsigned)__builtin_amdgcn_update_dpp(0, (int)x, CTRL, 0xf, 0xf, true); }
DI float row16_sum(float s) { s += dppf<0xB1>(s); s += dppf<0x4E>(s); s += dppf<0x141>(s); s += dppf<0x140>(s); return s; }
DI float row16_max(float s) { s = fmaxf(s, dppf<0xB1>(s)); s = fmaxf(s, dppf<0x4E>(s)); s = fmaxf(s, dppf<0x141>(s)); s = fmaxf(s, dppf<0x140>(s)); return s; }
DI float x16_sum(float v) { auto rr = __builtin_amdgcn_permlane16_swap(__float_as_uint(v), __float_as_uint(v), false, false); return __uint_as_float(rr[0]) + __uint_as_float(rr[1]); }
DI float x32_sum(float v) { auto rr = __builtin_amdgcn_permlane32_swap(__float_as_uint(v), __float_as_uint(v), false, false); return __uint_as_float(rr[0]) + __uint_as_float(rr[1]); }
DI float x16_max(float v) { auto rr = __builtin_amdgcn_permlane16_swap(__float_as_uint(v), __float_as_uint(v), false, false); return fmaxf(__uint_as_float(rr[0]), __uint_as_float(rr[1])); }
DI float x32_max(float v) { auto rr = __builtin_amdgcn_permlane32_swap(__float_as_uint(v), __float_as_uint(v), false, false); return fmaxf(__uint_as_float(rr[0]), __uint_as_float(rr[1])); }
DI unsigned row16_or(unsigned t) { t |= dppu<0xB1>(t); t |= dppu<0x4E>(t); t |= dppu<0x141>(t); t |= dppu<0x140>(t); return t; }
DI unsigned x16_or(unsigned v) { auto rr = __builtin_amdgcn_permlane16_swap(v, v, false, false); return rr[0] | rr[1]; }
DI float wave_sum(float v) { return x32_sum(x16_sum(row16_sum(v))); }
DI float wave_max(float v) { return x32_max(x16_max(row16_max(v))); }
DI bf16x8 pack8(const float* v) { u32x4 p; p.x = pk2(v[0], v[1]); p.y = pk2(v[2], v[3]); p.z = pk2(v[4], v[5]); p.w = pk2(v[6], v[7]); return __builtin_bit_cast(bf16x8, p); }
DI bf16x8 pack8v(f32x4 a, f32x4 b) { u32x4 p; p.x = pk2(a[0], a[1]); p.y = pk2(a[2], a[3]); p.z = pk2(b[0], b[1]); p.w = pk2(b[2], b[3]); return __builtin_bit_cast(bf16x8, p); }
#define MFMA16(a, b, c) __builtin_amdgcn_mfma_f32_16x16x32_bf16((a), (b), (c), 0, 0, 0)
#define MFMA32(a, b, c) __builtin_amdgcn_mfma_f32_32x32x16_bf16((a), (b), (c), 0, 0, 0)
#define LAS __attribute__((address_space(3)))
typedef short v4i16_t __attribute__((ext_vector_type(4)));
DI s16x4 tr_read(const LAS void* p) { return __builtin_bit_cast(s16x4, __builtin_amdgcn_ds_read_tr16_b64_v4i16((LAS v4i16_t*)p)); }
DI bf16x8 cat44(s16x4 lo, s16x4 hi) { return __builtin_shufflevector(lo, hi, 0, 1, 2, 3, 4, 5, 6, 7); }

constexpr size_t MiB = 1u << 20;
constexpr size_t WS_CTL = 0, CTL_ZERO_BYTES = 1 * MiB;
constexpr size_t WS_WIN = 2 * MiB;
constexpr size_t WS_WA = 14 * MiB, WS_WB = 15 * MiB;
constexpr size_t WS_WO = 16 * MiB;
constexpr size_t WS_WG = 18 * MiB, WS_WU = 24 * MiB, WS_WD = 30 * MiB;
constexpr size_t WS_W1K = 36 * MiB, WS_W1V = 37 * MiB;
constexpr size_t WS_XN = 40 * MiB;
constexpr size_t WS_Q = 76 * MiB;
constexpr size_t WS_KVB = 94 * MiB;
constexpr size_t WS_HQ = 112 * MiB, WS_HI = 130 * MiB, WS_HGT = 148 * MiB;
constexpr size_t WS_GL = 166 * MiB;
constexpr size_t WS_MG = 200 * MiB;
constexpr size_t WS_GATES = 266 * MiB;
constexpr size_t WS_CKP = 268 * MiB, WS_CVP = 269 * MiB;
constexpr size_t WS_CKS = 270 * MiB, WS_CVS = 275 * MiB;
constexpr size_t WS_SLOC = 280 * MiB;
constexpr size_t WS_GD = 297 * MiB;
constexpr size_t WS_ONSA = 298 * MiB, WS_OHG = 316 * MiB;
constexpr size_t WS_T = 334 * MiB;
constexpr size_t WS_MB = 400 * MiB;
constexpr size_t WS_SSQ = 434 * MiB;
constexpr size_t WS_G = 436 * MiB;
constexpr size_t WS_H = 527 * MiB;
constexpr size_t WS_END = 618 * MiB;
constexpr int CW_BAR = 4096;

constexpr int RING_BYTES = 131072;
constexpr int LDS_BYTES = 147456;
constexpr int MISC_OFF = LDS_BYTES - 256;

struct KParams {
    const float* in[27];
    const int* page_table;
    float* out;
    unsigned char* ws;
    int ph_lo, ph_hi;
    int rep, pad_;
};

#ifndef MK_REP_BIT
#define MK_REP_BIT (-1)
#endif
#define MK_REP 0
#define REP_LOOP(k) _Pragma("nounroll") for (int rp_ = 0; rp_ < (((k) == MK_REP_BIT) ? 2 : 1); ++rp_)

DI void p0_transpose_item(const float* W, int K, int N, bf16_t* WT, int prow0, int src_col0, int nvalid, int k0, LAS float* scr, int lane, const float* kscale = nullptr) {
    float tv[32];
#pragma unroll
    for (int i = 0; i < 32; ++i) { const int kk = 2 * i + (lane >> 5), c = lane & 31; tv[i] = (c < nvalid) ? W[(size_t)(k0 + kk) * N + src_col0 + c] : 0.f; }
#pragma unroll
    for (int i = 0; i < 32; ++i) { const int kk = 2 * i + (lane >> 5), c = lane & 31; scr[kk * 33 + c] = kscale ? tv[i] * kscale[k0 + kk] : tv[i]; }
    asm volatile("s_waitcnt lgkmcnt(0)" ::: "memory");
    const int c = lane & 7;
#pragma unroll
    for (int j = 0; j < 4; ++j) { const int n = (lane >> 3) + 8 * j; const LAS float* s = scr + (8 * c) * 33 + n;
        u32x4 o; o.x = pk2(s[0 * 33], s[1 * 33]); o.y = pk2(s[2 * 33], s[3 * 33]); o.z = pk2(s[4 * 33], s[5 * 33]); o.w = pk2(s[6 * 33], s[7 * 33]);
        *(u32x4*)(WT + (size_t)(prow0 + n) * K + k0 + 8 * c) = o; }
    asm volatile("s_waitcnt lgkmcnt(0)" ::: "memory");
}
DI void inproj_src(int p0, int& src, int& nvalid) {
    const int pn = p0 >> 8, within = p0 & 255, bj = within >> 7, wc = (within >> 5) & 3;
    nvalid = 32;
    if (pn < 5) src = 64 * (4 * pn + wc) + 32 * bj;
    else if (pn < 21) src = p0 + 24;
    else { src = 1280; nvalid = (within < 32) ? 24 : 0; }
}
DI void rms_row_to_bf16(const float* xrow, const float* g, bf16_t* orow, int lane) {
    const f32x4* xr = (const f32x4*)xrow + lane; const f32x4* gr = (const f32x4*)g + lane;
    f32x4 v[4]; float s = 0.f;
#pragma unroll
    for (int j = 0; j < 4; ++j) { v[j] = xr[64 * j]; s += (v[j].x * v[j].x + v[j].y * v[j].y) + (v[j].z * v[j].z + v[j].w * v[j].w); }
    const float rs = 1.f / sqrtf(wave_sum(s) * (1.f / DM) + EPS);
    unsigned long long* o8 = (unsigned long long*)orow + lane;
#pragma unroll
    for (int j = 0; j < 4; ++j) { const f32x4 gg = gr[64 * j];
        o8[64 * j] = (unsigned long long)pk2(v[j].x * rs * gg.x, v[j].y * rs * gg.y) | ((unsigned long long)pk2(v[j].z * rs * gg.z, v[j].w * rs * gg.w) << 32); }
}
DI void rms_2rows_to_bf16(const float* xa, const float* xb, const float* g, bf16_t* oa, bf16_t* ob, int lane) {
    const f32x4* pa = (const f32x4*)xa + lane; const f32x4* pb = (const f32x4*)xb + lane; const f32x4* gr = (const f32x4*)g + lane;
    f32x4 va[4], vb[4], gg[4]; float sa = 0.f, sb = 0.f;
#pragma unroll
    for (int j = 0; j < 4; ++j) { va[j] = pa[64 * j]; vb[j] = pb[64 * j]; gg[j] = gr[64 * j]; }
#pragma unroll
    for (int j = 0; j < 4; ++j) { sa += (va[j].x * va[j].x + va[j].y * va[j].y) + (va[j].z * va[j].z + va[j].w * va[j].w); sb += (vb[j].x * vb[j].x + vb[j].y * vb[j].y) + (vb[j].z * vb[j].z + vb[j].w * vb[j].w); }
    const float ra = 1.f / sqrtf(wave_sum(sa) * (1.f / DM) + EPS), rb = 1.f / sqrtf(wave_sum(sb) * (1.f / DM) + EPS);
    unsigned long long* o8a = (unsigned long long*)oa + lane; unsigned long long* o8b = (unsigned long long*)ob + lane;
#pragma unroll
    for (int j = 0; j < 4; ++j) {
        o8a[64 * j] = (unsigned long long)pk2(va[j].x * ra * gg[j].x, va[j].y * ra * gg[j].y) | ((unsigned long long)pk2(va[j].z * ra * gg[j].z, va[j].w * ra * gg[j].w) << 32);
        o8b[64 * j] = (unsigned long long)pk2(vb[j].x * rb * gg[j].x, vb[j].y * rb * gg[j].y) | ((unsigned long long)pk2(vb[j].z * rb * gg[j].z, vb[j].w * rb * gg[j].w) << 32); }
}
struct P0Args {
    const float *w_in, *w_a, *w_b, *w_o, *w_g, *w_u, *w_d, *w1k, *w1v, *xp, *xs, *g1, *g2;
    bf16_t *WIN, *WA, *WB, *WO, *WG, *WU, *WD, *W1K, *W1V, *XN;
};
DI void p0_prologue(const P0Args& a, LAS unsigned char* lds, int gw, int NGW, int lane, int wave) {
    LAS float* scr = (LAS float*)(lds + wave * 16384);
    constexpr int I_IN = 16 * (NIN / 32), I_A = 8 * 32, I_O = 16 * 32, I_G = 16 * (DFF / 32), I_D = (DFF / 64) * 32, I_W1 = 32 * 2;
    constexpr int NITEMS = I_IN + 2 * I_A + I_O + 2 * I_G + I_D + 2 * I_W1;
    for (int it = gw; it < NITEMS; it += NGW) {
        int r = it;
        if (r < I_IN) { const int nb = NIN / 32, kb = r / nb, pb = r % nb; int src, nv; inproj_src(pb * 32, src, nv);
            p0_transpose_item(a.w_in, DM, CIN, a.WIN, pb * 32, src, nv, kb * 64, scr, lane); continue; } r -= I_IN;
        if (r < I_A) { const int kb = r / 32, pb = r % 32; p0_transpose_item(a.w_a, NSAW, DM, a.WA, pb * 32, pb * 32, 32, kb * 64, scr, lane); continue; } r -= I_A;
        if (r < I_A) { const int kb = r / 32, pb = r % 32; p0_transpose_item(a.w_b, HGW, DM, a.WB, pb * 32, pb * 32, 32, kb * 64, scr, lane); continue; } r -= I_A;
        if (r < I_O) { const int kb = r / 32, pb = r % 32; p0_transpose_item(a.w_o, DM, DM, a.WO, pb * 32, pb * 32, 32, kb * 64, scr, lane); continue; } r -= I_O;
        if (r < 2 * I_G) { const int nb = 2 * DFF / 32, kb = r / nb, pb = r % nb, pn = pb >> 3, w = pb & 7;
            p0_transpose_item(w < 4 ? a.w_g : a.w_u, DM, DFF, a.WG, pb * 32, 128 * pn + 32 * (w & 3), 32, kb * 64, scr, lane, a.g2); continue; } r -= 2 * I_G;
        if (r < I_D) { const int kb = r / 32, pb = r % 32; p0_transpose_item(a.w_d, DFF, DM, a.WD, pb * 32, pb * 32, 32, kb * 64, scr, lane); continue; } r -= I_D;
        if (r < I_W1) { const int kb = r / 2, pb = r % 2; p0_transpose_item(a.w1k, 2048, 64, a.W1K, pb * 32, pb * 32, 32, kb * 64, scr, lane); continue; } r -= I_W1;
        { const int kb = r / 2, pb = r % 2; p0_transpose_item(a.w1v, 2048, 64, a.W1V, pb * 32, pb * 32, 32, kb * 64, scr, lane); }
    }
    for (int m = gw; m < MROWS; m += 2 * NGW) {
        const int m2 = m + NGW; const bool two = m2 < MROWS;
        const float* xr = (m < MP) ? a.xp + (size_t)m * DM : a.xs + (size_t)(m - MP) * DM;
        const float* xr2 = two ? ((m2 < MP) ? a.xp + (size_t)m2 * DM : a.xs + (size_t)(m2 - MP) * DM) : xr;
        rms_2rows_to_bf16(xr, xr2, a.g1, a.XN + (size_t)m * DM, a.XN + (size_t)(two ? m2 : m) * DM, lane);
    }
}

typedef const f32x4 (&AccRef)[2][2][4][2];
DI void st_bf4(bf16_t* p, f32x4 v) { u32x2 w; w.x = pk2(v[0], v[1]); w.y = pk2(v[2], v[3]); *(u32x2*)p = w; }
DI f32x4 ld_bf4(const bf16_t* p) { const u32x2 w = *(const u32x2*)p; return (f32x4){bflo(w.x), bfhi(w.x), bflo(w.y), bfhi(w.y)}; }
DI f32x4 sig4(f32x4 v) { return (f32x4){sigmoidf_(v[0]), sigmoidf_(v[1]), sigmoidf_(v[2]), sigmoidf_(v[3])}; }

DI void st_bf8(bf16_t* p, f32x4 a, f32x4 b) { u32x4 w; w.x = pk2(a[0], a[1]); w.y = pk2(a[2], a[3]); w.z = pk2(b[0], b[1]); w.w = pk2(b[2], b[3]); *(u32x4*)p = w; }
struct EpiInProj {
    static constexpr bool PERM = true, AFTER_DRAIN = false;
    bf16_t *Q, *KVB, *HQ, *HI, *HGT, *MG; float *GL, *GATES, *out; const float *qg, *kg, *lbl;
    DI void operator()(AccRef acc, const pg8::Unit& u, int wr, int wc, int fr, int fq) const {
        const int pn = u.pn, rbase = u.pm * 256 + wr * 64 + fr;
        if (pn < 5) {
            const int hu = 4 * pn + wc;
            const int uu0 = hu - 8, slot0 = uu0 >> 1;
            const float* gsrc = (hu < 8) ? qg : kg + (slot0 == 2 ? 64 : 128);
            f32x4 gn4[2][2];
#pragma unroll
            for (int bj = 0; bj < 2; ++bj)
#pragma unroll
                for (int n = 0; n < 2; ++n) gn4[bj][n] = *(const f32x4*)(gsrc + 32 * bj + 8 * fq + 4 * n);
#pragma unroll
            for (int ai = 0; ai < 2; ++ai)
#pragma unroll
                for (int m = 0; m < 4; ++m) {
                    const int row = rbase + ai * 128 + m * 16;
                    float ss = 0.f;
#pragma unroll
                    for (int bj = 0; bj < 2; ++bj)
#pragma unroll
                        for (int n = 0; n < 2; ++n) { const f32x4 x = acc[ai][bj][m][n]; ss += (x[0] * x[0] + x[1] * x[1]) + (x[2] * x[2] + x[3] * x[3]); }
                    ss = x32_sum(x16_sum(ss));
                    if (row >= MROWS) continue;
                    const float rs = __builtin_amdgcn_rsqf(ss * (1.f / 64.f) + EPS);
                    if (hu < 8) {
#pragma unroll
                        for (int bj = 0; bj < 2; ++bj) st_bf8(Q + (size_t)row * NSAW + hu * 64 + 32 * bj + 8 * fq, acc[ai][bj][m][0] * gn4[bj][0] * (rs * QSCALE), acc[ai][bj][m][1] * gn4[bj][1] * (rs * QSCALE));
                    } else {
                        const int uu = hu - 8, slot = uu >> 1, g = uu & 1; const bool normed = (slot == 2 || slot == 4);
                        float* fdst;
                        if (slot < 4) fdst = out + OFF_KV + ((size_t)row * 4 + slot) * 128 + g * 64;
                        else if (row < MP) { const int b = row >> 11, t = row & 2047; fdst = (t >= SEQ - WIN) ? out + OFF_WINP + (((size_t)b * WIN + (t - (SEQ - WIN))) * 2 + (slot - 4)) * 128 + g * 64 : nullptr; }
                        else fdst = out + OFF_WINS + (((size_t)(row - MP) * WIN + (WIN - 1)) * 2 + (slot - 4)) * 128 + g * 64;
#pragma unroll
                        for (int bj = 0; bj < 2; ++bj) { const int d = 32 * bj + 8 * fq; f32x4 v0 = acc[ai][bj][m][0], v1 = acc[ai][bj][m][1];
                            if (normed) { v0 = v0 * gn4[bj][0] * rs; v1 = v1 * gn4[bj][1] * rs; }
                            if (fdst) { *(f32x4*)(fdst + d) = v0; *(f32x4*)(fdst + d + 4) = v1; }
                            if (slot >= 2) st_bf8(KVB + (size_t)row * 512 + (slot - 2) * 128 + g * 64 + d, v0, v1); }
                    }
                }
        } else if (pn < 21) {
            const int kind = (pn < 13) ? ((pn - 5) >> 1) : 4, cb = (pn < 13) ? 256 * ((pn - 5) & 1) : 256 * (pn - 13);
            f32x4 lb4[2][2];
            if (kind == 1) {
#pragma unroll
                for (int bj = 0; bj < 2; ++bj)
#pragma unroll
                    for (int n = 0; n < 2; ++n) { const int c = cb + 128 * bj + 32 * wc + 8 * fq + 4 * n; const f32x4 l0 = *(const f32x4*)(lbl + c), l1 = *(const f32x4*)(lbl + HGW + c);
#pragma unroll
                        for (int j = 0; j < 4; ++j) lb4[bj][n][j] = __builtin_amdgcn_rcpf(1.f + __expf(l1[j] - l0[j])); }
            }
#pragma unroll
            for (int ai = 0; ai < 2; ++ai)
#pragma unroll
                for (int m = 0; m < 4; ++m) {
                    const int row = rbase + ai * 128 + m * 16;
                    if (row >= MROWS) continue;
#pragma unroll
                    for (int bj = 0; bj < 2; ++bj) { const int c = cb + 128 * bj + 32 * wc + 8 * fq; const f32x4 x0 = acc[ai][bj][m][0], x1 = acc[ai][bj][m][1];
                        if (kind == 0) st_bf8(HQ + (size_t)row * HGW + c, x0 * HG_SCALE, x1 * HG_SCALE);
                        else if (kind == 1) { f32x4 o0, o1;
#pragma unroll
                            for (int j = 0; j < 4; ++j) { const float la = lb4[bj][0][j], lb = lb4[bj][1][j];
                                o0[j] = __logf(la + (1.f - la) * __builtin_amdgcn_rcpf(1.f + __expf(-x0[j]))); o1[j] = __logf(lb + (1.f - lb) * __builtin_amdgcn_rcpf(1.f + __expf(-x1[j]))); }
                            *(f32x4*)(GL + (size_t)row * HGW + c) = o0; *(f32x4*)(GL + (size_t)row * HGW + c + 4) = o1; }
                        else if (kind == 2) st_bf8(HI + (size_t)row * HGW + c, x0, x1);
                        else if (kind == 3) st_bf8(HGT + (size_t)row * HGW + c, x0, x1);
                        else st_bf8(MG + (size_t)row * 2048 + c, x0, x1); }
                }
        } else {
            if (wc == 0 && fq < 3) {
#pragma unroll
                for (int ai = 0; ai < 2; ++ai)
#pragma unroll
                    for (int m = 0; m < 4; ++m) {
                        const int row = rbase + ai * 128 + m * 16;
                        if (row >= MROWS) continue;
                        *(f32x4*)(GATES + (size_t)row * 24 + 8 * fq) = sig4(acc[ai][0][m][0]);
                        *(f32x4*)(GATES + (size_t)row * 24 + 8 * fq + 4) = sig4(acc[ai][0][m][1]);
                    }
            }
        }
    }
};

DI void bf8_to_f32(u32x4 w, f32x4& a, f32x4& b) { a = (f32x4){bflo(w.x), bfhi(w.x), bflo(w.y), bfhi(w.y)}; b = (f32x4){bflo(w.z), bfhi(w.z), bflo(w.w), bfhi(w.w)}; }
struct EpiMergeB {
    static constexpr bool PERM = true, AFTER_DRAIN = false;
    const bf16_t* MG; bf16_t* T;
    DI void operator()(AccRef acc, const pg8::Unit& u, int wr, int wc, int fr, int fq) const {
        const int rbase = u.pm * 256 + wr * 64 + fr, cbase = u.pn * 256 + 32 * wc + 8 * fq;
        u32x4 gv[2][4][2];
#pragma unroll
        for (int ai = 0; ai < 2; ++ai)
#pragma unroll
            for (int m = 0; m < 4; ++m)
#pragma unroll
                for (int bj = 0; bj < 2; ++bj) gv[ai][m][bj] = *(const u32x4*)(MG + (size_t)(rbase + ai * 128 + m * 16) * 2048 + DM + cbase + 128 * bj);
#pragma unroll
        for (int ai = 0; ai < 2; ++ai)
#pragma unroll
            for (int m = 0; m < 4; ++m)
#pragma unroll
                for (int bj = 0; bj < 2; ++bj) { f32x4 g0, g1; bf8_to_f32(gv[ai][m][bj], g0, g1);
                    st_bf8(T + (size_t)(rbase + ai * 128 + m * 16) * DM + cbase + 128 * bj, sig4(g0) * acc[ai][bj][m][0], sig4(g1) * acc[ai][bj][m][1]); }
    }
};
struct EpiMergeA {
    static constexpr bool PERM = true, AFTER_DRAIN = false;
    const bf16_t* MG; const bf16_t* T; bf16_t* MB;
    DI void operator()(AccRef acc, const pg8::Unit& u, int wr, int wc, int fr, int fq) const {
        const int rbase = u.pm * 256 + wr * 64 + fr, cbase = u.pn * 256 + 32 * wc + 8 * fq;
#pragma unroll
        for (int ai = 0; ai < 2; ++ai) {
            u32x4 gv[4][2], tv[4][2];
#pragma unroll
            for (int m = 0; m < 4; ++m)
#pragma unroll
                for (int bj = 0; bj < 2; ++bj) { const size_t row = rbase + ai * 128 + m * 16; const int c = cbase + 128 * bj;
                    gv[m][bj] = *(const u32x4*)(MG + row * 2048 + c); tv[m][bj] = *(const u32x4*)(T + row * DM + c); }
#pragma unroll
            for (int m = 0; m < 4; ++m)
#pragma unroll
                for (int bj = 0; bj < 2; ++bj) { f32x4 g0, g1, t0, t1; bf8_to_f32(gv[m][bj], g0, g1); bf8_to_f32(tv[m][bj], t0, t1);
                    st_bf8(MB + (size_t)(rbase + ai * 128 + m * 16) * DM + cbase + 128 * bj, sig4(g0) * acc[ai][bj][m][0] + t0, sig4(g1) * acc[ai][bj][m][1] + t1); }
        }
    }
};
struct EpiWo {
    static constexpr bool PERM = true, AFTER_DRAIN = false;
    const float *xp, *xs; bf16_t* X1B; float* SSQ;
    DI void operator()(AccRef acc, const pg8::Unit& u, int wr, int wc, int fr, int fq) const {
        const int rbase = u.pm * 256 + wr * 64 + fr, cbase = u.pn * 256 + 32 * wc + 8 * fq;
#pragma unroll
        for (int ai = 0; ai < 2; ++ai) {
            f32x4 xv[4][2][2];
#pragma unroll
            for (int m = 0; m < 4; ++m)
#pragma unroll
                for (int bj = 0; bj < 2; ++bj)
#pragma unroll
                    for (int n = 0; n < 2; ++n) xv[m][bj][n] = *(const f32x4*)(xp + (size_t)(rbase + ai * 128 + m * 16) * DM + cbase + 128 * bj + 4 * n);
#pragma unroll
            for (int m = 0; m < 4; ++m) { const size_t row = rbase + ai * 128 + m * 16; float ss = 0.f;
#pragma unroll
                for (int bj = 0; bj < 2; ++bj) { const int c = cbase + 128 * bj; const f32x4 v0 = xv[m][bj][0] + acc[ai][bj][m][0], v1 = xv[m][bj][1] + acc[ai][bj][m][1];
                    ss += ((v0[0] * v0[0] + v0[1] * v0[1]) + (v0[2] * v0[2] + v0[3] * v0[3])) + ((v1[0] * v1[0] + v1[1] * v1[1]) + (v1[2] * v1[2] + v1[3] * v1[3]));
                    st_bf8(X1B + row * DM + c, v0, v1); }
                ss = x32_sum(x16_sum(ss));
                if (fq == 0) SSQ[row * 16 + u.pn * 4 + wc] = ss; }
        }
    }
};
constexpr size_t RSTD_OFF = 458752;
constexpr size_t SSQS_OFF = 393216;
DI float row_rstd(const float* SSQ, int row) {
    if (row < MP) {
        const f32x4* p = (const f32x4*)(SSQ + (size_t)row * 16); const f32x4 a = p[0], b = p[1], c = p[2], d = p[3];
        const float s = ((a[0] + a[1]) + (a[2] + a[3])) + ((b[0] + b[1]) + (b[2] + b[3])) + ((c[0] + c[1]) + (c[2] + c[3])) + ((d[0] + d[1]) + (d[2] + d[3]));
        return 1.f / sqrtf(s * (1.f / DM) + EPS);
    }
    const f32x4* p = (const f32x4*)(SSQ + SSQS_OFF + (size_t)(row - MP) * 64); float s = 0.f;
#pragma unroll 4
    for (int i = 0; i < 16; ++i) { const f32x4 a = p[i]; s += (a[0] + a[1]) + (a[2] + a[3]); }
    return 1.f / sqrtf(s * (1.f / DM) + EPS);
}
DI f32x4 dpp_prev(f32x4 prev, f32x4 cur, int which) {
    const int fr = threadIdx.x & 15;
    f32x4 o;
#pragma unroll
    for (int j = 0; j < 4; ++j) { const float push = (fr > 15 - which) ? prev[j] : cur[j];
        const int pi = __builtin_bit_cast(int, push);
        const int r = (which == 1) ? __builtin_amdgcn_update_dpp(pi, pi, 0x121, 0xf, 0xf, false) : __builtin_amdgcn_update_dpp(pi, pi, 0x122, 0xf, 0xf, false);
        o[j] = __builtin_bit_cast(float, r); }
    return o;
}
constexpr int EX_OFF = RING_BYTES;
DI int halo_index(int pm) { return 2 * (pm - 1 - (pm >> 3)); }
struct EpiGU {
    static constexpr bool PERM = true, AFTER_DRAIN = false;
    const float* SSQ; const float* HALO; bf16_t* H; float* out; const float *state_conv, *cw, *cb; LAS unsigned char* lds;
    DI void operator()(AccRef acc, const pg8::Unit& u, int wr, int wc, int fr, int fq) const {
        const int rbase = u.pm * 256 + wr * 64 + fr, cl = 32 * wc + 8 * fq, cbase = u.pn * 128 + cl;
        LAS float* EX = (LAS float*)(lds + EX_OFF);
        float rs[8];
#pragma unroll
        for (int q = 0; q < 8; ++q) { const int row = rbase + (q >> 2) * 128 + (q & 3) * 16; rs[q] = (row < MROWS) ? SSQ[RSTD_OFF + row] : 0.f; }
        if (fr >= 14) {
#pragma unroll
            for (int ai = 0; ai < 2; ++ai)
#pragma unroll
                for (int n = 0; n < 2; ++n) *(LAS f32x4*)(EX + ((ai * 2 + wr) * 2 + (fr - 14)) * 128 + cl + 4 * n) = acc[ai][0][3][n] * rs[ai * 4 + 3];
        }
        asm volatile("s_waitcnt lgkmcnt(0)" ::: "memory"); __builtin_amdgcn_s_barrier(); asm volatile("" ::: "memory");
        if (u.pm < 64) {
            f32x4 hal[2];
#pragma unroll
            for (int n = 0; n < 2; ++n) hal[n] = (fr >= 14 && wr == 0 && (u.pm & 7) != 0) ? *(const f32x4*)(HALO + (size_t)(halo_index(u.pm) + (fr - 14)) * DFF + cbase + 4 * n) : (f32x4){0.f, 0.f, 0.f, 0.f};
            f32x4 cc[2][4];
#pragma unroll
            for (int n = 0; n < 2; ++n) { const int c = cbase + 4 * n; cc[n][0] = *(const f32x4*)(cb + c); cc[n][1] = *(const f32x4*)(cw + c); cc[n][2] = *(const f32x4*)(cw + DFF + c); cc[n][3] = *(const f32x4*)(cw + 2 * DFF + c); }
#pragma unroll
            for (int ai = 0; ai < 2; ++ai) {
                f32x4 prev[2];
#pragma unroll
                for (int n = 0; n < 2; ++n) { f32x4 pbv = (f32x4){0.f, 0.f, 0.f, 0.f};
                    if (fr >= 14) {
                        if (wr == 1) pbv = *(const LAS f32x4*)(EX + ((ai * 2 + 0) * 2 + (fr - 14)) * 128 + cl + 4 * n);
                        else if (ai == 1) pbv = *(const LAS f32x4*)(EX + ((0 * 2 + 1) * 2 + (fr - 14)) * 128 + cl + 4 * n);
                        else pbv = hal[n];
                    }
                    prev[n] = pbv; }
#pragma unroll
                for (int m = 0; m < 4; ++m) { const int row = rbase + ai * 128 + m * 16; const float r1 = rs[ai * 4 + m]; const int t = row & 2047;
                    f32x4 hv[2];
#pragma unroll
                    for (int n = 0; n < 2; ++n) {
                        const f32x4 g0 = acc[ai][0][m][n] * r1, g1 = dpp_prev(prev[n], g0, 1), g2 = dpp_prev(prev[n], g0, 2);
                        const f32x4 cv = cc[n][0] + cc[n][1] * g2 + cc[n][2] * g1 + cc[n][3] * g0;
                        const f32x4 up = acc[ai][1][m][n] * r1;
                        hv[n] = (f32x4){siluf_(cv[0]) * up[0], siluf_(cv[1]) * up[1], siluf_(cv[2]) * up[2], siluf_(cv[3]) * up[3]};
                        if (t >= SEQ - 2) *(f32x4*)(out + OFF_CVP + ((size_t)(row >> 11) * 2 + (t - (SEQ - 2))) * DFF + cbase + 4 * n) = g0;
                        prev[n] = g0; }
                    st_bf8(H + (size_t)row * DFF + cbase, hv[0], hv[1]); }
            }
        } else {
#pragma unroll
            for (int m = 0; m < 4; ++m) { const int row = rbase + m * 16; if (row >= MROWS) continue;
                const float r1 = rs[m]; const int bs = row - MP;
                f32x4 hv[2];
#pragma unroll
                for (int n = 0; n < 2; ++n) { const int c = cbase + 4 * n;
                    const f32x4 g0 = acc[0][0][m][n] * r1;
                    const f32x4 g1 = *(const f32x4*)(state_conv + ((size_t)bs * 2 + 1) * DFF + c), g2 = *(const f32x4*)(state_conv + ((size_t)bs * 2) * DFF + c);
                    const f32x4 cv = *(const f32x4*)(cb + c) + *(const f32x4*)(cw + c) * g2 + *(const f32x4*)(cw + DFF + c) * g1 + *(const f32x4*)(cw + 2 * DFF + c) * g0;
                    const f32x4 up = acc[0][1][m][n] * r1;
                    hv[n] = (f32x4){siluf_(cv[0]) * up[0], siluf_(cv[1]) * up[1], siluf_(cv[2]) * up[2], siluf_(cv[3]) * up[3]};
                    *(f32x4*)(out + OFF_CVS + ((size_t)bs * 2 + 1) * DFF + c) = g0;
                    *(f32x4*)(out + OFF_CVS + ((size_t)bs * 2) * DFF + c) = g1; }
                st_bf8(H + (size_t)row * DFF + cbase, hv[0], hv[1]); }
        }
    }
};
struct EpiDown {
    static constexpr bool PERM = true, AFTER_DRAIN = false;
    const bf16_t* X1; float* Y;
    DI void operator()(AccRef acc, const pg8::Unit& u, int wr, int wc, int fr, int fq) const {
        const int rbase = u.pm * 256 + wr * 64 + fr, cbase = u.pn * 256 + 32 * wc + 8 * fq;
        u32x4 xv[2][4][2];
#pragma unroll
        for (int ai = 0; ai < 2; ++ai)
#pragma unroll
            for (int m = 0; m < 4; ++m)
#pragma unroll
                for (int bj = 0; bj < 2; ++bj) xv[ai][m][bj] = *(const u32x4*)(X1 + (size_t)(rbase + ai * 128 + m * 16) * DM + cbase + 128 * bj);
#pragma unroll
        for (int ai = 0; ai < 2; ++ai)
#pragma unroll
            for (int m = 0; m < 4; ++m)
#pragma unroll
                for (int bj = 0; bj < 2; ++bj) { f32x4 x0, x1; bf8_to_f32(xv[ai][m][bj], x0, x1); float* yp = Y + (size_t)(rbase + ai * 128 + m * 16) * DM + cbase + 128 * bj;
                    *(f32x4*)yp = x0 + acc[ai][bj][m][0]; *(f32x4*)(yp + 4) = x1 + acc[ai][bj][m][1]; }
    }
};

#ifdef MK_EXTRA_PHASE
struct EpiNull {
    static constexpr bool PERM = false, AFTER_DRAIN = false;
    float* sink;
    DI void operator()(AccRef acc, const pg8::Unit& u, int wr, int wc, int fr, int fq) const {
        f32x4 t = (f32x4){0.f, 0.f, 0.f, 0.f};
#pragma unroll
        for (int ai = 0; ai < 2; ++ai)
#pragma unroll
            for (int bj = 0; bj < 2; ++bj)
#pragma unroll
                for (int m = 0; m < 4; ++m)
#pragma unroll
                    for (int n = 0; n < 2; ++n) t += acc[ai][bj][m][n];
        if (t[0] == 1234.5f) sink[0] = t[1] + t[2] + t[3];
    }
};
#endif

template <int NP, class F>
DI void skinny_gemm(const bf16_t* A0, const bf16_t* B0, int K0, const bf16_t* A1, const bf16_t* B1, int K1, LAS unsigned char* lds, int cu, int G, int lane, int wave, F epi) {
    const int ts = wave >> 2, kq = wave & 3, l15 = lane & 15, gq = lane >> 4;
    LAS f32x4* red = (LAS f32x4*)lds;
    for (int t0 = 2 * cu; t0 < 512; t0 += 2 * G) {
        const int t = t0 + ts, rt = t & 7, ct = t >> 3;
        f32x4 acc[2] = {(f32x4){0.f, 0.f, 0.f, 0.f}, (f32x4){0.f, 0.f, 0.f, 0.f}};
#pragma unroll
        for (int p = 0; p < NP; ++p) {
            const bf16_t* A = p ? A1 : A0; const bf16_t* B = p ? B1 : B0; const int K = p ? K1 : K0;
            const bf16_t* ap = A + (size_t)(16 * rt + l15) * K + (size_t)kq * (K / 4) + 8 * gq;
            const bf16_t* bp = B + (size_t)(16 * ct + l15) * K + (size_t)kq * (K / 4) + 8 * gq;
            const int nsteps = K / 128;
            for (int s0 = 0; s0 < nsteps; s0 += 8) {
                bf16x8 af[8], bfv[8];
#pragma unroll
                for (int s = 0; s < 8; ++s) if (s0 + s < nsteps) { af[s] = *(const bf16x8*)(ap + (s0 + s) * 32); bfv[s] = *(const bf16x8*)(bp + (s0 + s) * 32); }
#pragma unroll
                for (int s = 0; s < 8; ++s) if (s0 + s < nsteps) acc[p] = MFMA16(af[s], bfv[s], acc[p]);
            }
        }
        __syncthreads();
#pragma unroll
        for (int p = 0; p < NP; ++p) red[(p * 8 + wave) * 64 + lane] = acc[p];
        __syncthreads();
        if (kq == 0) {
#pragma unroll
            for (int p = 0; p < NP; ++p) { acc[p] = (red[(p * 8 + wave) * 64 + lane] + red[(p * 8 + wave + 1) * 64 + lane]) + (red[(p * 8 + wave + 2) * 64 + lane] + red[(p * 8 + wave + 3) * 64 + lane]); }
            epi(16 * rt + 4 * gq, 16 * ct + l15, ct, acc[0], acc[1]);
        }
    }
}

struct SkMerge { const bf16_t* MG; bf16_t* MB;
    DI void operator()(int r0, int col, int ct, const f32x4& ab, const f32x4& aa) const {
#pragma unroll
        for (int r = 0; r < 4; ++r) { const size_t row = (size_t)MP + r0 + r;
            const float ga = bf2f(MG[row * 2048 + col]), gb = bf2f(MG[row * 2048 + DM + col]);
            MB[row * DM + col] = (bf16_t)f2bf(sigmoidf_(ga) * aa[r] + sigmoidf_(gb) * ab[r]); } } };
struct SkWo { const float* xs; bf16_t* X1B; float* SSQS;
    DI void operator()(int r0, int col, int ct, const f32x4& a0, const f32x4&) const {
#pragma unroll
        for (int r = 0; r < 4; ++r) { const int rs_ = r0 + r; const size_t row = (size_t)MP + rs_;
            const float x1 = xs[(size_t)rs_ * DM + col] + a0[r];
            X1B[row * DM + col] = (bf16_t)f2bf(x1);
            float ss = row16_sum(x1 * x1);
            if ((col & 15) == 0) SSQS[(size_t)rs_ * 64 + ct] = ss; } } };
struct SkDown { const bf16_t* X1; float* Y;
    DI void operator()(int r0, int col, int ct, const f32x4& a0, const f32x4&) const {
#pragma unroll
        for (int r = 0; r < 4; ++r) { const size_t row = (size_t)MP + r0 + r; Y[row * DM + col] = bf2f(X1[row * DM + col]) + a0[r]; } } };

DI int halo_row(int h) { const int idx = h >> 1; return 256 * (idx + 1 + idx / 7) - 2 + (h & 1); }
DI void halo_gemm(const bf16_t* X1G, const bf16_t* WGU, const float* SSQ, float* HALO, LAS unsigned char* lds, int cu, int G, int lane, int wave) {
    const int ts = wave >> 2, kq = wave & 3, l15 = lane & 15, gq = lane >> 4;
    LAS f32x4* red = (LAS f32x4*)lds;
    constexpr int NT = 7 * 176;
    for (int t0 = 2 * cu; t0 < NT; t0 += 2 * G) {
        const int t = t0 + ts; const bool live = t < NT; const int tt = live ? t : 0, rt = tt % 7, ct = tt / 7;
        const int c0 = 16 * ct, prow = 256 * (c0 >> 7) + (c0 & 127);
        const bf16_t* ap = X1G + (size_t)halo_row(16 * rt + l15) * DM + kq * 256 + 8 * gq;
        const bf16_t* bp = WGU + (size_t)(prow + l15) * DM + kq * 256 + 8 * gq;
        bf16x8 af[8], bfv[8];
#pragma unroll
        for (int s2 = 0; s2 < 8; ++s2) { af[s2] = *(const bf16x8*)(ap + s2 * 32); bfv[s2] = *(const bf16x8*)(bp + s2 * 32); }
        f32x4 acc = (f32x4){0.f, 0.f, 0.f, 0.f};
#pragma unroll
        for (int s2 = 0; s2 < 8; ++s2) acc = MFMA16(af[s2], bfv[s2], acc);
        __syncthreads();
        red[wave * 64 + lane] = acc;
        __syncthreads();
        if (kq == 0 && live) {
            acc = (red[wave * 64 + lane] + red[(wave + 1) * 64 + lane]) + (red[(wave + 2) * 64 + lane] + red[(wave + 3) * 64 + lane]);
#pragma unroll
            for (int r = 0; r < 4; ++r) { const int h = 16 * rt + 4 * gq + r; HALO[(size_t)h * DFF + c0 + l15] = acc[r] * row_rstd(SSQ, halo_row(h)); }
        }
    }
}

DI int crow(int reg, int hi) { return (reg & 3) + 8 * (reg >> 2) + 4 * hi; }
constexpr int A_KT = 0, A_KSTR = 144, A_KBYTES = 64 * A_KSTR;
constexpr int A_VT = 2 * A_KBYTES, A_VSTR = 192, A_VBYTES = 64 * A_VSTR;
constexpr int A_LUT = A_VT + 2 * A_VBYTES;
constexpr int A_IMP = A_LUT + 4 * 132 * 4;
constexpr int A_TOT = A_IMP + 4 * 64 * 33 * 4;
constexpr int A_SELM = A_TOT + 64 * 33 * 4;
constexpr int A_WS = A_SELM + 512;
constexpr int A_OACC = A_WS + 8 * 64 * 4;
constexpr int A_GB = A_OACC + 8 * 32 * 64 * 2;
constexpr int A_CSH = A_GB + 768 * 4;
constexpr int A_END = A_CSH + 64;
static_assert(A_END <= RING_BYTES, "attention LDS");

DI float swap_max(float v) { auto rr = __builtin_amdgcn_permlane32_swap(__float_as_uint(v), __float_as_uint(v), false, false); return fmaxf(__uint_as_float(rr[0]), __uint_as_float(rr[1])); }
DI float swap_sum(float v) { auto rr = __builtin_amdgcn_permlane32_swap(__float_as_uint(v), __float_as_uint(v), false, false); return __uint_as_float(rr[0]) + __uint_as_float(rr[1]); }

DI float score_bound(const float* qg, const float* kg, const float* rel_table, int lane) {
    float a = fabsf(qg[lane]), b = fmaxf(fmaxf(fabsf(kg[lane]), fabsf(kg[64 + lane])), fabsf(kg[128 + lane]));
    float c = fmaxf(fmaxf(fabsf(rel_table[lane]), fabsf(rel_table[64 + lane])), fmaxf(fabsf(rel_table[128 + lane]), fabsf(rel_table[192 + lane])));
#pragma unroll
    for (int o = 1; o < 64; o <<= 1) { a = fmaxf(a, __shfl_xor(a, o)); b = fmaxf(b, __shfl_xor(b, o)); c = fmaxf(c, __shfl_xor(c, o)); }
    return 64.f * QSCALE * a * b + c * LOG2E + 0.5f;
}
DI void build_lut(LAS float* lut, const float* rel_table, int g, int tid, float shift = 0.f) {
    for (int e = tid; e < 4 * 129; e += NTHREADS) { const int r = e / 129, dd = e % 129;
        int bk; if (dd < 16) bk = dd; else { bk = 16 + (int)(logf((float)dd / 16.f) / 2.0794415416798357f * 16.f); bk = bk > 31 ? 31 : bk; }
        lut[r * 132 + dd] = rel_table[bk * NH + 4 * g + r] * LOG2E - shift; }
}

struct AttnCtx {
    LAS unsigned char* lds; int tid, lane, wave, r32, hi, r, qh;
    bf16x8 qr[4];
    f32x16 o[2], ls;
};
DI void tile_fetch(const bf16_t* Ksrc, const bf16_t* Vsrc, int stride, int tid, u32x4& kreg, u32x4& vreg) {
    asm volatile("" : "+v"(tid));
    const int key = tid >> 3, ch = tid & 7;
    kreg = *(const u32x4*)(Ksrc + (size_t)key * stride + ch * 8); vreg = *(const u32x4*)(Vsrc + (size_t)key * stride + ch * 8);
}
DI void tile_store(LAS unsigned char* lds, int buf, int tid, const u32x4& kreg, const u32x4& vreg) {
    asm volatile("" : "+v"(tid));
    const int key = tid >> 3, ch = tid & 7;
    static_assert(A_KSTR == 144 && A_VSTR == 192, "row strides as shifts");
    *(LAS u32x4*)(lds + A_KT + buf * A_KBYTES + ((key << 7) + (key << 4)) + ch * 16) = kreg;
    *(LAS u32x4*)(lds + A_VT + buf * A_VBYTES + ((key << 7) + (key << 6)) + ch * 16) = vreg;
}
DI void qk_tile(const AttnCtx& c, int buf, f32x16& p0, f32x16& p1) {
    const LAS unsigned char* kb = c.lds + A_KT + buf * A_KBYTES + c.r32 * A_KSTR + c.hi * 16;
    bf16x8 a0[4], a1[4];
#pragma unroll
    for (int d0 = 0; d0 < 4; ++d0) { a0[d0] = *(const LAS bf16x8*)(kb + d0 * 32); a1[d0] = *(const LAS bf16x8*)(kb + 32 * A_KSTR + d0 * 32); }
    __builtin_amdgcn_sched_barrier(0);
#pragma unroll
    for (int k = 0; k < 16; ++k) { p0[k] = 0.f; p1[k] = 0.f; }
#pragma unroll
    for (int d0 = 0; d0 < 4; ++d0) p0 = MFMA32(a0[d0], c.qr[d0], p0);
#pragma unroll
    for (int d0 = 0; d0 < 4; ++d0) p1 = MFMA32(a1[d0], c.qr[d0], p1);
}
DI void half_pv(AttnCtx& c, const LAS unsigned char* vb, f32x16& e, float bias) {
    bf16x8 vf[2][2];
#pragma unroll
    for (int ks = 0; ks < 2; ++ks)
#pragma unroll
        for (int d0 = 0; d0 < 2; ++d0) { const LAS unsigned char* vp = vb + (16 * ks) * A_VSTR + d0 * 64; vf[ks][d0] = cat44(tr_read(vp), tr_read(vp + 8 * A_VSTR)); }
#pragma unroll
    for (int k = 0; k < 16; k += 2) { const f32x2 t = (f32x2){e[k], e[k + 1]} + (f32x2){bias, bias}; e[k] = __builtin_amdgcn_exp2f(t[0]); e[k + 1] = __builtin_amdgcn_exp2f(t[1]); }
    const bf16x8 ones = {0x3f80, 0x3f80, 0x3f80, 0x3f80, 0x3f80, 0x3f80, 0x3f80, 0x3f80};
#pragma unroll
    for (int ks = 0; ks < 2; ++ks) { u32x4 w;
#pragma unroll
        for (int j = 0; j < 4; ++j) w[j] = pkbf(e[8 * ks + 2 * j], e[8 * ks + 2 * j + 1]);
        const bf16x8 pa = __builtin_bit_cast(bf16x8, w);
        c.o[0] = MFMA32(pa, vf[ks][0], c.o[0]); c.o[1] = MFMA32(pa, vf[ks][1], c.o[1]); c.ls = MFMA32(pa, ones, c.ls); }
}
DI void pv_halves(AttnCtx& c, int buf, f32x16& s0, f32x16& s1, float bias) {
    const int q = (c.lane & 15) >> 2, p = c.lane & 3, blk = (c.lane >> 4) & 1;
    const LAS unsigned char* vb = c.lds + A_VT + buf * A_VBYTES + (4 * c.hi + q) * A_VSTR + (16 * blk + 4 * p) * 2;
    half_pv(c, vb, s0, bias);
    half_pv(c, vb + 32 * A_VSTR, s1, bias);
}
DI void softmax_pv(AttnCtx& c, int buf, f32x16& s0, f32x16& s1) { pv_halves(c, buf, s0, s1, 0.f); }
DI void softmax_pv_far(AttnCtx& c, int buf, f32x16& s0, f32x16& s1, float bias) { pv_halves(c, buf, s0, s1, bias); }
template <bool FIRST>
DI void branch_finish(AttnCtx& c, int br) {
    int gofs = ((c.r * 64 + 32 * c.qh + 4 * c.hi) * 3 + br); asm volatile("" : "+v"(gofs));
    const LAS float* gb = (const LAS float*)(c.lds + A_GB) + gofs;
    int sofs = c.wave * 2048 + c.r32 + 256 * c.hi; asm volatile("" : "+v"(sofs));
    LAS bf16_t* oa = (LAS bf16_t*)(c.lds + A_OACC) + sofs;
#pragma unroll
    for (int k = 0; k < 16; ++k) { const float l = c.ls[k]; const float a = l > 0.f ? gb[crow(k, 0) * 3] * __builtin_amdgcn_rcpf(l) : 0.f;
#pragma unroll
        for (int d0 = 0; d0 < 2; ++d0) { LAS bf16_t* p = oa + crow(k, 0) * 64 + 32 * d0; float v = c.o[d0][k] * a; if (!FIRST) v += bf2f(*p); *p = (bf16_t)f2bf(v); } }
#pragma unroll
    for (int k = 0; k < 16; ++k) { c.o[0][k] = 0.f; c.o[1][k] = 0.f; c.ls[k] = 0.f; }
}

struct AttnArgs { const bf16_t *Q, *KVB, *CKP, *CVP; const float *GATES, *rel_table; bf16_t* ONSA; };

DI void attn_prompt_unit(const AttnArgs& A, LAS unsigned char* lds, int b, int g, int i, int tid, int lane, int wave) {
    AttnCtx c; c.lds = lds; c.tid = tid; c.lane = lane; c.wave = wave; c.r32 = lane & 31; c.hi = lane >> 5; c.r = wave >> 1; c.qh = wave & 1;
    const int u = 32 * c.qh + c.r32, h = 4 * g + c.r;
    const size_t qrow = (size_t)b * SEQ + 64 * i + u;
    LAS float* lut = (LAS float*)(lds + A_LUT) + c.r * 132;
    LAS float* IMP = (LAS float*)(lds + A_IMP); LAS float* TOT = (LAS float*)(lds + A_TOT); LAS unsigned* SELM = (LAS unsigned*)(lds + A_SELM);
#pragma unroll
    for (int d0 = 0; d0 < 4; ++d0) c.qr[d0] = *(const bf16x8*)(A.Q + qrow * NSAW + h * 64 + 16 * d0 + 8 * c.hi);
#pragma unroll
    for (int k = 0; k < 16; ++k) { c.o[0][k] = 0.f; c.o[1][k] = 0.f; c.ls[k] = 0.f; }
    u32x4 kreg, vreg;
    const float bias_far = lut[128];

    tile_fetch(A.CKP + (size_t)(b * 2 + g) * 4096, A.CVP + (size_t)(b * 2 + g) * 4096, 64, tid, kreg, vreg);
    __syncthreads();
    for (int e = tid; e < 768; e += NTHREADS) { const int r2 = e / 192, rem = e % 192, q2 = rem / 3, br = rem % 3;
        ((LAS float*)(lds + A_GB))[e] = A.GATES[((size_t)b * SEQ + 64 * i + q2) * 24 + (4 * g + r2) * 3 + br]; }
    tile_store(lds, 0, tid, kreg, vreg);
    __syncthreads();
    {
        f32x16 s0, s1; qk_tile(c, 0, s0, s1);
        int qb = 64 * i + u - 31 - 128 * c.hi; asm volatile("" : "+v"(qb));
        float b0[16], b1[16];
#pragma unroll
        for (int k = 0; k < 16; ++k) { const int d0 = qb - 32 * crow(k, 0), d1 = d0 - 1024;
            b0[k] = lut[min(max(d0, 0), 128)]; b1[k] = lut[min(max(d1, 0), 128)]; }
#pragma unroll
        for (int k = 0; k < 16; ++k) { const int d0 = qb - 32 * crow(k, 0), d1 = d0 - 1024;
            s0[k] = d0 >= 0 ? s0[k] + b0[k] : -INFINITY; s1[k] = d1 >= 0 ? s1[k] + b1[k] : -INFINITY; }
        softmax_pv(c, 0, s0, s1);
        float lsum = 0.f;
#pragma unroll
        for (int k = 0; k < 16; ++k) lsum += s0[k] + s1[k];
        const float lt = swap_sum(lsum), inv = lt > 0.f ? __builtin_amdgcn_rcpf(lt) : 0.f;
        int iofs = (c.r * 64 + u) * 33 + 2 * c.hi; asm volatile("" : "+v"(iofs));
#pragma unroll
        for (int k = 0; k < 16; k += 2) {
            IMP[iofs + (crow(k, 0) >> 1)] = (s0[k] + s0[k + 1]) * inv;
            IMP[iofs + 16 + (crow(k, 0) >> 1)] = (s1[k] + s1[k + 1]) * inv;
        }
        branch_finish<true>(c, 0);
    }
    __syncthreads();
    {
        int tq = tid; asm volatile("" : "+v"(tq));
        const int uq = tq >> 3, sub = tq & 7;
        unsigned mbits = 0u;
        if (i < 16) { mbits = (i >= 31) ? 0xffffffffu : ((1u << (i + 1)) - 1u); }
        else {
#pragma unroll
            for (int jj = 0; jj < 4; ++jj) { const int j = sub * 4 + jj;
                TOT[uq * 33 + j] = (IMP[(0 * 64 + uq) * 33 + j] + IMP[(1 * 64 + uq) * 33 + j]) + (IMP[(2 * 64 + uq) * 33 + j] + IMP[(3 * 64 + uq) * 33 + j]); }
        }
        __syncthreads();
        if (i >= 16) {
            const int ntop = 16 - 3;
            float mine[4]; int cnt[4];
#pragma unroll
            for (int jj = 0; jj < 4; ++jj) { mine[jj] = TOT[uq * 33 + sub * 4 + jj]; cnt[jj] = 0; }
            for (int j2 = 1; j2 < i - 1; ++j2) { const float o2 = TOT[uq * 33 + j2];
#pragma unroll
                for (int jj = 0; jj < 4; ++jj) cnt[jj] += (o2 > mine[jj] || (o2 == mine[jj] && j2 < sub * 4 + jj)) ? 1 : 0; }
#pragma unroll
            for (int jj = 0; jj < 4; ++jj) { const int j = sub * 4 + jj;
                if (j > i) continue;
                if (j == 0 || j >= i - 1) { mbits |= 1u << j; continue; }
                if (cnt[jj] < ntop) mbits |= 1u << j; }
            mbits |= dppu<0xB1>(mbits); mbits |= dppu<0x4E>(mbits); mbits |= dppu<0x141>(mbits);
        }
        if (sub == 0) SELM[uq] = mbits;
    }
    __syncthreads();
    const unsigned selm = SELM[u];
    unsigned umask = selm;
    { const unsigned t = x16_or(row16_or(selm)); if (c.r32 == 0 && c.hi == 0 && c.r == 0) SELM[64 + c.qh] = t; }
    __syncthreads();
    umask = SELM[64] | SELM[65];
    umask = __builtin_amdgcn_readfirstlane(umask);
    __syncthreads();

    {
        const bf16_t* Kb = A.KVB + (size_t)b * SEQ * 512 + 0 * 128 + g * 64; const bf16_t* Vb = Kb + 128;
        unsigned rem = umask & ((i >= 31) ? 0xffffffffu : ((1u << (i + 1)) - 1u));
        int j = __builtin_ctz(rem); rem &= rem - 1u;
        tile_fetch(Kb + (size_t)64 * j * 512, Vb + (size_t)64 * j * 512, 512, tid, kreg, vreg);
        int buf = 0;
#define SEL_STEP(KR, VR) { \
            tile_store(lds, buf, tid, KR, VR); \
            __syncthreads(); \
            const int jn = rem ? __builtin_ctz(rem) : -1; if (rem) rem &= rem - 1u; \
            if (jn >= 0) tile_fetch(Kb + (size_t)64 * jn * 512, Vb + (size_t)64 * jn * 512, 512, tid, KR, VR); \
            { \
                f32x16 s0, s1; qk_tile(c, buf, s0, s1); \
                const bool sel = (selm >> j) & 1u; \
                float bv = sel ? bias_far : -INFINITY;        \
                if (i - j < 3) { \
                    asm volatile("" ::: "memory");     \
                    int dbase = 64 * (i - j) + u - 4 * c.hi; asm volatile("" : "+v"(dbase)); \
                    float b0[16], b1[16]; \
                    _Pragma("unroll") for (int k = 0; k < 16; ++k) { const int d0 = dbase - crow(k, 0), d1 = d0 - 32; b0[k] = lut[min(max(d0, 0), 128)]; b1[k] = lut[min(max(d1, 0), 128)]; } \
                    _Pragma("unroll") for (int k = 0; k < 16; ++k) { const int d0 = dbase - crow(k, 0), d1 = d0 - 32; \
                        s0[k] = (sel && d0 >= 0) ? s0[k] + b0[k] : -INFINITY; s1[k] = (sel && d1 >= 0) ? s1[k] + b1[k] : -INFINITY; } \
                    bv = 0.f; \
                } \
                pv_halves(c, buf, s0, s1, bv);                \
            } \
            if (jn < 0) break; \
            j = jn; buf ^= 1; }
        for (;;) { SEL_STEP(kreg, vreg) }
#undef SEL_STEP
        branch_finish<false>(c, 1);
    }
    __syncthreads();
    {
        const bf16_t* Kb = A.KVB + (size_t)b * SEQ * 512 + 2 * 128 + g * 64; const bf16_t* Vb = Kb + 128;
        int j = i - 8 < 0 ? 0 : i - 8;
        tile_fetch(Kb + (size_t)64 * j * 512, Vb + (size_t)64 * j * 512, 512, tid, kreg, vreg);
        int buf = 0;
#define WIN_STEP(KR, VR) { \
            tile_store(lds, buf, tid, KR, VR); \
            __syncthreads(); \
            if (j + 1 <= i) tile_fetch(Kb + (size_t)64 * (j + 1) * 512, Vb + (size_t)64 * (j + 1) * 512, 512, tid, KR, VR); \
            { \
                f32x16 s0, s1; qk_tile(c, buf, s0, s1); \
                float bv = bias_far; \
                if (!(i - j >= 3 && i - j < 8)) { \
                    asm volatile("" ::: "memory");     \
                    int dbase = 64 * (i - j) + u - 4 * c.hi; asm volatile("" : "+v"(dbase)); \
                    float b0[16], b1[16]; \
                    _Pragma("unroll") for (int k = 0; k < 16; ++k) { const int d0 = dbase - crow(k, 0), d1 = d0 - 32; b0[k] = lut[min(max(d0, 0), 128)]; b1[k] = lut[min(max(d1, 0), 128)]; } \
                    _Pragma("unroll") for (int k = 0; k < 16; ++k) { const int d0 = dbase - crow(k, 0), d1 = d0 - 32; \
                        s0[k] = (d0 >= 0 && d0 <= WIN) ? s0[k] + b0[k] : -INFINITY; s1[k] = (d1 >= 0 && d1 <= WIN) ? s1[k] + b1[k] : -INFINITY; } \
                    bv = 0.f; \
                } \
                pv_halves(c, buf, s0, s1, bv); \
            } \
            if (j >= i) break; \
            ++j; buf ^= 1; }
        for (;;) { WIN_STEP(kreg, vreg) }
#undef WIN_STEP
        branch_finish<false>(c, 2);
    }
    {
        const LAS bf16_t* stg = (const LAS bf16_t*)(lds + A_OACC) + wave * 2048;
        bf16_t* ob = A.ONSA + ((size_t)b * SEQ + 64 * i + 32 * c.qh) * NSAW + h * 64;
#pragma unroll
        for (int i4 = 0; i4 < 4; ++i4) { const int rw = i4 * 8 + (lane >> 3), ch = lane & 7;
            const u32x4 v = *(const LAS u32x4*)(stg + rw * 64 + ch * 8); *(u32x4*)(ob + (size_t)rw * NSAW + ch * 8) = v; }
    }
}

constexpr int H_QT = 0, H_QSTR = 272;
constexpr int H_KS = H_QT + 64 * H_QSTR;
constexpr int H_QR = H_KS + 64 * H_QSTR;
constexpr int H_KT = H_QR + 64 * H_QSTR, H_KTSTR = 144;
constexpr int H_VL = H_KT + 128 * H_KTSTR, H_VSTR = 288;
constexpr int H_AT = H_VL + 64 * H_VSTR, H_ASTR = 144;
constexpr int H_BC = H_AT + 64 * H_ASTR, H_BSTR = 132;
constexpr int H_PT = H_BC + 64 * H_BSTR * 4;
constexpr int H_BR = H_PT + 4 * 128 * 4;
constexpr int H_DB = H_BR + 4 * 128 * 4;
constexpr int H_SS = H_DB + 128 * 4;
constexpr int H_END = H_SS + 8 * 64 * 4;
static_assert(H_END <= MISC_OFF, "hgrn LDS");

DI float ex2(float x) { return __builtin_amdgcn_exp2f(x); }

struct HgArgs { const bf16_t *HQ, *HI, *HGT; const float *GL, *hgn; float *SLOC, *GD; bf16_t* OHG; float* out; };
struct HgChunkRegs { f32x4 gl[4]; u32x4 hq[2], hi[2], hg[2]; };
template <bool WITH_OUT>
DI void hg_fetch(const HgArgs& A, size_t row0, int h, int tid, HgChunkRegs& R) {
#pragma unroll
    for (int i = 0; i < 4; ++i) { const int idx = tid + 512 * i; R.gl[i] = *(const f32x4*)(A.GL + (row0 + (idx >> 5)) * HGW + h * 128 + 4 * (idx & 31)); }
#pragma unroll
    for (int i = 0; i < 2; ++i) { const int idx = tid + 512 * i; const size_t o = (row0 + (idx >> 4)) * HGW + h * 128 + 8 * (idx & 15);
        R.hi[i] = *(const u32x4*)(A.HI + o); if (WITH_OUT) { R.hq[i] = *(const u32x4*)(A.HQ + o); R.hg[i] = *(const u32x4*)(A.HGT + o); } }
}
template <bool WITH_OUT>
DI void hg_stage(LAS unsigned char* lds, int tid, const HgChunkRegs& R) {
#pragma unroll
    for (int i = 0; i < 4; ++i) { const int idx = tid + 512 * i; *(LAS f32x4*)(lds + H_BC + ((idx >> 5) * H_BSTR + 4 * (idx & 31)) * 4) = R.gl[i]; }
#pragma unroll
    for (int i = 0; i < 2; ++i) { const int idx = tid + 512 * i; *(LAS u32x4*)(lds + H_VL + (idx >> 4) * H_VSTR + 16 * (idx & 15)) = R.hi[i];
        if (WITH_OUT) *(LAS u32x4*)(lds + H_QR + (idx >> 4) * H_QSTR + 16 * (idx & 15)) = R.hq[i]; }
}

template <bool WITH_OUT>
DI void hgrn_unit(const HgArgs& A, LAS unsigned char* lds, int unit, int tid, int lane, int wave) {
    const int bh = unit >> 3, grp = unit & 7, b = bh >> 2, h = bh & 3;
    const int gq = lane >> 4, l15 = lane & 15;
    const size_t rowu = (size_t)b * SEQ + 256 * grp;
    HgChunkRegs R;
    hg_fetch<WITH_OUT>(A, rowu, h, tid, R);
    f32x4 acc[8];
#pragma unroll
    for (int kt = 0; kt < 8; ++kt) acc[kt] = (f32x4){0.f, 0.f, 0.f, 0.f};
    if (WITH_OUT) {
        { int lofs = lane; asm volatile("" : "+v"(lofs));
          const f32x4* sl0 = (const f32x4*)A.SLOC + ((size_t)(bh * 8) * 8 + wave) * 8 * 64 + lofs; const float* gd0 = A.GD + (size_t)(bh * 8) * 128 + 4 * gq;
#pragma unroll
          for (int kt = 0; kt < 8; ++kt) {
              if (kt == 4) __builtin_amdgcn_sched_barrier(0);
              f32x4 sv[7], gv[7];
#pragma unroll
              for (int g2 = 0; g2 < 7; ++g2) if (g2 < grp) { sv[g2] = sl0[((size_t)g2 * 64 + kt) * 64]; gv[g2] = *(const f32x4*)(gd0 + (size_t)g2 * 128 + 16 * kt); }
              f32x4 a = (f32x4){0.f, 0.f, 0.f, 0.f};
#pragma unroll
              for (int g2 = 0; g2 < 7; ++g2) if (g2 < grp) {
#pragma unroll
                  for (int r = 0; r < 4; ++r) a[r] = a[r] * __expf(gv[g2][r]) + sv[g2][r]; }
              acc[kt] = a; } }
        for (int e = tid; e < 64 * H_ASTR / 4; e += NTHREADS) ((LAS unsigned*)(lds + H_AT))[e] = 0u;
    }
    const int kch = tid & 127, part = tid >> 7;
    float gdsum = 0.f;
    for (int ch = 0; ch < 4; ++ch) {
        const size_t row0 = rowu + 64 * ch;
        __syncthreads();
        hg_stage<WITH_OUT>(lds, tid, R);
        const u32x4 hg0 = R.hg[0], hg1 = R.hg[1];
        __syncthreads();
        if (ch < 3) hg_fetch<WITH_OUT>(A, row0 + 64, h, tid, R);
        LAS float* bcol = (LAS float*)(lds + H_BC) + (16 * part) * H_BSTR + kch;
        float run = 0.f;
#pragma unroll
        for (int t = 0; t < 16; ++t) run += bcol[t * H_BSTR];
        ((LAS float*)(lds + H_PT))[part * 128 + kch] = run;
        __syncthreads();
        float off = 0.f, btot = 0.f;
        { const LAS float* pt = (const LAS float*)(lds + H_PT);
#pragma unroll
          for (int p2 = 0; p2 < 4; ++p2) { const float v = pt[p2 * 128 + kch]; if (p2 < part) off += v; btot += v; } }
        const float bref = off + run;
        if (part == 0) { ((LAS float*)(lds + H_DB))[kch] = __expf(btot); gdsum += btot; }
        if (WITH_OUT) ((LAS float*)(lds + H_BR))[part * 128 + kch] = bref;
        { float bt = off;
#pragma unroll
          for (int t4 = 0; t4 < 4; ++t4) {
              unsigned kw[2];
#pragma unroll
              for (int t1 = 0; t1 < 4; ++t1) { const int tl = 4 * t4 + t1, tt = 16 * part + tl;
                  const float gl = bcol[tl * H_BSTR]; bt += gl;
                  const float kkv = 1.f - __expf(gl);
                  const unsigned hv = f2bf(kkv * __expf(btot - bt));
                  if (t1 & 1) kw[t1 >> 1] |= hv << 16; else kw[t1 >> 1] = hv;
                  if (WITH_OUT) {
                      const float qv = bf2f(*(const LAS bf16_t*)(lds + H_QR + tt * H_QSTR + kch * 2));
                      *(LAS bf16_t*)(lds + H_QT + tt * H_QSTR + kch * 2) = (bf16_t)f2bf(qv * __expf(bt));
                      *(LAS bf16_t*)(lds + H_KS + tt * H_QSTR + kch * 2) = (bf16_t)f2bf(kkv * __expf(bref - bt));
                      bcol[tl * H_BSTR] = bt;
                  } }
              *(LAS u32x2*)(lds + H_KT + kch * H_KTSTR + part * 32 + t4 * 8) = (u32x2){kw[0], kw[1]}; } }
        __syncthreads();
        if (WITH_OUT) {
            for (int tile = wave; tile < 10; tile += 8) {
                int it, js; { int rem = tile; it = 0; while (rem > it) { rem -= it + 1; ++it; } js = rem; }
                f32x4 a4 = (f32x4){0.f, 0.f, 0.f, 0.f};
                const int trow = 16 * it + l15, srow = 16 * js + l15;
#pragma unroll 2
                for (int ks = 0; ks < 4; ++ks) {
                    const int k0 = 32 * ks + 8 * gq;
                    const u32x4 qraw = *(const LAS u32x4*)(lds + H_QR + trow * H_QSTR + k0 * 2);
                    const LAS float* bp = (const LAS float*)(lds + H_BC) + trow * H_BSTR + k0; const LAS float* rp = (const LAS float*)(lds + H_BR) + js * 128 + k0;
                    const f32x4 b0 = *(const LAS f32x4*)bp, b1 = *(const LAS f32x4*)(bp + 4), r0 = *(const LAS f32x4*)rp, r1 = *(const LAS f32x4*)(rp + 4);
                    float qd[8];
                    qd[0] = bflo(qraw.x) * __expf(b0[0] - r0[0]); qd[1] = bfhi(qraw.x) * __expf(b0[1] - r0[1]); qd[2] = bflo(qraw.y) * __expf(b0[2] - r0[2]); qd[3] = bfhi(qraw.y) * __expf(b0[3] - r0[3]);
                    qd[4] = bflo(qraw.z) * __expf(b1[0] - r1[0]); qd[5] = bfhi(qraw.z) * __expf(b1[1] - r1[1]); qd[6] = bflo(qraw.w) * __expf(b1[2] - r1[2]); qd[7] = bfhi(qraw.w) * __expf(b1[3] - r1[3]);
                    const bf16x8 af = pack8(qd);
                    const bf16x8 bfv = *(const LAS bf16x8*)(lds + H_KS + srow * H_QSTR + k0 * 2);
                    a4 = MFMA16(af, bfv, a4);
                }
#pragma unroll
                for (int r = 0; r < 4; ++r) { const int tl = 4 * gq + r; float v = a4[r]; if (it == js && l15 > tl) v = 0.f;
                    *(LAS bf16_t*)(lds + H_AT + (16 * it + tl) * H_ASTR + (16 * js + l15) * 2) = (bf16_t)f2bf(v); }
            }
            __syncthreads();
        }
        bf16x8 vf[2];
        { const int q = l15 >> 2, p = l15 & 3;
#pragma unroll
          for (int ks = 0; ks < 2; ++ks) { const LAS unsigned char* vp = lds + H_VL + (32 * ks + 4 * gq + q) * H_VSTR + (16 * wave + 4 * p) * 2;
              vf[ks] = cat44(tr_read(vp), tr_read(vp + 16 * H_VSTR)); } }
        if (WITH_OUT) {
            f32x4 o[4];
#pragma unroll
            for (int it = 0; it < 4; ++it) { o[it] = (f32x4){0.f, 0.f, 0.f, 0.f};
                const int trow = 16 * it + l15;
#pragma unroll
                for (int ks = 0; ks < 2; ++ks) { const LAS unsigned char* ap = lds + H_AT + trow * H_ASTR + (32 * ks + 4 * gq) * 2;
                    const bf16x8 af = cat44(*(const LAS s16x4*)ap, *(const LAS s16x4*)(ap + 32)); o[it] = MFMA16(af, vf[ks], o[it]); } }
#pragma unroll
            for (int ks = 0; ks < 4; ++ks) {
                const bf16x8 sf = pack8v(acc[2 * ks], acc[2 * ks + 1]);
#pragma unroll
                for (int it = 0; it < 4; ++it) { const LAS unsigned char* qp = lds + H_QT + (16 * it + l15) * H_QSTR + (32 * ks + 4 * gq) * 2;
                    const bf16x8 af = cat44(*(const LAS s16x4*)qp, *(const LAS s16x4*)(qp + 32)); o[it] = MFMA16(af, sf, o[it]); } }
            LAS float* SS = (LAS float*)(lds + H_SS);
#pragma unroll
            for (int it = 0; it < 4; ++it)
#pragma unroll
                for (int r = 0; r < 4; ++r) { const float s = row16_sum(o[it][r] * o[it][r]);
                    if (l15 == 0) SS[wave * 64 + 16 * it + 4 * gq + r] = s; }
            __syncthreads();
            if (tid < 64) { float tot = 0.f;
#pragma unroll
                for (int w2 = 0; w2 < 8; ++w2) tot += SS[w2 * 64 + tid];
                ((LAS float*)(lds + H_PT))[tid] = 1.f / sqrtf(tot * (1.f / 128.f) + EPS); }
            __syncthreads();
            const float gn = A.hgn[16 * wave + l15];
#pragma unroll
            for (int it = 0; it < 4; ++it) {
                const f32x4 rs4 = *(const LAS f32x4*)((const LAS float*)(lds + H_PT) + 16 * it + 4 * gq);
#pragma unroll
                for (int r = 0; r < 4; ++r) *(LAS bf16_t*)(lds + H_KS + (16 * it + 4 * gq + r) * H_QSTR + (16 * wave + l15) * 2) = (bf16_t)f2bf(o[it][r] * rs4[r] * gn); }
        }
        { const LAS float* DB = (const LAS float*)(lds + H_DB);
#pragma unroll
          for (int kt = 0; kt < 8; ++kt) { const f32x4 d4 = *(const LAS f32x4*)(DB + 16 * kt + 4 * gq); acc[kt] = acc[kt] * d4;
#pragma unroll
              for (int ks = 0; ks < 2; ++ks) { const LAS unsigned char* kp = lds + H_KT + (16 * kt + l15) * H_KTSTR + (32 * ks + 4 * gq) * 2;
                  const bf16x8 af = cat44(*(const LAS s16x4*)kp, *(const LAS s16x4*)(kp + 32)); acc[kt] = MFMA16(af, vf[ks], acc[kt]); } } }
        if (WITH_OUT) {
            __syncthreads();
#pragma unroll
            for (int i = 0; i < 2; ++i) { const int idx = tid + 512 * i, rw = idx >> 4, c16 = idx & 15;
                const u32x4 ov = *(const LAS u32x4*)(lds + H_KS + rw * H_QSTR + 16 * c16);
                const size_t o = (row0 + rw) * HGW + h * 128 + 8 * c16; const u32x4 gv = i ? hg1 : hg0;
                u32x4 w;
                w.x = pk2(bflo(ov.x) * siluf_(bflo(gv.x)), bfhi(ov.x) * siluf_(bfhi(gv.x))); w.y = pk2(bflo(ov.y) * siluf_(bflo(gv.y)), bfhi(ov.y) * siluf_(bfhi(gv.y)));
                w.z = pk2(bflo(ov.z) * siluf_(bflo(gv.z)), bfhi(ov.z) * siluf_(bfhi(gv.z))); w.w = pk2(bflo(ov.w) * siluf_(bflo(gv.w)), bfhi(ov.w) * siluf_(bfhi(gv.w)));
                *(u32x4*)(A.OHG + o) = w; }
        }
    }
    if (!WITH_OUT) {
        int lofs = lane; asm volatile("" : "+v"(lofs));
        f32x4* sl = (f32x4*)A.SLOC + ((size_t)(unit * 8 + wave) * 8) * 64 + lofs;
#pragma unroll
        for (int kt = 0; kt < 8; ++kt) sl[kt * 64] = acc[kt];
        if (part == 0) A.GD[(size_t)unit * 128 + kch] = gdsum;
    } else if (grp == 7) {
        int lofs = (4 * gq) * 128 + 16 * wave + l15; asm volatile("" : "+v"(lofs));
        float* so = A.out + OFF_HGP + (size_t)bh * 16384 + lofs;
#pragma unroll
        for (int kt = 0; kt < 8; ++kt)
#pragma unroll
            for (int r = 0; r < 4; ++r) so[(16 * kt + r) * 128] = acc[kt][r];
    }
}

DI float gelu_tanh(float x) { const float uu = 0.7978845608028654f * (x + 0.044715f * x * x * x); const float t = 1.f - 2.f * __builtin_amdgcn_rcpf(__expf(2.f * uu) + 1.f); return 0.5f * x * (1.f + t); }
struct CmpArgs { const float *cache, *kvout; const int* page_table; const bf16_t *W1K, *W1V; const float *w2k, *w2v, *kg0; float *CKS, *CVS; bf16_t *CKP, *CVP; };
constexpr int C_PART = 0, C_HB = 32768, C_W2 = 36864;
DI void cmp_rows(const CmpArgs& A, int item, int lane, int wave, const float* (&rp)[4]) {
    const bool sample = item < 2048; const int it2 = sample ? item : item - 2048;
    const int bb = it2 >> 4, g = (it2 >> 3) & 1, kv = (it2 >> 2) & 1, rt = it2 & 3;
    const int nl = lane & 15, gq = lane >> 4, n = 16 * rt + nl;
#pragma unroll
    for (int jj = 0; jj < 4; ++jj) { const int t = 32 * n + 4 * wave + jj;
        const float* p = sample ? A.cache + ((size_t)A.page_table[bb * NPAGES + (t >> 7)] * PAGE + (t & 127)) * 512 : A.kvout + ((size_t)bb * SEQ + t) * 512;
        rp[jj] = p + kv * 128 + g * 64 + 8 * gq; }
}
DI void cmp_load(const float* const (&rp)[4], f32x4 (&av)[4][2][2]) {
#pragma unroll
    for (int jj = 0; jj < 4; ++jj)
#pragma unroll
        for (int k2 = 0; k2 < 2; ++k2) { av[jj][k2][0] = *(const f32x4*)(rp[jj] + 32 * k2); av[jj][k2][1] = *(const f32x4*)(rp[jj] + 32 * k2 + 4); }
}
DI void cmp_wload(const bf16_t* W1, int lane, int wave, bf16x8 (&wf)[4][2][4]) {
    const int nl = lane & 15, gq = lane >> 4;
    const bf16_t* wp = W1 + (size_t)nl * 2048 + (4 * wave) * 64 + 8 * gq;
#pragma unroll
    for (int jj = 0; jj < 4; ++jj)
#pragma unroll
        for (int k2 = 0; k2 < 2; ++k2)
#pragma unroll
            for (int nt = 0; nt < 4; ++nt) wf[jj][k2][nt] = *(const bf16x8*)(wp + (size_t)(16 * nt) * 2048 + jj * 64 + 32 * k2);
}
DI void cmp_mfma(const bf16x8 (&wf)[4][2][4], const f32x4 (&av)[4][2][2], f32x4 (&acc)[4]) {
#pragma unroll
    for (int nt = 0; nt < 4; ++nt) acc[nt] = (f32x4){0.f, 0.f, 0.f, 0.f};
#pragma unroll
    for (int jj = 0; jj < 4; ++jj)
#pragma unroll
        for (int k2 = 0; k2 < 2; ++k2) { const bf16x8 af = pack8v(av[jj][k2][0], av[jj][k2][1]);
#pragma unroll
            for (int nt = 0; nt < 4; ++nt) acc[nt] = MFMA16(af, wf[jj][k2][nt], acc[nt]); }
}
DI void cmp_tail(const CmpArgs& A, LAS unsigned char* lds, int item, int tid, int lane, int wave, const f32x4 (&acc)[4]) {
    const bool sample = item < 2048; const int it2 = sample ? item : item - 2048;
    const int bb = it2 >> 4, g = (it2 >> 3) & 1, kv = (it2 >> 2) & 1, rt = it2 & 3;
    const int nl = lane & 15, gq = lane >> 4;
    LAS float* part = (LAS float*)(lds + C_PART); LAS float* hb = (LAS float*)(lds + C_HB);
    __syncthreads();
#pragma unroll
    for (int nt = 0; nt < 4; ++nt)
#pragma unroll
        for (int r = 0; r < 4; ++r) part[wave * 1024 + (4 * gq + r) * 64 + 16 * nt + nl] = acc[nt][r];
    __syncthreads();
    const int row = tid >> 5, e2 = (tid & 31) * 2;
    { float h0 = 0.f, h1 = 0.f;
#pragma unroll
      for (int w2 = 0; w2 < 8; ++w2) { const f32x2 v = *(const LAS f32x2*)(part + w2 * 1024 + row * 64 + e2); h0 += v.x; h1 += v.y; }
      hb[row * 64 + e2] = gelu_tanh(h0); hb[row * 64 + e2 + 1] = gelu_tanh(h1); }
    __syncthreads();
    const LAS float* w2 = (const LAS float*)(lds + C_W2) + kv * 4096;
    float o0 = 0.f, o1 = 0.f;
#pragma unroll 16
    for (int e = 0; e < 64; ++e) { const float hv = hb[row * 64 + e]; const f32x2 w = *(const LAS f32x2*)(w2 + e * 64 + e2); o0 += hv * w.x; o1 += hv * w.y; }
    if (kv == 0) { float ss = o0 * o0 + o1 * o1;
        ss = x16_sum(row16_sum(ss));
        const LAS float* kgl = (const LAS float*)(lds + C_W2) + 8192;
        const float rs = 1.f / sqrtf(ss * (1.f / 64.f) + EPS); o0 *= rs * kgl[e2]; o1 *= rs * kgl[e2 + 1]; }
    const int nn = 16 * rt + row;
    if (sample) { float* dst = (kv ? A.CVS : A.CKS) + ((size_t)(bb * 2 + g) * 64 + nn) * 64 + e2; *(f32x2*)dst = (f32x2){o0, o1}; }
    else { bf16_t* dst = (kv ? A.CVP : A.CKP) + ((size_t)(bb * 2 + g) * 64 + nn) * 64 + e2; *(unsigned*)dst = pk2(o0, o1); }
}
DI int cmp_item_id(int kv, int q) {
    const int sample = q < 1024; const int r = sample ? q : q - 1024;
    const int it2 = ((r >> 3) << 4) | (((r >> 2) & 1) << 3) | (kv << 2) | (r & 3);
    return sample ? it2 : 2048 + it2;
}
DI void compress_phase(const CmpArgs& A, LAS unsigned char* lds, int w, int W, int q0, int q1, int tid, int lane, int wave) {
    __syncthreads();
    { LAS float* w2l = (LAS float*)(lds + C_W2);
      for (int e = tid; e < 4096; e += NTHREADS) { w2l[e] = A.w2k[e]; w2l[4096 + e] = A.w2v[e]; }
      if (tid < 64) w2l[8192 + tid] = A.kg0[tid]; }
    const int kv = w & 1, step = W >> 1;
    int q = q0 + (w >> 1);
    if (q >= q1 || step < 1) return;
    bf16x8 wf[4][2][4];
    cmp_wload(kv ? A.W1V : A.W1K, lane, wave, wf);
    f32x4 av[4][2][2]; const float* rp[4];
    int item = cmp_item_id(kv, q);
    cmp_rows(A, item, lane, wave, rp);
    cmp_load(rp, av);
    for (;;) {
        const int qn = q + step; const bool more = qn < q1; const int next = more ? cmp_item_id(kv, qn) : 0;
        if (more) cmp_rows(A, next, lane, wave, rp);
        f32x4 acc[4];
        cmp_mfma(wf, av, acc);
        asm volatile("" ::: "memory"); __builtin_amdgcn_sched_barrier(0);
        if (more) cmp_load(rp, av);
        asm volatile("" ::: "memory");
        cmp_tail(A, lds, item, tid, lane, wave, acc);
        if (!more) break;
        item = next; q = qn;
    }
}
constexpr int CMP_EARLY_Q = 159;
DI bool cmp_early(int G, int lo, int& rem, int& W) { const int nunits = (MPAD / 256) * (NIN / 256); rem = nunits % G; W = (G - rem) & ~1; return lo == 0 && rem > 0 && W >= 2 && (2 * CMP_EARLY_Q + W - 1) / W <= 3; }

struct HsArgs { const float *S0, *GL, *hgn; const bf16_t *HQ, *HI, *HGT; bf16_t* OHG; float* out; };
DI void hgrn_sample_unit(const HsArgs& A, LAS unsigned char* lds, int unit, int tid, int lane, int wave) {
    const int bs = unit >> 2, h = unit & 3; const size_t row = (size_t)MP + bs;
    const int vq = tid & 31, kg = tid >> 5;
    const float* S0 = A.S0 + (size_t)unit * 16384; float* S1 = A.out + OFF_HGS + (size_t)unit * 16384;
    const f32x4 vv = ld_bf4(A.HI + row * HGW + h * 128 + 4 * vq);
    f32x4 o = (f32x4){0.f, 0.f, 0.f, 0.f};
    f32x4 s[8];
#pragma unroll
    for (int i2 = 0; i2 < 8; ++i2) s[i2] = *(const f32x4*)(S0 + (size_t)(kg + 16 * i2) * 128 + 4 * vq);
#pragma unroll
    for (int i2 = 0; i2 < 8; ++i2) { const int k = kg + 16 * i2;
        const float f = __expf(A.GL[row * HGW + h * 128 + k]), qk = bf2f(A.HQ[row * HGW + h * 128 + k]);
        const f32x4 sn = s[i2] * f + vv * (1.f - f);
        *(f32x4*)(S1 + (size_t)k * 128 + 4 * vq) = sn; o += sn * qk; }
    LAS float* red = (LAS float*)lds; LAS float* ov = red + 16 * 128;
    __syncthreads();
    *(LAS f32x4*)(red + kg * 128 + 4 * vq) = o;
    __syncthreads();
    if (tid < 128) { float t = 0.f;
#pragma unroll
        for (int k2 = 0; k2 < 16; ++k2) t += red[k2 * 128 + tid];
        ov[tid] = t; }
    __syncthreads();
    if (wave == 0) { const float a = ov[lane], b2 = ov[lane + 64]; const float ss = wave_sum(a * a + b2 * b2); const float rs = 1.f / sqrtf(ss * (1.f / 128.f) + EPS);
        const size_t idx = row * HGW + h * 128;
        A.OHG[idx + lane] = (bf16_t)f2bf(a * rs * A.hgn[lane] * siluf_(bf2f(A.HGT[idx + lane])));
        A.OHG[idx + lane + 64] = (bf16_t)f2bf(b2 * rs * A.hgn[lane + 64] * siluf_(bf2f(A.HGT[idx + lane + 64]))); }
}

constexpr int D_SC = 0;
constexpr int D_LUT = D_SC + 4 * 1024 * 4;
constexpr int D_RED = D_LUT + 4 * 132 * 4;
constexpr int D_MISC = D_RED + 32 * 256 * 4;
constexpr int D_OUT = D_MISC + 256;
struct DecArgs { const bf16_t* Q; const float *GATES, *rel_table, *cache, *skw, *CKS, *CVS; const int* page_table; float* out; bf16_t* ONSA; };

#define DEC_BLOAD(dst, k0v, n, RS, OFF) do { _Pragma("unroll") for (int u_ = 0; u_ < 8; ++u_) { const int kk = (k0v) + 32 * u_ + ks; \
        if (kk < (n)) dst[u_] = __builtin_bit_cast(f32x4, __builtin_amdgcn_raw_buffer_load_b128(RS, (unsigned)(OFF) + 16u * l16, 0, 0)); else dst[u_] = (f32x4){0.f, 0.f, 0.f, 0.f}; } } while (0)
#define DEC_SCORE_ROW(kvu_, kk, live, DIST, COPYK) do { \
        float d_[4]; _Pragma("unroll") for (int r_ = 0; r_ < 4; ++r_) { const f32x4 p_ = kvu_ * qv[r_]; d_[r_] = (p_[0] + p_[1]) + (p_[2] + p_[3]); } \
        _Pragma("unroll") for (int r_ = 0; r_ < 4; ++r_) d_[r_] = row16_sum(d_[r_]); \
        if (live) { COPYK; if (l16 < 4) { const int dd_ = (DIST); SC[l16 * 1024 + kk] = d_[l16 == 0 ? 0 : (l16 == 1 ? 1 : (l16 == 2 ? 2 : 3))] + LUT[l16 * 132 + (dd_ > 128 ? 128 : dd_)]; } } } while (0)
#define DEC_KLOAD(dst, k0v, n, RS, OFF) do { _Pragma("unroll") for (int t_ = 0; t_ < 2; ++t_) { const int kb_t_ = (k0v) + 32 * wave + 16 * t_; const int kk = kb_t_ + l16; \
        if (kb_t_ < (n)) { const unsigned o_ = (unsigned)(OFF) + 16u * q4; _Pragma("unroll") for (int j_ = 0; j_ < 4; ++j_) dst[4 * t_ + j_] = __builtin_bit_cast(f32x4, __builtin_amdgcn_raw_buffer_load_b128(RS, o_ + 64u * j_, 0, 0)); } \
        else { _Pragma("unroll") for (int j_ = 0; j_ < 4; ++j_) dst[4 * t_ + j_] = (f32x4){0.f, 0.f, 0.f, 0.f}; } } } while (0)
#define DEC_KSCORE(src, k0v, n, DIST, COPYK) do { _Pragma("unroll") for (int t_ = 0; t_ < 2; ++t_) { const int kb_t_ = (k0v) + 32 * wave + 16 * t_; const int kk = kb_t_ + l16; \
        if (kb_t_ < (n)) { const f32x4 k0_v = src[4 * t_], k1_v = src[4 * t_ + 1], k2_v = src[4 * t_ + 2], k3_v = src[4 * t_ + 3]; \
            f32x4 sc_ = MFMA16(qa[0], pack8v(k0_v, k1_v), ((f32x4){0.f, 0.f, 0.f, 0.f})); sc_ = MFMA16(qa[1], pack8v(k2_v, k3_v), sc_); \
            COPYK; \
            if (lane < 16) { const int dd_ = (DIST); const int di_ = dd_ > 128 ? 128 : dd_; \
                _Pragma("unroll") for (int r_ = 0; r_ < 4; ++r_) SC[r_ * 1024 + kk] = sc_[r_] + LUT[r_ * 132 + di_]; } } } } while (0)
#define DEC_SCORE_PASS(n, RS, OFF, DIST, COPYK, PRELOADED) do { if (!(PRELOADED)) DEC_KLOAD(ka_, 0, n, RS, OFF); \
    _Pragma("nounroll") for (int k0_ = 0; ; k0_ += 512) { \
        if (k0_ + 256 < (n)) DEC_KLOAD(kb_, k0_ + 256, n, RS, OFF); \
        DEC_KSCORE(ka_, k0_, n, DIST, COPYK); \
        if (k0_ + 256 >= (n)) break; \
        if (k0_ + 512 < (n)) DEC_KLOAD(ka_, k0_ + 512, n, RS, OFF); \
        DEC_KSCORE(kb_, k0_ + 256, n, DIST, COPYK); \
        if (k0_ + 512 >= (n)) break; } } while (0)
#define DEC_SCORE_ONE(kidx, PTR, DISTV) do { const f32x4 kone_ = (ks == 0) ? *(const f32x4*)((PTR) + 4 * l16) : (f32x4){0.f, 0.f, 0.f, 0.f}; const int kk = (kidx); \
        DEC_SCORE_ROW(kone_, kk, ks == 0, DISTV, (void)0); } while (0)
#define DEC_SOFTMAX(nkeys) do { __syncthreads(); if (wave < 4) { float m_ = -INFINITY; for (int kk = lane; kk < (nkeys); kk += 64) m_ = fmaxf(m_, SC[wave * 1024 + kk]); \
        m_ = wave_max(m_); float s_ = 0.f; \
        for (int kk = lane; kk < (nkeys); kk += 64) { const float e_ = ex2(SC[wave * 1024 + kk] - m_); SC[wave * 1024 + kk] = e_; s_ += e_; } \
        s_ = wave_sum(s_); if (lane == 0) MISCF[wave] = s_; } __syncthreads(); } while (0)
#define DEC_PV_BODY(src, k0v, n, COPYV) do { _Pragma("unroll") for (int u_ = 0; u_ < 8; ++u_) { const int kk = (k0v) + 32 * u_ + ks; const f32x4 vvu_ = src[u_]; \
        if (kk < (n)) { COPYV; _Pragma("unroll") for (int r_ = 0; r_ < 4; ++r_) oa_[r_] += vvu_ * SC[r_ * 1024 + kk]; } } } while (0)
#define DEC_PV_PASS(n, ntot, RS, OFF, COPYV, GATE, MIDDLE, TAILHOOK, HAS1, PTR1) do { f32x4 oa_[4]; _Pragma("unroll") for (int r_ = 0; r_ < 4; ++r_) oa_[r_] = (f32x4){0.f, 0.f, 0.f, 0.f}; \
    { f32x4 va_[8], vb_[8]; DEC_BLOAD(va_, 0, n, RS, OFF);        \
    f32x4 vone_ = (f32x4){0.f, 0.f, 0.f, 0.f}; if ((HAS1) && ks == 0) vone_ = *(const f32x4*)((PTR1) + 4 * l16); \
    DEC_SOFTMAX(ntot); MIDDLE; \
    if ((HAS1) && ks == 0) { _Pragma("unroll") for (int r_ = 0; r_ < 4; ++r_) oa_[r_] += vone_ * SC[r_ * 1024 + (n)]; } \
    _Pragma("nounroll") for (int k0_ = 0; ; k0_ += 512) { \
        if (k0_ + 256 < (n)) DEC_BLOAD(vb_, k0_ + 256, n, RS, OFF); \
        DEC_PV_BODY(va_, k0_, n, COPYV); \
        if (k0_ + 256 >= (n)) break; \
        if (k0_ + 512 < (n)) DEC_BLOAD(va_, k0_ + 512, n, RS, OFF); \
        DEC_PV_BODY(vb_, k0_ + 256, n, COPYV); \
        if (k0_ + 512 >= (n)) break; } } \
    _Pragma("unroll") for (int r_ = 0; r_ < 4; ++r_) *(LAS f32x4*)(RED + (ks * 4 + r_) * 64 + 4 * l16) = oa_[r_]; \
    __syncthreads(); \
    TAILHOOK;        \
    if (tid < 256) { const int r_ = tid >> 6, d_ = tid & 63; float t_ = 0.f; _Pragma("unroll 8") for (int s_ = 0; s_ < 32; ++s_) t_ += RED[(s_ * 4 + r_) * 64 + d_]; \
        const float L_ = MISCF[r_]; OUTB[tid] += (L_ > 0.f ? (GATE) / L_ : 0.f) * t_; } \
    __syncthreads(); } while (0)

DI void decode_unit(const DecArgs& A, LAS unsigned char* lds, int unit, int tid, int lane, int wave) {
    const int bs = unit >> 1, g = unit & 1; const size_t row = (size_t)MP + bs;
    asm volatile("" : "+v"(tid));
    const int l16 = tid & 15, ks = tid >> 4, q4 = lane >> 4;
    LAS float* SC = (LAS float*)(lds + D_SC); LAS float* LUT = (LAS float*)(lds + D_LUT); LAS float* RED = (LAS float*)(lds + D_RED);
    LAS float* MISCF = (LAS float*)(lds + D_MISC); LAS int* SELB = (LAS int*)(lds + D_MISC + 64); LAS float* OUTB = (LAS float*)(lds + D_OUT);
    __syncthreads();
    build_lut(LUT, A.rel_table, g, tid);
    f32x4 ka_[8], kb_[8];
    f32x4 qv[4];
#pragma unroll
    for (int r = 0; r < 4; ++r) qv[r] = ld_bf4(A.Q + row * NSAW + (4 * g + r) * 64 + 4 * l16);
    bf16x8 qa[2];
#pragma unroll
    for (int s2 = 0; s2 < 2; ++s2) { const bf16_t* qp = A.Q + row * NSAW + (4 * g + (l16 & 3)) * 64 + 32 * s2 + 4 * q4;
        const s16x4 z4 = {0, 0, 0, 0}; qa[s2] = (l16 < 4) ? cat44(*(const s16x4*)qp, *(const s16x4*)(qp + 16)) : cat44(z4, z4); }
    float gate0 = 0.f, gate1 = 0.f, gate2 = 0.f;
    if (tid < 256) { const int r = tid >> 6; const float* gp = A.GATES + row * 24 + (4 * g + r) * 3;
        gate0 = gp[0]; gate1 = gp[1]; gate2 = gp[2];
        OUTB[tid] = 0.f; }
    if (tid < NPAGES) ((LAS int*)(lds + D_MISC + 128))[tid] = A.page_table[bs * NPAGES + tid];
    __syncthreads();
    const auto rs_ck = __builtin_amdgcn_make_buffer_rsrc((void*)A.CKS, 0, BS * 2 * 4096 * 4, 0x00020000);
    const auto rs_cv = __builtin_amdgcn_make_buffer_rsrc((void*)A.CVS, 0, BS * 2 * 4096 * 4, 0x00020000);
    const auto rs_cache = __builtin_amdgcn_make_buffer_rsrc((void*)A.cache, 0, 2560u * PAGE * 512u * 4u, 0x00020000);
    const auto rs_win = __builtin_amdgcn_make_buffer_rsrc((void*)A.skw, 0, (unsigned)BS * WIN * 256 * 4, 0x00020000);
    const LAS int* pt = (const LAS int*)(lds + D_MISC + 128);
    const float* snewk = A.out + OFF_KV + (row * 4 + 2) * 128 + g * 64; const float* snewv = A.out + OFF_KV + (row * 4 + 3) * 128 + g * 64;
    float* wo = A.out + OFF_WINS + (size_t)bs * WIN * 256 + g * 64;
    const float* wnewk = wo + (size_t)(WIN - 1) * 256; const float* wnewv = wnewk + 128;
    const unsigned ckoff = (unsigned)(bs * 2 + g) * 4096u * 4u, wkoff = ((unsigned)bs * WIN * 256u + g * 64u) * 4u;
#define SEL_T(kk) (64 * SELB[(kk) >> 6] + ((kk) & 63))
#define SEL_OFF(kk, slot) ((((unsigned)pt[SEL_T(kk) >> 7] * PAGE + (SEL_T(kk) & 127)) * 512u + (slot) * 128u + g * 64u) * 4u)
    DEC_SCORE_PASS(64, rs_ck, ckoff + kk * 256u, PAST - (32 * kk + 31), (void)0, 0);
#define DEC_CMP_MIDDLE \
      if (wave == 0) { float imp = 0.f; \
          if (lane < 32) { _Pragma("unroll") for (int r = 0; r < 4; ++r) imp += (SC[r * 1024 + 2 * lane] + SC[r * 1024 + 2 * lane + 1]) / MISCF[r]; } \
          const bool cand = lane >= 1 && lane <= 30; int cnt = 0; \
          _Pragma("unroll") for (int j2 = 1; j2 <= 30; ++j2) { const float o2 = __uint_as_float(__builtin_amdgcn_readlane(__float_as_uint(imp), j2)); cnt += (cand && (o2 > imp || (o2 == imp && j2 < lane))) ? 1 : 0; } \
          const bool sel = (lane == 0) || (lane == 31) || (cand && cnt < 13); \
          const unsigned long long bal = __ballot(sel); \
          if (sel) SELB[__builtin_popcountll(bal & ((1ull << lane) - 1ull))] = lane; }
    DEC_PV_PASS(64, 64, rs_cv, ckoff + kk * 256u, (void)0, gate0, DEC_CMP_MIDDLE, DEC_KLOAD(ka_, 0, 960, rs_cache, SEL_OFF(kk, 2)), 0, snewv);
#undef DEC_CMP_MIDDLE
    DEC_SCORE_PASS(960, rs_cache, SEL_OFF(kk, 2), PAST - SEL_T(kk), (void)0, 1);
    DEC_SCORE_ONE(960, snewk, 0);
    DEC_PV_PASS(960, 961, rs_cache, SEL_OFF(kk, 3), (void)0, gate1, (void)0, DEC_KLOAD(ka_, 0, 512, rs_win, wkoff + kk * 1024u), 1, snewv);
    DEC_SCORE_PASS(512, rs_win, wkoff + kk * 1024u, (WIN - (kk)), { if (kk >= 1) { float* wr_ = wo + (size_t)(kk - 1) * 256 + 4 * q4; *(f32x4*)wr_ = k0_v; *(f32x4*)(wr_ + 16) = k1_v; *(f32x4*)(wr_ + 32) = k2_v; *(f32x4*)(wr_ + 48) = k3_v; } }, 1);
    DEC_SCORE_ONE(512, wnewk, 0);
    DEC_PV_PASS(512, 513, rs_win, wkoff + 512u + kk * 1024u, { if (kk >= 1) *(f32x4*)(wo + (size_t)(kk - 1) * 256 + 128 + 4 * l16) = vvu_; }, gate2, (void)0, (void)0, 1, wnewv);
#undef SEL_T
#undef SEL_OFF
    if (tid < 256) A.ONSA[row * NSAW + (4 * g) * 64 + tid] = (bf16_t)f2bf(OUTB[tid]);
}

DI void phase_2a(const KParams& P, LAS unsigned char* lds, int vcu, int G, int tid, int lane, int wave) {
    unsigned char* ws = P.ws;
    { CmpArgs A{P.in[2], P.out + OFF_KV, P.page_table, (const bf16_t*)(ws + WS_W1K), (const bf16_t*)(ws + WS_W1V), P.in[14], P.in[16], P.in[12],
                (float*)(ws + WS_CKS), (float*)(ws + WS_CVS), (bf16_t*)(ws + WS_CKP), (bf16_t*)(ws + WS_CVP)};
#ifndef NO_CMP
      int rem_, W_; const bool early_ = cmp_early(G, P.ph_lo, rem_, W_);
      REP_LOOP(16) compress_phase(A, lds, vcu, G, early_ ? CMP_EARLY_Q : 0, 1024 + 64, tid, lane, wave);
#endif
    }
    __syncthreads();
    { HgArgs A{(const bf16_t*)(ws + WS_HQ), (const bf16_t*)(ws + WS_HI), (const bf16_t*)(ws + WS_HGT), (const float*)(ws + WS_GL), P.in[17],
               (float*)(ws + WS_SLOC), (float*)(ws + WS_GD), (bf16_t*)(ws + WS_OHG), P.out};
#ifndef NO_HG1
      REP_LOOP(17) for (int u = vcu; u < 256; u += G) hgrn_unit<false>(A, lds, u, tid, lane, wave);
#endif
    }
    __syncthreads();
    { HsArgs A{P.in[5], (const float*)(ws + WS_GL), P.in[17], (const bf16_t*)(ws + WS_HQ), (const bf16_t*)(ws + WS_HI), (const bf16_t*)(ws + WS_HGT), (bf16_t*)(ws + WS_OHG), P.out};
#ifndef NO_HGS
      REP_LOOP(18) for (int u = vcu; u < 512; u += G) hgrn_sample_unit(A, lds, u, tid, lane, wave);
#endif
    }
}
DI void phase_2b(const KParams& P, LAS unsigned char* lds, int vcu, int G, int tid0, int lane0, int wave0) {
    unsigned char* ws = P.ws;
#define IDS2() int tid = threadIdx.x; asm volatile("" : "+v"(tid)); const int lane = tid & 63, wave = __builtin_amdgcn_readfirstlane(tid >> 6)
    { IDS2(); AttnArgs A{(const bf16_t*)(ws + WS_Q), (const bf16_t*)(ws + WS_KVB), (const bf16_t*)(ws + WS_CKP), (const bf16_t*)(ws + WS_CVP), (const float*)(ws + WS_GATES), P.in[7], (bf16_t*)(ws + WS_ONSA)};
#ifndef NO_ATT
      __syncthreads();
      if (wave == 0) { int l2 = lane; asm volatile("" : "+v"(l2)); const float cb_ = score_bound(P.in[11], P.in[12], P.in[7], l2); if (l2 == 0) *(LAS float*)(lds + A_CSH) = cb_; }
      REP_LOOP(19) for (int pu = vcu; pu < 256; pu += G) { const int b = pu >> 5, g = (pu >> 4) & 1, i0 = pu & 15;
          __syncthreads();
          build_lut((LAS float*)(lds + A_LUT), A.rel_table, g, tid, *(const LAS float*)(lds + A_CSH));
          __syncthreads();
          attn_prompt_unit(A, lds, b, g, 31 - i0, tid, lane, wave);
          attn_prompt_unit(A, lds, b, g, i0, tid, lane, wave); }
#endif
    }
    __syncthreads();
    { IDS2(); HgArgs A{(const bf16_t*)(ws + WS_HQ), (const bf16_t*)(ws + WS_HI), (const bf16_t*)(ws + WS_HGT), (const float*)(ws + WS_GL), P.in[17],
               (float*)(ws + WS_SLOC), (float*)(ws + WS_GD), (bf16_t*)(ws + WS_OHG), P.out};
#ifndef NO_HG3
      REP_LOOP(20) for (int u = vcu; u < 256; u += G) hgrn_unit<true>(A, lds, u, tid, lane, wave);
#endif
    }
    __syncthreads();
    { IDS2(); DecArgs A{(const bf16_t*)(ws + WS_Q), (const float*)(ws + WS_GATES), P.in[7], P.in[2], P.in[4], (const float*)(ws + WS_CKS), (const float*)(ws + WS_CVS), P.page_table, P.out, (bf16_t*)(ws + WS_ONSA)};
#ifndef NO_DEC
      REP_LOOP(21) for (int u = vcu; u < 256; u += G) decode_unit(A, lds, u, tid, lane, wave);
#endif
    }
}

#ifndef MK_SINGLE
#define MK_SINGLE 1
#endif
constexpr int N_PHASES = 9;
__global__ void __launch_bounds__(NTHREADS, 2) hybrid_fwd(KParams P) {
    extern __shared__ __attribute__((aligned(16))) unsigned char lds_raw[];
    LAS unsigned char* lds = (LAS unsigned char*)lds_raw;
    volatile LAS unsigned* MISC = (volatile LAS unsigned*)(lds + MISC_OFF);
    const int G = gridDim.x, bx = blockIdx.x;
    const int vcu = (G % 8 == 0) ? (bx % 8) * (G / 8) + bx / 8 : bx;
    unsigned char* ws = P.ws;
    if (threadIdx.x < 64) MISC[threadIdx.x] = 0u;
    __syncthreads();
    XcdBarrier bar; bar.bar = (unsigned*)(ws + WS_CTL) + CW_BAR; bar.x = 0; bar.st = nullptr;
    const int lo = P.ph_lo, hi = P.ph_hi;
    if (hi - lo > 1) bar = xcd_barrier_post((unsigned*)(ws + WS_CTL) + CW_BAR, MISC + 8);
#define IN(k) (lo <= (k) && (k) < hi)
#define SEAM(k) do { if (IN(k) && IN((k) + 1)) xcd_barrier(bar); } while (0)
    float* out = P.out;
#define WSP(T_, off) ((T_*)(ws + (off)))
#define FRESH_IDS() int tid = threadIdx.x; asm volatile("" : "+v"(tid)); const int lane = tid & 63, wave = __builtin_amdgcn_readfirstlane(tid >> 6); (void)lane; (void)wave
    if (IN(0)) REP_LOOP(0) { FRESH_IDS();
        P0Args a{P.in[10], P.in[18], P.in[19], P.in[20], P.in[22], P.in[23], P.in[26], P.in[13], P.in[15], P.in[0], P.in[1], P.in[9], P.in[21],
                 WSP(bf16_t, WS_WIN), WSP(bf16_t, WS_WA), WSP(bf16_t, WS_WB), WSP(bf16_t, WS_WO), WSP(bf16_t, WS_WG), WSP(bf16_t, WS_WU), WSP(bf16_t, WS_WD), WSP(bf16_t, WS_W1K), WSP(bf16_t, WS_W1V), WSP(bf16_t, WS_XN)};
        p0_prologue(a, lds, vcu * NWAVES + wave, G * NWAVES, lane, wave);
    }
    SEAM(0);
    if (IN(1)) REP_LOOP(1) {
        pg8::Gemm g{WSP(bf16_t, WS_XN), WSP(bf16_t, WS_WIN), MPAD, NIN, DM}; pg8::StaticOrder S; S.init(MPAD, NIN, G, bx);
        EpiInProj E{WSP(bf16_t, WS_Q), WSP(bf16_t, WS_KVB), WSP(bf16_t, WS_HQ), WSP(bf16_t, WS_HI), WSP(bf16_t, WS_HGT), WSP(bf16_t, WS_MG), WSP(float, WS_GL), WSP(float, WS_GATES), out, P.in[11], P.in[12], P.in[8]};
#ifndef NO_GEMM
        pg8::gemm_phase<EpiInProj, pg8::StaticOrder, true, true>(lds, g, S, E);
#endif
        { int rem, W;
          if (cmp_early(G, lo, rem, W) && bx >= rem && bx - rem < W) { FRESH_IDS();
              CmpArgs A{P.in[2], P.out + OFF_KV, P.page_table, WSP(bf16_t, WS_W1K), WSP(bf16_t, WS_W1V), P.in[14], P.in[16], P.in[12],
                        WSP(float, WS_CKS), WSP(float, WS_CVS), WSP(bf16_t, WS_CKP), WSP(bf16_t, WS_CVP)};
              compress_phase(A, lds, bx - rem, W, 0, CMP_EARLY_Q, tid, lane, wave); } }
    }
    SEAM(1);
    if (IN(2)) { FRESH_IDS(); phase_2a(P, lds, vcu, G, tid, lane, wave); }
    SEAM(2);
    if (IN(3)) { FRESH_IDS(); phase_2b(P, lds, vcu, G, tid, lane, wave); }
    SEAM(3);
    if (IN(4)) REP_LOOP(4) {
        { pg8::Gemm g{WSP(bf16_t, WS_OHG), WSP(bf16_t, WS_WB), MP, DM, HGW}; pg8::StaticOrder S; S.init(MP, DM, G, bx); EpiMergeB E{WSP(bf16_t, WS_MG), WSP(bf16_t, WS_T)};
#ifndef NO_GEMM
          pg8::gemm_phase<EpiMergeB, pg8::StaticOrder, true, true>(lds, g, S, E);
#endif
        }
        { pg8::Gemm g{WSP(bf16_t, WS_ONSA), WSP(bf16_t, WS_WA), MP, DM, NSAW}; pg8::StaticOrder S; S.init(MP, DM, G, bx); EpiMergeA E{WSP(bf16_t, WS_MG), WSP(bf16_t, WS_T), WSP(bf16_t, WS_MB)};
#ifndef NO_GEMM
          pg8::gemm_phase<EpiMergeA, pg8::StaticOrder, true, true>(lds, g, S, E);
#endif
        }
        FRESH_IDS();
        skinny_gemm<2>(WSP(bf16_t, WS_OHG) + (size_t)MP * HGW, WSP(bf16_t, WS_WB), HGW, WSP(bf16_t, WS_ONSA) + (size_t)MP * NSAW, WSP(bf16_t, WS_WA), NSAW, lds, bx, G, lane, wave,
            SkMerge{WSP(bf16_t, WS_MG), WSP(bf16_t, WS_MB)});
    }
    SEAM(4);
    if (IN(5)) REP_LOOP(5) {
        pg8::Gemm g{WSP(bf16_t, WS_MB), WSP(bf16_t, WS_WO), MP, DM, DM}; pg8::StaticOrder S; S.init(MP, DM, G, bx);
        EpiWo E{P.in[0], P.in[1], WSP(bf16_t, WS_T + 33 * MiB), WSP(float, WS_SSQ)};
#ifndef NO_GEMM
        pg8::gemm_phase<EpiWo, pg8::StaticOrder, true, true>(lds, g, S, E);
#endif
        FRESH_IDS();
        skinny_gemm<1>(WSP(bf16_t, WS_MB) + (size_t)MP * DM, WSP(bf16_t, WS_WO), DM, nullptr, nullptr, 0, lds, bx, G, lane, wave,
            SkWo{P.in[1], WSP(bf16_t, WS_T + 33 * MiB), WSP(float, WS_SSQ) + SSQS_OFF});
    }
    SEAM(5);
    if (IN(6)) REP_LOOP(6) { FRESH_IDS();
        for (int r_ = bx * NTHREADS + tid; r_ < MROWS; r_ += G * NTHREADS) WSP(float, WS_SSQ)[RSTD_OFF + r_] = row_rstd(WSP(float, WS_SSQ), r_);
        halo_gemm(WSP(bf16_t, WS_T + 33 * MiB), WSP(bf16_t, WS_WG), WSP(float, WS_SSQ), WSP(float, WS_G), lds, bx, G, lane, wave);
    }
    SEAM(6);
    if (IN(7)) REP_LOOP(7) {
        pg8::Gemm g{WSP(bf16_t, WS_T + 33 * MiB), WSP(bf16_t, WS_WG), MPAD, 2 * DFF, DM}; pg8::StaticOrder S; S.init(MPAD, 2 * DFF, G, bx);
        EpiGU E{WSP(float, WS_SSQ), WSP(float, WS_G), WSP(bf16_t, WS_H), out, P.in[6], P.in[24], P.in[25], lds};
#ifndef NO_GEMM
        pg8::gemm_phase<EpiGU, pg8::StaticOrder, true, true>(lds, g, S, E);
#endif
    }
    SEAM(7);
    if (IN(8)) REP_LOOP(8) {
        pg8::Gemm g{WSP(bf16_t, WS_H), WSP(bf16_t, WS_WD), MP, DM, DFF}; pg8::StaticOrder S; S.init(MP, DM, G, bx);
        EpiDown E{WSP(bf16_t, WS_T + 33 * MiB), out + OFF_Y};
#ifndef NO_GEMM
        pg8::gemm_phase<EpiDown, pg8::StaticOrder, true, true>(lds, g, S, E);
#endif
        FRESH_IDS();
        skinny_gemm<1>(WSP(bf16_t, WS_H) + (size_t)MP * DFF, WSP(bf16_t, WS_WD), DFF, nullptr, nullptr, 0, lds, bx, G, lane, wave,
            SkDown{WSP(bf16_t, WS_T + 33 * MiB), out + OFF_Y});
    }
#ifdef MK_EXTRA_BARRIERS
    if (hi - lo > 1) for (int eb_ = 0; eb_ < MK_EXTRA_BARRIERS; ++eb_) xcd_barrier(bar);
#endif
#ifdef MK_EXTRA_PHASE
    if (IN(13)) { pg8::Gemm g{WSP(bf16_t, WS_XN), WSP(bf16_t, WS_WIN), MPAD, NIN, DM}; pg8::StaticOrder S; S.init(MPAD, NIN, G, bx); EpiNull E{WSP(float, WS_G) + 4000000};
        pg8::gemm_phase<EpiNull, pg8::StaticOrder, true, true>(lds, g, S, E); }
    if (IN(10)) { pg8::Gemm g{WSP(bf16_t, WS_OHG), WSP(bf16_t, WS_WB), MP, DM, HGW}; pg8::StaticOrder S; S.init(MP, DM, G, bx); EpiMergeB E{WSP(bf16_t, WS_MG), WSP(bf16_t, WS_T)};
        pg8::gemm_phase<EpiMergeB, pg8::StaticOrder, true, true>(lds, g, S, E); }
    if (IN(11)) { pg8::Gemm g{WSP(bf16_t, WS_ONSA), WSP(bf16_t, WS_WA), MP, DM, NSAW}; pg8::StaticOrder S; S.init(MP, DM, G, bx); EpiMergeA E{WSP(bf16_t, WS_MG), WSP(bf16_t, WS_T), WSP(bf16_t, WS_MB)};
        pg8::gemm_phase<EpiMergeA, pg8::StaticOrder, true, true>(lds, g, S, E); }
    if (IN(12)) { FRESH_IDS();
        skinny_gemm<2>(WSP(bf16_t, WS_OHG) + (size_t)MP * HGW, WSP(bf16_t, WS_WB), HGW, WSP(bf16_t, WS_ONSA) + (size_t)MP * NSAW, WSP(bf16_t, WS_WA), NSAW, lds, bx, G, lane, wave,
            SkMerge{WSP(bf16_t, WS_MG), WSP(bf16_t, WS_MB)}); }
#endif
#undef IN
#undef SEAM
}

extern "C" void kernel_launch(void* const* d_in, const int* in_sizes, int n_in, void* d_out, int out_size, void* d_ws, size_t ws_size, hipStream_t stream) {
    static int grid = 0;
    if (grid == 0) {
        if (n_in != 27 || (size_t)out_size != OUT_TOTAL || ws_size < WS_END) {
            fprintf(stderr, "kernel_launch: unexpected problem: n_in %d out %d ws %zu (need %zu)\n", n_in, out_size, ws_size, (size_t)WS_END); grid = -1; return; }
        int dev = 0, cus = 0, per_cu = 0;
        if (hipGetDevice(&dev) != hipSuccess || hipDeviceGetAttribute(&cus, hipDeviceAttributeMultiprocessorCount, dev) != hipSuccess) { grid = -1; return; }
        if (hipFuncSetAttribute((const void*)hybrid_fwd, hipFuncAttributeMaxDynamicSharedMemorySize, LDS_BYTES) != hipSuccess) { fprintf(stderr, "kernel_launch: hipFuncSetAttribute failed\n"); grid = -1; return; }
        if (hipOccupancyMaxActiveBlocksPerMultiprocessor(&per_cu, (const void*)hybrid_fwd, NTHREADS, LDS_BYTES) != hipSuccess || per_cu < 1) {
            fprintf(stderr, "kernel_launch: occupancy query reports %d workgroups per CU\n", per_cu); }
        (void)hipGetLastError();
        grid = cus;
    }
    if (grid < 0) return;
    (void)hipMemsetAsync((char*)d_ws + WS_CTL, 0, CTL_ZERO_BYTES, stream);
    KParams p{};
    for (int i = 0; i < 27; ++i) p.in[i] = (const float*)d_in[i];
    p.page_table = (const int*)d_in[3]; p.out = (float*)d_out; p.ws = (unsigned char*)d_ws;
#if MK_SINGLE
    p.ph_lo = 0; p.ph_hi = N_PHASES; p.rep = MK_REP;
    hipLaunchKernelGGL(hybrid_fwd, dim3(grid), dim3(NTHREADS), LDS_BYTES, stream, p);
#ifdef MK_EXTRA_PHASE
    p.ph_lo = MK_EXTRA_PHASE; p.ph_hi = MK_EXTRA_PHASE + 1;
    hipLaunchKernelGGL(hybrid_fwd, dim3(grid), dim3(NTHREADS), LDS_BYTES, stream, p);
#endif
#else
    for (int k = 0; k < N_PHASES; ++k) { p.ph_lo = k; p.ph_hi = k + 1; hipLaunchKernelGGL(hybrid_fwd, dim3(grid), dim3(NTHREADS), LDS_BYTES, stream, p); }
#endif
}
```

```cpp
#include <hip/hip_runtime.h>
#include <cstdio>
#include <cstdint>
#include <cmath>
namespace pg8 {
#define PG8_LAS __attribute__((address_space(3)))
typedef unsigned short bf16_t;
typedef short bf16x8 __attribute__((ext_vector_type(8)));
typedef float f32x4 __attribute__((ext_vector_type(4)));
typedef unsigned u32x4 __attribute__((ext_vector_type(4)));
constexpr int BM = 256, BK = 64, HALF = 128, HTB = HALF * BK * 2  , STAGE_BYTES = 8 * HTB, NXCD = 8, WGM = 8;

__host__ __device__ __forceinline__ int lds_byte(int r, int c) { const int st = (r >> 4) * 2 + (c >> 5), rr = r & 15, cc = c & 31, ob = rr * 64 + cc * 2; return st * 1024 + (ob ^ (((ob >> 9) & 1) << 5)); }
__host__ __device__ __forceinline__ void stage_rc(int b, int& R, int& C) { const int st = b / 1024, sb = b % 1024, swz = sb ^ (((sb >> 9) & 1) << 5); R = (st >> 1) * 16 + swz / 64; C = (st & 1) * 32 + (swz % 64) / 2; }
__host__ __device__ __forceinline__ int perm32(int rho) { const int n = rho >> 4, i = rho & 15; return 8 * (i >> 2) + 4 * n + (i & 3); }

struct Unit { int pm, pn; };
struct Gemm { const bf16_t* A; const bf16_t* Bt; int M, N, K; };

struct StaticOrder {
    int nM, nN, nwg, G, c;
    __host__ __device__ void init(int M, int N, int G_, int c_) { nM = M / BM; nN = N / BM; nwg = nM * nN; G = G_; c = c_; }
    __host__ __device__ bool next(int i, Unit& u) const {
        const long L = (long)i * G + c; if (L >= nwg) return false;
        int wgid = (int)L; { const int q = nwg / NXCD, r = nwg % NXCD, xcd = wgid % NXCD, off = wgid / NXCD; wgid = (xcd < r ? xcd * (q + 1) : r * (q + 1) + (xcd - r) * q) + off; }
        const int nig = WGM * nN, gid = wgid / nig, fm = gid * WGM, gsz = (nM - fm) < WGM ? (nM - fm) : WGM;
        u.pm = fm + ((wgid % nig) % gsz); u.pn = (wgid % nig) / gsz; return true;
    }
    __device__ __forceinline__ void a_ready(const Unit&) const {}
    __device__ __forceinline__ void done(const Unit&) const {}
};

template <class Epi, class Sched, bool ALIGN_EPI = false, bool SP2 = false>
__device__ __forceinline__ void gemm_phase(PG8_LAS unsigned char* lds, const Gemm g, const Sched& S, const Epi& E) {
    const int tid = threadIdx.x, wid = __builtin_amdgcn_readfirstlane(tid >> 6), lane = tid & 63, wr = wid >> 2, wc = wid & 3, fr = lane & 15, fq = lane >> 4;
    const int K = g.K, nt = K / BK;
    unsigned voffA[2], voffB[2];
#pragma unroll
    for (int i = 0; i < 2; ++i) { int R, C; stage_rc(tid * 16 + i * 8192, R, C); const int Rb = Epi::PERM ? ((R & ~31) + perm32(R & 31)) : R;
        voffA[i] = (unsigned)(R * K + C) * 2u; voffB[i] = (unsigned)(Rb * K + C) * 2u; }
    const size_t kstep = (size_t)(BK * 2);
    const size_t hstep = (size_t)HALF * K * 2;
    const size_t tstep = 2 * hstep;
    const unsigned ldsw = (unsigned)wid * 1024u;
    const int aoff = lds_byte(wr * 64 + fr, fq * 8), boff = lds_byte(wc * 32 + fr, fq * 8);
#define PG8_SA(b, h) (((b) * 2 + (h)) * HTB)
#define PG8_SB(b, h) ((4 + (b) * 2 + (h)) * HTB)
#define PG8_STAGE(bufoff, gbase, voff) do { _Pragma("unroll") for (int _i = 0; _i < 2; ++_i) \
        __builtin_amdgcn_global_load_lds((const unsigned*)((const char*)(gbase) + (voff)[_i]), (PG8_LAS unsigned*)(lds + (bufoff) + ldsw + _i * 8192), 16, 0, 0); } while (0)
#define PG8_LDA(dst, b, h) do { _Pragma("unroll") for (int m = 0; m < 4; ++m) _Pragma("unroll") for (int k = 0; k < 2; ++k) dst[m][k] = *(const PG8_LAS bf16x8*)(lds + PG8_SA(b, h) + aoff + m * 2048 + k * 1024); } while (0)
#define PG8_LDB(dst, b, h) do { _Pragma("unroll") for (int n = 0; n < 2; ++n) _Pragma("unroll") for (int k = 0; k < 2; ++k) dst[n][k] = *(const PG8_LAS bf16x8*)(lds + PG8_SB(b, h) + boff + n * 2048 + k * 1024); } while (0)
#define PG8_MMA(ai, bj, At, Bt) do { __builtin_amdgcn_s_setprio(1); _Pragma("unroll") for (int m = 0; m < 4; ++m) _Pragma("unroll") for (int n = 0; n < 2; ++n) _Pragma("unroll") for (int k = 0; k < 2; ++k) \
        acc[ai][bj][m][n] = __builtin_amdgcn_mfma_f32_16x16x32_bf16(Bt[n][k], At[m][k], acc[ai][bj][m][n], 0, 0, 0); __builtin_amdgcn_s_setprio(0); } while (0)
#define PG8_WAIT_V(n) asm volatile("s_waitcnt vmcnt(" #n ")" ::: "memory")
#define PG8_WAIT_L(n) asm volatile("s_waitcnt lgkmcnt(" #n ")" ::: "memory")
#define PG8_BAR __builtin_amdgcn_s_barrier()
#define PG8_SCHED __builtin_amdgcn_sched_barrier(0)
    Unit cur, nxt; int ui = 0;
    if (!S.next(0, cur)) return;
    f32x4 acc[2][2][4][2];
#pragma unroll
    for (int a = 0; a < 2; ++a)
#pragma unroll
        for (int b = 0; b < 2; ++b)
#pragma unroll
            for (int m = 0; m < 4; ++m)
#pragma unroll
                for (int n = 0; n < 2; ++n) acc[a][b][m][n] = (f32x4){0.f, 0.f, 0.f, 0.f};
    bf16x8 At[4][2], B0[2][2], B1[2][2];
    const char* cA = (const char*)g.A + (size_t)cur.pm * tstep; const char* cB = (const char*)g.Bt + (size_t)cur.pn * tstep;
    S.a_ready(cur);
    if constexpr (SP2) {
        PG8_STAGE(PG8_SB(0, 0), cB, voffB); PG8_STAGE(PG8_SB(0, 1), cB + hstep, voffB); PG8_STAGE(PG8_SA(0, 0), cA, voffA); PG8_STAGE(PG8_SA(0, 1), cA + hstep, voffA);
        if (wr == 1) PG8_BAR;
        PG8_WAIT_V(2); PG8_BAR;
        PG8_STAGE(PG8_SB(1, 0), cB + kstep, voffB); PG8_STAGE(PG8_SA(1, 0), cA + kstep, voffA); PG8_STAGE(PG8_SB(1, 1), cB + hstep + kstep, voffB);
        PG8_WAIT_V(6); PG8_BAR;
    } else {
        PG8_STAGE(PG8_SB(0, 0), cB, voffB); PG8_STAGE(PG8_SA(0, 0), cA, voffA); PG8_STAGE(PG8_SB(0, 1), cB + hstep, voffB); PG8_STAGE(PG8_SA(0, 1), cA + hstep, voffA);
        if (wr == 1) PG8_BAR;
        PG8_WAIT_V(4); PG8_BAR;
        PG8_STAGE(PG8_SB(1, 0), cB + kstep, voffB); PG8_STAGE(PG8_SA(1, 0), cA + kstep, voffA); PG8_STAGE(PG8_SB(1, 1), cB + hstep + kstep, voffB);
        PG8_WAIT_V(6); PG8_BAR;
    }
    for (;;) {
        const bool has_next = S.next(ui + 1, nxt);
        const char* nA = has_next ? (const char*)g.A + (size_t)nxt.pm * tstep : cA; const char* nB = has_next ? (const char*)g.Bt + (size_t)nxt.pn * tstep : cB;
        for (int t = 0; t < nt; t += 2) {
            const bool last = (t == nt - 2);
            const char* a1 = cA + (size_t)(t + 1) * kstep;
            const char* a2 = last ? nA : cA + (size_t)(t + 2) * kstep; const char* b2 = last ? nB : cB + (size_t)(t + 2) * kstep;
            const char* a3 = a2 + kstep; const char* b3 = b2 + kstep;
            if (last && has_next) S.a_ready(nxt);
            if constexpr (SP2) {
            PG8_LDB(B0, 0, 0); PG8_LDB(B1, 0, 1); PG8_SCHED; PG8_LDA(At, 0, 0); PG8_STAGE(PG8_SA(1, 1), a1 + hstep, voffA);
            PG8_WAIT_V(8); PG8_WAIT_L(0); PG8_BAR; PG8_MMA(0, 0, At, B0); PG8_MMA(0, 1, At, B1); PG8_BAR; PG8_SCHED;
            PG8_LDA(At, 0, 1); PG8_STAGE(PG8_SB(0, 0), b2, voffB); PG8_STAGE(PG8_SB(0, 1), b2 + hstep, voffB); PG8_STAGE(PG8_SA(0, 0), a2, voffA);
            PG8_WAIT_V(8); PG8_WAIT_L(0); PG8_BAR; PG8_MMA(1, 0, At, B0); PG8_MMA(1, 1, At, B1); PG8_BAR; PG8_SCHED;
            PG8_LDB(B0, 1, 0); PG8_LDB(B1, 1, 1); PG8_SCHED; PG8_LDA(At, 1, 0); PG8_STAGE(PG8_SA(0, 1), a2 + hstep, voffA);
            PG8_WAIT_V(8); PG8_WAIT_L(0); PG8_BAR; PG8_MMA(0, 0, At, B0); PG8_MMA(0, 1, At, B1); PG8_BAR; PG8_SCHED;
            PG8_LDA(At, 1, 1); PG8_STAGE(PG8_SB(1, 0), b3, voffB); PG8_STAGE(PG8_SB(1, 1), b3 + hstep, voffB); PG8_STAGE(PG8_SA(1, 0), a3, voffA);
            PG8_WAIT_V(8); PG8_WAIT_L(0); PG8_BAR; PG8_MMA(1, 0, At, B0); PG8_MMA(1, 1, At, B1); PG8_BAR; PG8_SCHED;
            } else {
            PG8_LDB(B0, 0, 0); PG8_SCHED; PG8_LDA(At, 0, 0); PG8_STAGE(PG8_SA(1, 1), a1 + hstep, voffA);
            PG8_WAIT_L(8); PG8_BAR; PG8_WAIT_L(0); PG8_MMA(0, 0, At, B0); PG8_BAR; PG8_SCHED;
            PG8_LDB(B1, 0, 1); PG8_STAGE(PG8_SB(0, 0), b2, voffB);
            PG8_BAR; PG8_WAIT_L(0); PG8_MMA(0, 1, At, B1); PG8_BAR;
            PG8_LDA(At, 0, 1); PG8_STAGE(PG8_SA(0, 0), a2, voffA);
            PG8_BAR; PG8_WAIT_L(0); PG8_MMA(1, 0, At, B0); PG8_BAR; PG8_SCHED;
            PG8_STAGE(PG8_SB(0, 1), b2 + hstep, voffB);
            PG8_WAIT_V(6); PG8_BAR; PG8_MMA(1, 1, At, B1); PG8_BAR;
            PG8_LDB(B0, 1, 0); PG8_SCHED; PG8_LDA(At, 1, 0); PG8_STAGE(PG8_SA(0, 1), a2 + hstep, voffA);
            PG8_WAIT_L(8); PG8_BAR; PG8_WAIT_L(0); PG8_MMA(0, 0, At, B0); PG8_BAR; PG8_SCHED;
            PG8_LDB(B1, 1, 1); PG8_STAGE(PG8_SB(1, 0), b3, voffB);
            PG8_BAR; PG8_WAIT_L(0); PG8_MMA(0, 1, At, B1); PG8_BAR;
            PG8_LDA(At, 1, 1); PG8_STAGE(PG8_SA(1, 0), a3, voffA);
            PG8_BAR; PG8_WAIT_L(0); PG8_MMA(1, 0, At, B0); PG8_BAR; PG8_SCHED;
            PG8_STAGE(PG8_SB(1, 1), b3 + hstep, voffB);
            PG8_WAIT_V(6); PG8_BAR; PG8_MMA(1, 1, At, B1); PG8_BAR;
            }
        }
        if constexpr (ALIGN_EPI) { if (wr == 0) PG8_BAR; }
        if constexpr (!Epi::AFTER_DRAIN) { E(acc, cur, wr, wc, fr, fq); S.done(cur); }
        if (!has_next) break;
#pragma unroll
        for (int a = 0; a < 2; ++a)
#pragma unroll
            for (int b = 0; b < 2; ++b)
#pragma unroll
                for (int m = 0; m < 4; ++m)
#pragma unroll
                    for (int n = 0; n < 2; ++n) acc[a][b][m][n] = (f32x4){0.f, 0.f, 0.f, 0.f};
        cur = nxt; cA = nA; cB = nB; ++ui;
        if constexpr (ALIGN_EPI) { if (wr == 1) PG8_BAR; }
    }
    PG8_WAIT_V(0);
    if constexpr (!ALIGN_EPI) { if (wr == 0) PG8_BAR; }
    PG8_BAR;
    if constexpr (Epi::AFTER_DRAIN) { E.fused(acc, cur, wr, wc, fr, fq, lds, wid, lane); S.done(cur); }
#undef PG8_SA
#undef PG8_SB
#undef PG8_STAGE
#undef PG8_LDA
#undef PG8_LDB
#undef PG8_MMA
#undef PG8_WAIT_V
#undef PG8_WAIT_L
#undef PG8_BAR
#undef PG8_SCHED
}
}
#define GAS __attribute__((address_space(1)))
#define LAS __attribute__((address_space(3)))
typedef unsigned short bf16;
typedef unsigned v4u __attribute__((ext_vector_type(4)));
typedef float f32x4 __attribute__((ext_vector_type(4)));
typedef short bf16x8 __attribute__((ext_vector_type(8)));
typedef GAS unsigned gu32;
typedef GAS unsigned long long gu64;
#define RLX_AGENT __ATOMIC_RELAXED, __HIP_MEMORY_SCOPE_AGENT
#define LDS_WAIT() asm volatile("s_waitcnt lgkmcnt(0)" ::: "memory")
#define VM_WAIT() asm volatile("s_waitcnt vmcnt(0)" ::: "memory")
__device__ __forceinline__ unsigned long long rt() { return __builtin_amdgcn_s_memrealtime(); }
__device__ __forceinline__ unsigned f2bf(float f) { unsigned u = __builtin_bit_cast(unsigned, f); return (u + 0x7fffu + ((u >> 16) & 1u)) >> 16; }
__device__ __forceinline__ unsigned pk2(float lo, float hi) { return f2bf(lo) | (f2bf(hi) << 16); }

#define XB_TMO      128
#define XB_XCNT(j)  (256  + 64 * (j))
#define XB_XSUB(j)  (1280 + 64 * (j))
#define XB_XGEN(j)  (2304 + 64 * (j))
#define XB_TOP      3328
#define XB_TOPGEN   3392
#define XCD_BAR_WORDS 3456
#define XB_SPIN_CAP (1u << 18)

__device__ __forceinline__ unsigned xb_ld(unsigned* p)              { return __hip_atomic_load(p, __ATOMIC_RELAXED, __HIP_MEMORY_SCOPE_AGENT); }
__device__ __forceinline__ unsigned xb_add(unsigned* p, unsigned v) { return __hip_atomic_fetch_add(p, v, __ATOMIC_RELAXED, __HIP_MEMORY_SCOPE_AGENT); }
__device__ __forceinline__ unsigned xb_xcc_id() { return (unsigned)__builtin_amdgcn_s_getreg((3 << 11) | 20) & 0xFu; }
#define XB_SPIN(cond, bar) do { unsigned _sp = 0; while (cond) { __builtin_amdgcn_s_sleep(1); \
    if ((++_sp & 255u) == 0u) { if (xb_ld(&(bar)[XB_TMO])) break; if (_sp > XB_SPIN_CAP) { atomicAdd(&(bar)[XB_TMO], 1u); break; } } } } while (0)

struct XcdBarrier {
    unsigned* bar; unsigned x;
    volatile LAS unsigned* st;
};

__device__ __forceinline__ XcdBarrier xcd_barrier_post(unsigned* bar, volatile LAS unsigned* st) {
    XcdBarrier b; b.bar = bar; b.x = xb_xcc_id(); b.st = st;
    if (threadIdx.x == 0) (void)xb_add(&bar[XB_XCNT(b.x)], 1u);
    return b;
}
__device__ __forceinline__ void xcd_barrier_complete(unsigned* bar, unsigned x, unsigned& nloc, unsigned& nx) {
    const unsigned G = gridDim.x * gridDim.y * gridDim.z;
    unsigned sum, cnt, mine, sp = 0u;
    for (;;) {
        sum = 0u; cnt = 0u; mine = 0u;
#pragma unroll
        for (unsigned j = 0; j < 16; ++j) { const unsigned c = xb_ld(&bar[XB_XCNT(j)]); sum += c; cnt += (c > 0u) ? 1u : 0u; mine = (j == x) ? c : mine; }
        if (sum == G) break;
        __builtin_amdgcn_s_sleep(1);
        if ((++sp & 255u) == 0u) { if (xb_ld(&bar[XB_TMO])) break; if (sp > XB_SPIN_CAP) { atomicAdd(&bar[XB_TMO], 1u); break; } }
    }
    nloc = mine > 0u ? mine : 1u; nx = cnt > 0u ? cnt : 1u;
}

__device__ __forceinline__ void xcd_barrier(const XcdBarrier& b) {
    asm volatile("s_waitcnt vmcnt(0)" ::: "memory");
    __syncthreads();
    if (threadIdx.x == 0) {
        unsigned* bar = b.bar;
        __builtin_amdgcn_s_waitcnt(0);
        unsigned nloc = b.st[0], nx = b.st[1];
        if (nloc == 0u) { xcd_barrier_complete(bar, b.x, nloc, nx); b.st[0] = nloc; b.st[1] = nx; }
        const unsigned old = xb_add(&bar[XB_XSUB(b.x)], 1u);
        const unsigned gen = old / nloc;
        if (old + 1u == (gen + 1u) * nloc) {
            __builtin_amdgcn_fence(__ATOMIC_RELEASE, "agent");
            asm volatile("s_waitcnt vmcnt(0)" ::: "memory");
            const unsigned og = xb_add(&bar[XB_TOP], 1u);
            const unsigned tg = og / nx;
            if (og + 1u == (tg + 1u) * nx) xb_add(&bar[XB_TOPGEN], 1u);
            else XB_SPIN(xb_ld(&bar[XB_TOPGEN]) == tg, bar);
            __builtin_amdgcn_fence(__ATOMIC_ACQUIRE, "agent");
            xb_add(&bar[XB_XGEN(b.x)], 1u);
            asm volatile("s_waitcnt vmcnt(0)" ::: "memory");
        } else {
            XB_SPIN(xb_ld(&bar[XB_XGEN(b.x)]) == gen, bar);
            __builtin_amdgcn_fence(__ATOMIC_ACQUIRE, "agent");
            asm volatile("s_waitcnt vmcnt(0)" ::: "memory");
        }
    }
    __syncthreads();
}

constexpr int NWAVES = 8, NTHREADS = 512;
constexpr int DM = 1024, BATCH_P = 8, SEQ = 2048, MP = BATCH_P * SEQ  , BS = 128  ;
constexpr int MROWS = MP + BS  , MPAD = 16640  ;
constexpr int NH = 8, NG = 2, NR = 4, HD = 64, NSAW = 512, KVW = 128;
constexpr int HGH = 4, HGD = 128, HGW = 512;
constexpr int DFF = 2816, CIN = 5400, NIN = 5632  ;
constexpr int PAST = 2048, PAGE = 128, NPAGES = 16, WIN = 512;
constexpr float EPS = 1e-6f, LOG2E = 1.4426950408889634f;
constexpr float QSCALE = 0.125f * LOG2E;
constexpr float HG_SCALE = 0.08838834764831845f;

constexpr size_t OFF_Y = 0, OFF_KV = 16908288, OFF_WINP = 25362432, OFF_WINS = 26411008, OFF_HGP = 43188224, OFF_HGS = 43712512,
                 OFF_CVP = 52101120, OFF_CVS = 52146176, OUT_TOTAL = 52867072;

typedef unsigned short bf16_t;
typedef short bf16x8 __attribute__((ext_vector_type(8)));
typedef short s16x4 __attribute__((ext_vector_type(4)));
typedef float f32x4 __attribute__((ext_vector_type(4)));
typedef float f32x2 __attribute__((ext_vector_type(2)));
typedef float f32x16 __attribute__((ext_vector_type(16)));
typedef unsigned u32x4 __attribute__((ext_vector_type(4)));
typedef unsigned u32x2 __attribute__((ext_vector_type(2)));
#define DI __device__ __forceinline__

typedef __bf16 hw_bf16x2 __attribute__((ext_vector_type(2)));
DI unsigned pkbf(float lo, float hi) { const f32x2 v = {lo, hi}; return __builtin_bit_cast(unsigned, __builtin_convertvector(v, hw_bf16x2)); }
#define pk2 pkbf
DI float bf2f(unsigned short b) { return __builtin_bit_cast(float, (unsigned)b << 16); }
DI float bflo(unsigned w) { return __builtin_bit_cast(float, w << 16); }
DI float bfhi(unsigned w) { return __builtin_bit_cast(float, w & 0xffff0000u); }
DI float sigmoidf_(float x) { return __builtin_amdgcn_rcpf(1.f + __expf(-x)); }
DI float siluf_(float x) { return x * __builtin_amdgcn_rcpf(1.f + __expf(-x)); }
template <int CTRL> DI float dppf(float x) { return __int_as_float(__builtin_amdgcn_update_dpp(0, __float_as_int(x), CTRL, 0xf, 0xf, true)); }
template <int CTRL> DI unsigned dppu(unsigned x) { return (unsigned)__builtin_amdgcn_update_dpp(0, (int)x, CTRL, 0xf, 0xf, true); }
DI float row16_sum(float s) { s += dppf<0xB1>(s); s += dppf<0x4E>(s); s += dppf<0x141>(s); s += dppf<0x140>(s); return s; }
DI float row16_max(float s) { s = fmaxf(s, dppf<0xB1>(s)); s = fmaxf(s, dppf<0x4E>(s)); s = fmaxf(s, dppf<0x141>(s)); s = fmaxf(s, dppf<0x140>(s)); return s; }
DI float x16_sum(float v) { auto rr = __builtin_amdgcn_permlane16_swap(__float_as_uint(v), __float_as_uint(v), false, false); return __uint_as_float(rr[0]) + __uint_as_float(rr[1]); }
DI float x32_sum(float v) { auto rr = __builtin_amdgcn_permlane32_swap(__float_as_uint(v), __float_as_uint(v), false, false); return __uint_as_float(rr[0]) + __uint_as_float(rr[1]); }
DI float x16_max(float v) { auto rr = __builtin_amdgcn_permlane16_swap(__float_as_uint(v), __float_as_uint(v), false, false); return fmaxf(__uint_as_float(rr[0]), __uint_as_float(rr[1])); }
DI float x32_max(float v) { auto rr = __builtin_amdgcn_permlane32_swap(__float_as_uint(v), __float_as_uint(v), false, false); return fmaxf(__uint_as_float(rr[0]), __uint_as_float(rr[1])); }
DI float wave_sum(float v) { return x32_sum(x16_sum(row16_sum(v))); }
DI float wave_max(float v) { return x32_max(x16_max(row16_max(v))); }
DI bf16x8 pack8(const float* v) { u32x4 p; p.x = pk2(v[0], v[1]); p.y = pk2(v[2], v[3]); p.z = pk2(v[4], v[5]); p.w = pk2(v[6], v[7]); return __builtin_bit_cast(bf16x8, p); }
DI bf16x8 pack8v(f32x4 a, f32x4 b) { u32x4 p; p.x = pk2(a[0], a[1]); p.y = pk2(a[2], a[3]); p.z = pk2(b[0], b[1]); p.w = pk2(b[2], b[3]); return __builtin_bit_cast(bf16x8, p); }
#define MFMA16(a, b, c) __builtin_amdgcn_mfma_f32_16x16x32_bf16((a), (b), (c), 0, 0, 0)
#define MFMA32(a, b, c) __builtin_amdgcn_mfma_f32_32x32x16_bf16((a), (b), (c), 0, 0, 0)
#define LAS __attribute__((address_space(3)))
typedef short v4i16_t __attribute__((ext_vector_type(4)));
DI s16x4 tr_read(const LAS void* p) { return __builtin_bit_cast(s16x4, __builtin_amdgcn_ds_read_tr16_b64_v4i16((LAS v4i16_t*)p)); }
DI bf16x8 cat44(s16x4 lo, s16x4 hi) { return __builtin_shufflevector(lo, hi, 0, 1, 2, 3, 4, 5, 6, 7); }

constexpr size_t MiB = 1u << 20;
constexpr size_t WS_CTL = 0, CTL_ZERO_BYTES = 1 * MiB;
constexpr size_t WS_WIN = 2 * MiB;
constexpr size_t WS_WA = 14 * MiB, WS_WB = 15 * MiB;
constexpr size_t WS_WO = 16 * MiB;
constexpr size_t WS_WG = 18 * MiB, WS_WU = 24 * MiB, WS_WD = 30 * MiB;
constexpr size_t WS_W1K = 36 * MiB, WS_W1V = 37 * MiB;
constexpr size_t WS_XN = 40 * MiB;
constexpr size_t WS_Q = 76 * MiB;
constexpr size_t WS_KVB = 94 * MiB;
constexpr size_t WS_HQ = 112 * MiB, WS_HI = 130 * MiB, WS_HGT = 148 * MiB;
constexpr size_t WS_GL = 166 * MiB;
constexpr size_t WS_MG = 200 * MiB;
constexpr size_t WS_GATES = 266 * MiB;
constexpr size_t WS_CKP = 268 * MiB, WS_CVP = 269 * MiB;
constexpr size_t WS_CKS = 270 * MiB, WS_CVS = 275 * MiB;
constexpr size_t WS_SLOC = 280 * MiB;
constexpr size_t WS_GD = 297 * MiB;
constexpr size_t WS_ONSA = 298 * MiB, WS_OHG = 316 * MiB;
constexpr size_t WS_T = 334 * MiB;
constexpr size_t WS_MB = 400 * MiB;
constexpr size_t WS_SSQ = 434 * MiB;
constexpr size_t WS_G = 436 * MiB;
constexpr size_t WS_H = 527 * MiB;
constexpr size_t WS_END = 618 * MiB;
constexpr int CW_BAR = 4096;

constexpr int RING_BYTES = 131072;
constexpr int LDS_BYTES = 147456;
constexpr int MISC_OFF = LDS_BYTES - 256;

struct KParams {
    const float* in[27];
    const int* page_table;
    float* out;
    unsigned char* ws;
    int ph_lo, ph_hi;
    int rep, pad_;
};

#ifndef MK_REP_BIT
#define MK_REP_BIT (-1)
#endif
#define MK_REP 0
#define REP_LOOP(k) _Pragma("nounroll") for (int rp_ = 0; rp_ < (((k) == MK_REP_BIT) ? 2 : 1); ++rp_)

DI void p0_transpose_item(const float* W, int K, int N, bf16_t* WT, int prow0, int src_col0, int nvalid, int k0, LAS float* scr, int lane, const float* kscale = nullptr) {
    float tv[32];
#pragma unroll
    for (int i = 0; i < 32; ++i) { const int kk = 2 * i + (lane >> 5), c = lane & 31; tv[i] = (c < nvalid) ? W[(size_t)(k0 + kk) * N + src_col0 + c] : 0.f; }
#pragma unroll
    for (int i = 0; i < 32; ++i) { const int kk = 2 * i + (lane >> 5), c = lane & 31; scr[kk * 33 + c] = kscale ? tv[i] * kscale[k0 + kk] : tv[i]; }
    asm volatile("s_waitcnt lgkmcnt(0)" ::: "memory");
    const int c = lane & 7;
#pragma unroll
    for (int j = 0; j < 4; ++j) { const int n = (lane >> 3) + 8 * j; const LAS float* s = scr + (8 * c) * 33 + n;
        u32x4 o; o.x = pk2(s[0 * 33], s[1 * 33]); o.y = pk2(s[2 * 33], s[3 * 33]); o.z = pk2(s[4 * 33], s[5 * 33]); o.w = pk2(s[6 * 33], s[7 * 33]);
        *(u32x4*)(WT + (size_t)(prow0 + n) * K + k0 + 8 * c) = o; }
    asm volatile("s_waitcnt lgkmcnt(0)" ::: "memory");
}
DI void inproj_src(int p0, int& src, int& nvalid) {
    const int pn = p0 >> 8, within = p0 & 255, bj = within >> 7, wc = (within >> 5) & 3;
    nvalid = 32;
    if (pn < 5) src = 64 * (4 * pn + wc) + 32 * bj;
    else if (pn < 21) src = p0 + 24;
    else { src = 1280; nvalid = (within < 32) ? 24 : 0; }
}
DI void rms_row_to_bf16(const float* xrow, const float* g, bf16_t* orow, int lane) {
    const f32x4* xr = (const f32x4*)xrow + lane; const f32x4* gr = (const f32x4*)g + lane;
    f32x4 v[4]; float s = 0.f;
#pragma unroll
    for (int j = 0; j < 4; ++j) { v[j] = xr[64 * j]; s += (v[j].x * v[j].x + v[j].y * v[j].y) + (v[j].z * v[j].z + v[j].w * v[j].w); }
    const float rs = 1.f / sqrtf(wave_sum(s) * (1.f / DM) + EPS);
    unsigned long long* o8 = (unsigned long long*)orow + lane;
#pragma unroll
    for (int j = 0; j < 4; ++j) { const f32x4 gg = gr[64 * j];
        o8[64 * j] = (unsigned long long)pk2(v[j].x * rs * gg.x, v[j].y * rs * gg.y) | ((unsigned long long)pk2(v[j].z * rs * gg.z, v[j].w * rs * gg.w) << 32); }
}
DI void rms_2rows_to_bf16(const float* xa, const float* xb, const float* g, bf16_t* oa, bf16_t* ob, int lane) {
    const f32x4* pa = (const f32x4*)xa + lane; const f32x4* pb = (const f32x4*)xb + lane; const f32x4* gr = (const f32x4*)g + lane;
    f32x4 va[4], vb[4], gg[4]; float sa = 0.f, sb = 0.f;
#pragma unroll
    for (int j = 0; j < 4; ++j) { va[j] = pa[64 * j]; vb[j] = pb[64 * j]; gg[j] = gr[64 * j]; }
#pragma unroll
    for (int j = 0; j < 4; ++j) { sa += (va[j].x * va[j].x + va[j].y * va[j].y) + (va[j].z * va[j].z + va[j].w * va[j].w); sb += (vb[j].x * vb[j].x + vb[j].y * vb[j].y) + (vb[j].z * vb[j].z + vb[j].w * vb[j].w); }
    const float ra = 1.f / sqrtf(wave_sum(sa) * (1.f / DM) + EPS), rb = 1.f / sqrtf(wave_sum(sb) * (1.f / DM) + EPS);
    unsigned long long* o8a = (unsigned long long*)oa + lane; unsigned long long* o8b = (unsigned long long*)ob + lane;
#pragma unroll
    for (int j = 0; j < 4; ++j) {
        o8a[64 * j] = (unsigned long long)pk2(va[j].x * ra * gg[j].x, va[j].y * ra * gg[j].y) | ((unsigned long long)pk2(va[j].z * ra * gg[j].z, va[j].w * ra * gg[j].w) << 32);
        o8b[64 * j] = (unsigned long long)pk2(vb[j].x * rb * gg[j].x, vb[j].y * rb * gg[j].y) | ((unsigned long long)pk2(vb[j].z * rb * gg[j].z, vb[j].w * rb * gg[j].w) << 32); }
}
struct P0Args {
    const float *w_in, *w_a, *w_b, *w_o, *w_g, *w_u, *w_d, *w1k, *w1v, *xp, *xs, *g1, *g2;
    bf16_t *WIN, *WA, *WB, *WO, *WG, *WU, *WD, *W1K, *W1V, *XN;
};
DI void p0_prologue(const P0Args& a, LAS unsigned char* lds, int gw, int NGW, int lane, int wave) {
    LAS float* scr = (LAS float*)(lds + wave * 16384);
    constexpr int I_IN = 16 * (NIN / 32), I_A = 8 * 32, I_O = 16 * 32, I_G = 16 * (DFF / 32), I_D = (DFF / 64) * 32, I_W1 = 32 * 2;
    constexpr int NITEMS = I_IN + 2 * I_A + I_O + 2 * I_G + I_D + 2 * I_W1;
    for (int it = gw; it < NITEMS; it += NGW) {
        int r = it;
        if (r < I_IN) { const int nb = NIN / 32, kb = r / nb, pb = r % nb; int src, nv; inproj_src(pb * 32, src, nv);
            p0_transpose_item(a.w_in, DM, CIN, a.WIN, pb * 32, src, nv, kb * 64, scr, lane); continue; } r -= I_IN;
        if (r < I_A) { const int kb = r / 32, pb = r % 32; p0_transpose_item(a.w_a, NSAW, DM, a.WA, pb * 32, pb * 32, 32, kb * 64, scr, lane); continue; } r -= I_A;
        if (r < I_A) { const int kb = r / 32, pb = r % 32; p0_transpose_item(a.w_b, HGW, DM, a.WB, pb * 32, pb * 32, 32, kb * 64, scr, lane); continue; } r -= I_A;
        if (r < I_O) { const int kb = r / 32, pb = r % 32; p0_transpose_item(a.w_o, DM, DM, a.WO, pb * 32, pb * 32, 32, kb * 64, scr, lane); continue; } r -= I_O;
        if (r < 2 * I_G) { const int nb = 2 * DFF / 32, kb = r / nb, pb = r % nb, pn = pb >> 3, w = pb & 7;
            p0_transpose_item(w < 4 ? a.w_g : a.w_u, DM, DFF, a.WG, pb * 32, 128 * pn + 32 * (w & 3), 32, kb * 64, scr, lane, a.g2); continue; } r -= 2 * I_G;
        if (r < I_D) { const int kb = r / 32, pb = r % 32; p0_transpose_item(a.w_d, DFF, DM, a.WD, pb * 32, pb * 32, 32, kb * 64, scr, lane); continue; } r -= I_D;
        if (r < I_W1) { const int kb = r / 2, pb = r % 2; p0_transpose_item(a.w1k, 2048, 64, a.W1K, pb * 32, pb * 32, 32, kb * 64, scr, lane); continue; } r -= I_W1;
        { const int kb = r / 2, pb = r % 2; p0_transpose_item(a.w1v, 2048, 64, a.W1V, pb * 32, pb * 32, 32, kb * 64, scr, lane); }
    }
    for (int m = gw; m < MROWS; m += 2 * NGW) {
        const int m2 = m + NGW; const bool two = m2 < MROWS;
        const float* xr = (m < MP) ? a.xp + (size_t)m * DM : a.xs + (size_t)(m - MP) * DM;
        const float* xr2 = two ? ((m2 < MP) ? a.xp + (size_t)m2 * DM : a.xs + (size_t)(m2 - MP) * DM) : xr;
        rms_2rows_to_bf16(xr, xr2, a.g1, a.XN + (size_t)m * DM, a.XN + (size_t)(two ? m2 : m) * DM, lane);
    }
}

typedef const f32x4 (&AccRef)[2][2][4][2];
DI void st_bf4(bf16_t* p, f32x4 v) { u32x2 w; w.x = pk2(v[0], v[1]); w.y = pk2(v[2], v[3]); *(u32x2*)p = w; }
DI f32x4 ld_bf4(const bf16_t* p) { const u32x2 w = *(const u32x2*)p; return (f32x4){bflo(w.x), bfhi(w.x), bflo(w.y), bfhi(w.y)}; }
DI f32x4 sig4(f32x4 v) { return (f32x4){sigmoidf_(v[0]), sigmoidf_(v[1]), sigmoidf_(v[2]), sigmoidf_(v[3])}; }

DI void st_bf8(bf16_t* p, f32x4 a, f32x4 b) { u32x4 w; w.x = pk2(a[0], a[1]); w.y = pk2(a[2], a[3]); w.z = pk2(b[0], b[1]); w.w = pk2(b[2], b[3]); *(u32x4*)p = w; }
struct EpiInProj {
    static constexpr bool PERM = true, AFTER_DRAIN = false;
    bf16_t *Q, *KVB, *HQ, *HI, *HGT, *MG; float *GL, *GATES, *out; const float *qg, *kg, *lbl;
    DI void operator()(AccRef acc, const pg8::Unit& u, int wr, int wc, int fr, int fq) const {
        const int pn = u.pn, rbase = u.pm * 256 + wr * 64 + fr;
        if (pn < 5) {
            const int hu = 4 * pn + wc;
            const int uu0 = hu - 8, slot0 = uu0 >> 1;
            const float* gsrc = (hu < 8) ? qg : kg + (slot0 == 2 ? 64 : 128);
            f32x4 gn4[2][2];
#pragma unroll
            for (int bj = 0; bj < 2; ++bj)
#pragma unroll
                for (int n = 0; n < 2; ++n) gn4[bj][n] = *(const f32x4*)(gsrc + 32 * bj + 8 * fq + 4 * n);
#pragma unroll
            for (int ai = 0; ai < 2; ++ai)
#pragma unroll
                for (int m = 0; m < 4; ++m) {
                    const int row = rbase + ai * 128 + m * 16;
                    float ss = 0.f;
#pragma unroll
                    for (int bj = 0; bj < 2; ++bj)
#pragma unroll
                        for (int n = 0; n < 2; ++n) { const f32x4 x = acc[ai][bj][m][n]; ss += (x[0] * x[0] + x[1] * x[1]) + (x[2] * x[2] + x[3] * x[3]); }
                    ss = x32_sum(x16_sum(ss));
                    if (row >= MROWS) continue;
                    const float rs = __builtin_amdgcn_rsqf(ss * (1.f / 64.f) + EPS);
                    if (hu < 8) {
#pragma unroll
                        for (int bj = 0; bj < 2; ++bj) st_bf8(Q + (size_t)row * NSAW + hu * 64 + 32 * bj + 8 * fq, acc[ai][bj][m][0] * gn4[bj][0] * (rs * QSCALE), acc[ai][bj][m][1] * gn4[bj][1] * (rs * QSCALE));
                    } else {
                        const int uu = hu - 8, slot = uu >> 1, g = uu & 1; const bool normed = (slot == 2 || slot == 4);
                        float* fdst;
                        if (slot < 4) fdst = out + OFF_KV + ((size_t)row * 4 + slot) * 128 + g * 64;
                        else if (row < MP) { const int b = row >> 11, t = row & 2047; fdst = (t >= SEQ - WIN) ? out + OFF_WINP + (((size_t)b * WIN + (t - (SEQ - WIN))) * 2 + (slot - 4)) * 128 + g * 64 : nullptr; }
                        else fdst = out + OFF_WINS + (((size_t)(row - MP) * WIN + (WIN - 1)) * 2 + (slot - 4)) * 128 + g * 64;
#pragma unroll
                        for (int bj = 0; bj < 2; ++bj) { const int d = 32 * bj + 8 * fq; f32x4 v0 = acc[ai][bj][m][0], v1 = acc[ai][bj][m][1];
                            if (normed) { v0 = v0 * gn4[bj][0] * rs; v1 = v1 * gn4[bj][1] * rs; }
                            if (fdst) { *(f32x4*)(fdst + d) = v0; *(f32x4*)(fdst + d + 4) = v1; }
                            if (slot >= 2) st_bf8(KVB + (size_t)row * 512 + (slot - 2) * 128 + g * 64 + d, v0, v1); }
                    }
                }
        } else if (pn < 21) {
            const int kind = (pn < 13) ? ((pn - 5) >> 1) : 4, cb = (pn < 13) ? 256 * ((pn - 5) & 1) : 256 * (pn - 13);
            f32x4 lb4[2][2];
            if (kind == 1) {
#pragma unroll
                for (int bj = 0; bj < 2; ++bj)
#pragma unroll
                    for (int n = 0; n < 2; ++n) { const int c = cb + 128 * bj + 32 * wc + 8 * fq + 4 * n; const f32x4 l0 = *(const f32x4*)(lbl + c), l1 = *(const f32x4*)(lbl + HGW + c);
#pragma unroll
                        for (int j = 0; j < 4; ++j) lb4[bj][n][j] = __builtin_amdgcn_rcpf(1.f + __expf(l1[j] - l0[j])); }
            }
#pragma unroll
            for (int ai = 0; ai < 2; ++ai)
#pragma unroll
                for (int m = 0; m < 4; ++m) {
                    const int row = rbase + ai * 128 + m * 16;
                    if (row >= MROWS) continue;
#pragma unroll
                    for (int bj = 0; bj < 2; ++bj) { const int c = cb + 128 * bj + 32 * wc + 8 * fq; const f32x4 x0 = acc[ai][bj][m][0], x1 = acc[ai][bj][m][1];
                        if (kind == 0) st_bf8(HQ + (size_t)row * HGW + c, x0 * HG_SCALE, x1 * HG_SCALE);
                        else if (kind == 1) { f32x4 o0, o1;
#pragma unroll
                            for (int j = 0; j < 4; ++j) { const float la = lb4[bj][0][j], lb = lb4[bj][1][j];
                                o0[j] = __logf(la + (1.f - la) * __builtin_amdgcn_rcpf(1.f + __expf(-x0[j]))); o1[j] = __logf(lb + (1.f - lb) * __builtin_amdgcn_rcpf(1.f + __expf(-x1[j]))); }
                            *(f32x4*)(GL + (size_t)row * HGW + c) = o0; *(f32x4*)(GL + (size_t)row * HGW + c + 4) = o1; }
                        else if (kind == 2) st_bf8(HI + (size_t)row * HGW + c, x0, x1);
                        else if (kind == 3) st_bf8(HGT + (size_t)row * HGW + c, x0, x1);
                        else st_bf8(MG + (size_t)row * 2048 + c, x0, x1); }
                }
        } else {
            if (wc == 0 && fq < 3) {
#pragma unroll
                for (int ai = 0; ai < 2; ++ai)
#pragma unroll
                    for (int m = 0; m < 4; ++m) {
                        const int row = rbase + ai * 128 + m * 16;
                        if (row >= MROWS) continue;
                        *(f32x4*)(GATES + (size_t)row * 24 + 8 * fq) = sig4(acc[ai][0][m][0]);
                        *(f32x4*)(GATES + (size_t)row * 24 + 8 * fq + 4) = sig4(acc[ai][0][m][1]);
                    }
            }
        }
    }
};

DI void bf8_to_f32(u32x4 w, f32x4& a, f32x4& b) { a = (f32x4){bflo(w.x), bfhi(w.x), bflo(w.y), bfhi(w.y)}; b = (f32x4){bflo(w.z), bfhi(w.z), bflo(w.w), bfhi(w.w)}; }
struct EpiMergeB {
    static constexpr bool PERM = true, AFTER_DRAIN = false;
    const bf16_t* MG; bf16_t* T;
    DI void operator()(AccRef acc, const pg8::Unit& u, int wr, int wc, int fr, int fq) const {
        const int rbase = u.pm * 256 + wr * 64 + fr, cbase = u.pn * 256 + 32 * wc + 8 * fq;
        u32x4 gv[2][4][2];
#pragma unroll
        for (int ai = 0; ai < 2; ++ai)
#pragma unroll
            for (int m = 0; m < 4; ++m)
#pragma unroll
                for (int bj = 0; bj < 2; ++bj) gv[ai][m][bj] = *(const u32x4*)(MG + (size_t)(rbase + ai * 128 + m * 16) * 2048 + DM + cbase + 128 * bj);
#pragma unroll
        for (int ai = 0; ai < 2; ++ai)
#pragma unroll
            for (int m = 0; m < 4; ++m)
#pragma unroll
                for (int bj = 0; bj < 2; ++bj) { f32x4 g0, g1; bf8_to_f32(gv[ai][m][bj], g0, g1);
                    st_bf8(T + (size_t)(rbase + ai * 128 + m * 16) * DM + cbase + 128 * bj, sig4(g0) * acc[ai][bj][m][0], sig4(g1) * acc[ai][bj][m][1]); }
    }
};
struct EpiMergeA {
    static constexpr bool PERM = true, AFTER_DRAIN = false;
    const bf16_t* MG; const bf16_t* T; bf16_t* MB;
    DI void operator()(AccRef acc, const pg8::Unit& u, int wr, int wc, int fr, int fq) const {
        const int rbase = u.pm * 256 + wr * 64 + fr, cbase = u.pn * 256 + 32 * wc + 8 * fq;
#pragma unroll
        for (int ai = 0; ai < 2; ++ai) {
            u32x4 gv[4][2], tv[4][2];
#pragma unroll
            for (int m = 0; m < 4; ++m)
#pragma unroll
                for (int bj = 0; bj < 2; ++bj) { const size_t row = rbase + ai * 128 + m * 16; const int c = cbase + 128 * bj;
                    gv[m][bj] = *(const u32x4*)(MG + row * 2048 + c); tv[m][bj] = *(const u32x4*)(T + row * DM + c); }
#pragma unroll
            for (int m = 0; m < 4; ++m)
#pragma unroll
                for (int bj = 0; bj < 2; ++bj) { f32x4 g0, g1, t0, t1; bf8_to_f32(gv[m][bj], g0, g1); bf8_to_f32(tv[m][bj], t0, t1);
                    st_bf8(MB + (size_t)(rbase + ai * 128 + m * 16) * DM + cbase + 128 * bj, sig4(g0) * acc[ai][bj][m][0] + t0, sig4(g1) * acc[ai][bj][m][1] + t1); }
        }
    }
};
struct EpiWo {
    static constexpr bool PERM = true, AFTER_DRAIN = false;
    const float *xp, *xs; bf16_t* X1B; float* SSQ;
    DI void operator()(AccRef acc, const pg8::Unit& u, int wr, int wc, int fr, int fq) const {
        const int rbase = u.pm * 256 + wr * 64 + fr, cbase = u.pn * 256 + 32 * wc + 8 * fq;
#pragma unroll
        for (int ai = 0; ai < 2; ++ai) {
            f32x4 xv[4][2][2];
#pragma unroll
            for (int m = 0; m < 4; ++m)
#pragma unroll
                for (int bj = 0; bj < 2; ++bj)
#pragma unroll
                    for (int n = 0; n < 2; ++n) xv[m][bj][n] = *(const f32x4*)(xp + (size_t)(rbase + ai * 128 + m * 16) * DM + cbase + 128 * bj + 4 * n);
#pragma unroll
            for (int m = 0; m < 4; ++m) { const size_t row = rbase + ai * 128 + m * 16; float ss = 0.f;
#pragma unroll
                for (int bj = 0; bj < 2; ++bj) { const int c = cbase + 128 * bj; const f32x4 v0 = xv[m][bj][0] + acc[ai][bj][m][0], v1 = xv[m][bj][1] + acc[ai][bj][m][1];
                    ss += ((v0[0] * v0[0] + v0[1] * v0[1]) + (v0[2] * v0[2] + v0[3] * v0[3])) + ((v1[0] * v1[0] + v1[1] * v1[1]) + (v1[2] * v1[2] + v1[3] * v1[3]));
                    st_bf8(X1B + row * DM + c, v0, v1); }
                ss = x32_sum(x16_sum(ss));
                if (fq == 0) SSQ[row * 16 + u.pn * 4 + wc] = ss; }
        }
    }
};
constexpr size_t RSTD_OFF = 458752;
constexpr size_t SSQS_OFF = 393216;
DI float row_rstd(const float* SSQ, int row) {
    if (row < MP) {
        const f32x4* p = (const f32x4*)(SSQ + (size_t)row * 16); const f32x4 a = p[0], b = p[1], c = p[2], d = p[3];
        const float s = ((a[0] + a[1]) + (a[2] + a[3])) + ((b[0] + b[1]) + (b[2] + b[3])) + ((c[0] + c[1]) + (c[2] + c[3])) + ((d[0] + d[1]) + (d[2] + d[3]));
        return 1.f / sqrtf(s * (1.f / DM) + EPS);
    }
    const f32x4* p = (const f32x4*)(SSQ + SSQS_OFF + (size_t)(row - MP) * 64); float s = 0.f;
#pragma unroll 4
    for (int i = 0; i < 16; ++i) { const f32x4 a = p[i]; s += (a[0] + a[1]) + (a[2] + a[3]); }
    return 1.f / sqrtf(s * (1.f / DM) + EPS);
}
DI f32x4 dpp_prev(f32x4 prev, f32x4 cur, int which) {
    const int fr = threadIdx.x & 15;
    f32x4 o;
#pragma unroll
    for (int j = 0; j < 4; ++j) { const float push = (fr > 15 - which) ? prev[j] : cur[j];
        const int pi = __builtin_bit_cast(int, push);
        const int r = (which == 1) ? __builtin_amdgcn_update_dpp(pi, pi, 0x121, 0xf, 0xf, false) : __builtin_amdgcn_update_dpp(pi, pi, 0x122, 0xf, 0xf, false);
        o[j] = __builtin_bit_cast(float, r); }
    return o;
}
constexpr int EX_OFF = RING_BYTES;
DI int halo_index(int pm) { return 2 * (pm - 1 - (pm >> 3)); }
struct EpiGU {
    static constexpr bool PERM = true, AFTER_DRAIN = false;
    const float* SSQ; const float* HALO; bf16_t* H; float* out; const float *state_conv, *cw, *cb; LAS unsigned char* lds;
    DI void operator()(AccRef acc, const pg8::Unit& u, int wr, int wc, int fr, int fq) const {
        const int rbase = u.pm * 256 + wr * 64 + fr, cl = 32 * wc + 8 * fq, cbase = u.pn * 128 + cl;
        LAS float* EX = (LAS float*)(lds + EX_OFF);
        float rs[8];
#pragma unroll
        for (int q = 0; q < 8; ++q) { const int row = rbase + (q >> 2) * 128 + (q & 3) * 16; rs[q] = (row < MROWS) ? SSQ[RSTD_OFF + row] : 0.f; }
        if (fr >= 14) {
#pragma unroll
            for (int ai = 0; ai < 2; ++ai)
#pragma unroll
                for (int n = 0; n < 2; ++n) *(LAS f32x4*)(EX + ((ai * 2 + wr) * 2 + (fr - 14)) * 128 + cl + 4 * n) = acc[ai][0][3][n] * rs[ai * 4 + 3];
        }
        asm volatile("s_waitcnt lgkmcnt(0)" ::: "memory"); __builtin_amdgcn_s_barrier(); asm volatile("" ::: "memory");
        if (u.pm < 64) {
            f32x4 hal[2];
#pragma unroll
            for (int n = 0; n < 2; ++n) hal[n] = (fr >= 14 && wr == 0 && (u.pm & 7) != 0) ? *(const f32x4*)(HALO + (size_t)(halo_index(u.pm) + (fr - 14)) * DFF + cbase + 4 * n) : (f32x4){0.f, 0.f, 0.f, 0.f};
            f32x4 cc[2][4];
#pragma unroll
            for (int n = 0; n < 2; ++n) { const int c = cbase + 4 * n; cc[n][0] = *(const f32x4*)(cb + c); cc[n][1] = *(const f32x4*)(cw + c); cc[n][2] = *(const f32x4*)(cw + DFF + c); cc[n][3] = *(const f32x4*)(cw + 2 * DFF + c); }
#pragma unroll
            for (int ai = 0; ai < 2; ++ai) {
                f32x4 prev[2];
#pragma unroll
                for (int n = 0; n < 2; ++n) { f32x4 pbv = (f32x4){0.f, 0.f, 0.f, 0.f};
                    if (fr >= 14) {
                        if (wr == 1) pbv = *(const LAS f32x4*)(EX + ((ai * 2 + 0) * 2 + (fr - 14)) * 128 + cl + 4 * n);
                        else if (ai == 1) pbv = *(const LAS f32x4*)(EX + ((0 * 2 + 1) * 2 + (fr - 14)) * 128 + cl + 4 * n);
                        else pbv = hal[n];
                    }
                    prev[n] = pbv; }
#pragma unroll
                for (int m = 0; m < 4; ++m) { const int row = rbase + ai * 128 + m * 16; const float r1 = rs[ai * 4 + m]; const int t = row & 2047;
                    f32x4 hv[2];
#pragma unroll
                    for (int n = 0; n < 2; ++n) {
                        const f32x4 g0 = acc[ai][0][m][n] * r1, g1 = dpp_prev(prev[n], g0, 1), g2 = dpp_prev(prev[n], g0, 2);
                        const f32x4 cv = cc[n][0] + cc[n][1] * g2 + cc[n][2] * g1 + cc[n][3] * g0;
                        const f32x4 up = acc[ai][1][m][n] * r1;
                        hv[n] = (f32x4){siluf_(cv[0]) * up[0], siluf_(cv[1]) * up[1], siluf_(cv[2]) * up[2], siluf_(cv[3]) * up[3]};
                        if (t >= SEQ - 2) *(f32x4*)(out + OFF_CVP + ((size_t)(row >> 11) * 2 + (t - (SEQ - 2))) * DFF + cbase + 4 * n) = g0;
                        prev[n] = g0; }
                    st_bf8(H + (size_t)row * DFF + cbase, hv[0], hv[1]); }
            }
        } else {
#pragma unroll
            for (int m = 0; m < 4; ++m) { const int row = rbase + m * 16; if (row >= MROWS) continue;
                const float r1 = rs[m]; const int bs = row - MP;
                f32x4 hv[2];
#pragma unroll
                for (int n = 0; n < 2; ++n) { const int c = cbase + 4 * n;
                    const f32x4 g0 = acc[0][0][m][n] * r1;
                    const f32x4 g1 = *(const f32x4*)(state_conv + ((size_t)bs * 2 + 1) * DFF + c), g2 = *(const f32x4*)(state_conv + ((size_t)bs * 2) * DFF + c);
                    const f32x4 cv = *(const f32x4*)(cb + c) + *(const f32x4*)(cw + c) * g2 + *(const f32x4*)(cw + DFF + c) * g1 + *(const f32x4*)(cw + 2 * DFF + c) * g0;
                    const f32x4 up = acc[0][1][m][n] * r1;
                    hv[n] = (f32x4){siluf_(cv[0]) * up[0], siluf_(cv[1]) * up[1], siluf_(cv[2]) * up[2], siluf_(cv[3]) * up[3]};
                    *(f32x4*)(out + OFF_CVS + ((size_t)bs * 2 + 1) * DFF + c) = g0;
                    *(f32x4*)(out + OFF_CVS + ((size_t)bs * 2) * DFF + c) = g1; }
                st_bf8(H + (size_t)row * DFF + cbase, hv[0], hv[1]); }
        }
    }
};
struct EpiDown {
    static constexpr bool PERM = true, AFTER_DRAIN = false;
    const bf16_t* X1; float* Y;
    DI void operator()(AccRef acc, const pg8::Unit& u, int wr, int wc, int fr, int fq) const {
        const int rbase = u.pm * 256 + wr * 64 + fr, cbase = u.pn * 256 + 32 * wc + 8 * fq;
        u32x4 xv[2][4][2];
#pragma unroll
        for (int ai = 0; ai < 2; ++ai)
#pragma unroll
            for (int m = 0; m < 4; ++m)
#pragma unroll
                for (int bj = 0; bj < 2; ++bj) xv[ai][m][bj] = *(const u32x4*)(X1 + (size_t)(rbase + ai * 128 + m * 16) * DM + cbase + 128 * bj);
#pragma unroll
        for (int ai = 0; ai < 2; ++ai)
#pragma unroll
            for (int m = 0; m < 4; ++m)
#pragma unroll
                for (int bj = 0; bj < 2; ++bj) { f32x4 x0, x1; bf8_to_f32(xv[ai][m][bj], x0, x1); float* yp = Y + (size_t)(rbase + ai * 128 + m * 16) * DM + cbase + 128 * bj;
                    *(f32x4*)yp = x0 + acc[ai][bj][m][0]; *(f32x4*)(yp + 4) = x1 + acc[ai][bj][m][1]; }
    }
};

#ifdef MK_EXTRA_PHASE
struct EpiNull {
    static constexpr bool PERM = false, AFTER_DRAIN = false;
    float* sink;
    DI void operator()(AccRef acc, const pg8::Unit& u, int wr, int wc, int fr, int fq) const {
        f32x4 t = (f32x4){0.f, 0.f, 0.f, 0.f};
#pragma unroll
        for (int ai = 0; ai < 2; ++ai)
#pragma unroll
            for (int bj = 0; bj < 2; ++bj)
#pragma unroll
                for (int m = 0; m < 4; ++m)
#pragma unroll
                    for (int n = 0; n < 2; ++n) t += acc[ai][bj][m][n];
        if (t[0] == 1234.5f) sink[0] = t[1] + t[2] + t[3];
    }
};
#endif

template <int NP, class F>
DI void skinny_gemm(const bf16_t* A0, const bf16_t* B0, int K0, const bf16_t* A1, const bf16_t* B1, int K1, LAS unsigned char* lds, int cu, int G, int lane, int wave, F epi) {
    const int ts = wave >> 2, kq = wave & 3, l15 = lane & 15, gq = lane >> 4;
    LAS f32x4* red = (LAS f32x4*)lds;
    for (int t0 = 2 * cu; t0 < 512; t0 += 2 * G) {
        const int t = t0 + ts, rt = t & 7, ct = t >> 3;
        f32x4 acc[2] = {(f32x4){0.f, 0.f, 0.f, 0.f}, (f32x4){0.f, 0.f, 0.f, 0.f}};
#pragma unroll
        for (int p = 0; p < NP; ++p) {
            const bf16_t* A = p ? A1 : A0; const bf16_t* B = p ? B1 : B0; const int K = p ? K1 : K0;
            const bf16_t* ap = A + (size_t)(16 * rt + l15) * K + (size_t)kq * (K / 4) + 8 * gq;
            const bf16_t* bp = B + (size_t)(16 * ct + l15) * K + (size_t)kq * (K / 4) + 8 * gq;
            const int nsteps = K / 128;
            for (int s0 = 0; s0 < nsteps; s0 += 8) {
                bf16x8 af[8], bfv[8];
#pragma unroll
                for (int s = 0; s < 8; ++s) if (s0 + s < nsteps) { af[s] = *(const bf16x8*)(ap + (s0 + s) * 32); bfv[s] = *(const bf16x8*)(bp + (s0 + s) * 32); }
#pragma unroll
                for (int s = 0; s < 8; ++s) if (s0 + s < nsteps) acc[p] = MFMA16(af[s], bfv[s], acc[p]);
            }
        }
        __syncthreads();
#pragma unroll
        for (int p = 0; p < NP; ++p) red[(p * 8 + wave) * 64 + lane] = acc[p];
        __syncthreads();
        if (kq == 0) {
#pragma unroll
            for (int p = 0; p < NP; ++p) { acc[p] = (red[(p * 8 + wave) * 64 + lane] + red[(p * 8 + wave + 1) * 64 + lane]) + (red[(p * 8 + wave + 2) * 64 + lane] + red[(p * 8 + wave + 3) * 64 + lane]); }
            epi(16 * rt + 4 * gq, 16 * ct + l15, ct, acc[0], acc[1]);
        }
    }
}

struct SkMerge { const bf16_t* MG; bf16_t* MB;
    DI void operator()(int r0, int col, int ct, const f32x4& ab, const f32x4& aa) const {
#pragma unroll
        for (int r = 0; r < 4; ++r) { const size_t row = (size_t)MP + r0 + r;
            const float ga = bf2f(MG[row * 2048 + col]), gb = bf2f(MG[row * 2048 + DM + col]);
            MB[row * DM + col] = (bf16_t)f2bf(sigmoidf_(ga) * aa[r] + sigmoidf_(gb) * ab[r]); } } };
struct SkWo { const float* xs; bf16_t* X1B; float* SSQS;
    DI void operator()(int r0, int col, int ct, const f32x4& a0, const f32x4&) const {
#pragma unroll
        for (int r = 0; r < 4; ++r) { const int rs_ = r0 + r; const size_t row = (size_t)MP + rs_;
            const float x1 = xs[(size_t)rs_ * DM + col] + a0[r];
            X1B[row * DM + col] = (bf16_t)f2bf(x1);
            float ss = row16_sum(x1 * x1);
            if ((col & 15) == 0) SSQS[(size_t)rs_ * 64 + ct] = ss; } } };
struct SkDown { const bf16_t* X1; float* Y;
    DI void operator()(int r0, int col, int ct, const f32x4& a0, const f32x4&) const {
#pragma unroll
        for (int r = 0; r < 4; ++r) { const size_t row = (size_t)MP + r0 + r; Y[row * DM + col] = bf2f(X1[row * DM + col]) + a0[r]; } } };

DI int halo_row(int h) { const int idx = h >> 1; return 256 * (idx + 1 + idx / 7) - 2 + (h & 1); }
DI void halo_gemm(const bf16_t* X1G, const bf16_t* WGU, const float* SSQ, float* HALO, LAS unsigned char* lds, int cu, int G, int lane, int wave) {
    const int ts = wave >> 2, kq = wave & 3, l15 = lane & 15, gq = lane >> 4;
    LAS f32x4* red = (LAS f32x4*)lds;
    constexpr int NT = 7 * 176;
    for (int t0 = 2 * cu; t0 < NT; t0 += 2 * G) {
        const int t = t0 + ts; const bool live = t < NT; const int tt = live ? t : 0, rt = tt % 7, ct = tt / 7;
        const int c0 = 16 * ct, prow = 256 * (c0 >> 7) + (c0 & 127);
        const bf16_t* ap = X1G + (size_t)halo_row(16 * rt + l15) * DM + kq * 256 + 8 * gq;
        const bf16_t* bp = WGU + (size_t)(prow + l15) * DM + kq * 256 + 8 * gq;
        bf16x8 af[8], bfv[8];
#pragma unroll
        for (int s2 = 0; s2 < 8; ++s2) { af[s2] = *(const bf16x8*)(ap + s2 * 32); bfv[s2] = *(const bf16x8*)(bp + s2 * 32); }
        f32x4 acc = (f32x4){0.f, 0.f, 0.f, 0.f};
#pragma unroll
        for (int s2 = 0; s2 < 8; ++s2) acc = MFMA16(af[s2], bfv[s2], acc);
        __syncthreads();
        red[wave * 64 + lane] = acc;
        __syncthreads();
        if (kq == 0 && live) {
            acc = (red[wave * 64 + lane] + red[(wave + 1) * 64 + lane]) + (red[(wave + 2) * 64 + lane] + red[(wave + 3) * 64 + lane]);
#pragma unroll
            for (int r = 0; r < 4; ++r) { const int h = 16 * rt + 4 * gq + r; HALO[(size_t)h * DFF + c0 + l15] = acc[r] * row_rstd(SSQ, halo_row(h)); }
        }
    }
}

DI int crow(int reg, int hi) { return (reg & 3) + 8 * (reg >> 2) + 4 * hi; }
constexpr int A_KT = 0, A_KSTR = 144, A_KBYTES = 64 * A_KSTR;
constexpr int A_VT = 2 * A_KBYTES, A_VSTR = 192, A_VBYTES = 64 * A_VSTR;
constexpr int A_LUT = A_VT + 2 * A_VBYTES;
constexpr int A_IMP = A_LUT + 4 * 132 * 4;
constexpr int A_TOT = A_IMP + 4 * 64 * 33 * 4;
constexpr int A_SELM = A_TOT + 64 * 33 * 4;
constexpr int A_WS = A_SELM + 512;
constexpr int A_OACC = A_WS + 8 * 64 * 4;
constexpr int A_GB = A_OACC + 8 * 32 * 64 * 2;
constexpr int A_CSH = A_GB + 768 * 4;
constexpr int A_END = A_CSH + 64;
static_assert(A_END <= RING_BYTES, "attention LDS");

DI float swap_max(float v) { auto rr = __builtin_amdgcn_permlane32_swap(__float_as_uint(v), __float_as_uint(v), false, false); return fmaxf(__uint_as_float(rr[0]), __uint_as_float(rr[1])); }
DI float swap_sum(float v) { auto rr = __builtin_amdgcn_permlane32_swap(__float_as_uint(v), __float_as_uint(v), false, false); return __uint_as_float(rr[0]) + __uint_as_float(rr[1]); }

DI float score_bound(const float* qg, const float* kg, const float* rel_table, int lane) {
    float a = fabsf(qg[lane]), b = fmaxf(fmaxf(fabsf(kg[lane]), fabsf(kg[64 + lane])), fabsf(kg[128 + lane]));
    float c = fmaxf(fmaxf(fabsf(rel_table[lane]), fabsf(rel_table[64 + lane])), fmaxf(fabsf(rel_table[128 + lane]), fabsf(rel_table[192 + lane])));
#pragma unroll
    for (int o = 1; o < 64; o <<= 1) { a = fmaxf(a, __shfl_xor(a, o)); b = fmaxf(b, __shfl_xor(b, o)); c = fmaxf(c, __shfl_xor(c, o)); }
    return 64.f * QSCALE * a * b + c * LOG2E + 0.5f;
}
DI void build_lut(LAS float* lut, const float* rel_table, int g, int tid, float shift = 0.f) {
    for (int e = tid; e < 4 * 129; e += NTHREADS) { const int r = e / 129, dd = e % 129;
        int bk; if (dd < 16) bk = dd; else { bk = 16 + (int)(logf((float)dd / 16.f) / 2.0794415416798357f * 16.f); bk = bk > 31 ? 31 : bk; }
        lut[r * 132 + dd] = rel_table[bk * NH + 4 * g + r] * LOG2E - shift; }
}

struct AttnCtx {
    LAS unsigned char* lds; int tid, lane, wave, r32, hi, r, qh;
    bf16x8 qr[4];
    f32x16 o[2], ls;
};
DI void tile_fetch(const bf16_t* Ksrc, const bf16_t* Vsrc, int stride, int tid, u32x4& kreg, u32x4& vreg) {
    asm volatile("" : "+v"(tid));
    const int key = tid >> 3, ch = tid & 7;
    kreg = *(const u32x4*)(Ksrc + (size_t)key * stride + ch * 8); vreg = *(const u32x4*)(Vsrc + (size_t)key * stride + ch * 8);
}
DI void tile_store(LAS unsigned char* lds, int buf, int tid, const u32x4& kreg, const u32x4& vreg) {
    asm volatile("" : "+v"(tid));
    const int key = tid >> 3, ch = tid & 7;
    static_assert(A_KSTR == 144 && A_VSTR == 192, "row strides as shifts");
    *(LAS u32x4*)(lds + A_KT + buf * A_KBYTES + ((key << 7) + (key << 4)) + ch * 16) = kreg;
    *(LAS u32x4*)(lds + A_VT + buf * A_VBYTES + ((key << 7) + (key << 6)) + ch * 16) = vreg;
}
DI void qk_tile(const AttnCtx& c, int buf, f32x16& p0, f32x16& p1) {
    const LAS unsigned char* kb = c.lds + A_KT + buf * A_KBYTES + c.r32 * A_KSTR + c.hi * 16;
    bf16x8 a0[4], a1[4];
#pragma unroll
    for (int d0 = 0; d0 < 4; ++d0) { a0[d0] = *(const LAS bf16x8*)(kb + d0 * 32); a1[d0] = *(const LAS bf16x8*)(kb + 32 * A_KSTR + d0 * 32); }
    __builtin_amdgcn_sched_barrier(0);
#pragma unroll
    for (int k = 0; k < 16; ++k) { p0[k] = 0.f; p1[k] = 0.f; }
    __builtin_amdgcn_s_setprio(1);
#pragma unroll
    for (int d0 = 0; d0 < 4; ++d0) p0 = MFMA32(a0[d0], c.qr[d0], p0);
#pragma unroll
    for (int d0 = 0; d0 < 4; ++d0) p1 = MFMA32(a1[d0], c.qr[d0], p1);
    __builtin_amdgcn_s_setprio(0);
}
DI void half_pv(AttnCtx& c, const LAS unsigned char* vb, f32x16& e, float bias) {
    bf16x8 vf[2][2];
#pragma unroll
    for (int ks = 0; ks < 2; ++ks)
#pragma unroll
        for (int d0 = 0; d0 < 2; ++d0) { const LAS unsigned char* vp = vb + (16 * ks) * A_VSTR + d0 * 64; vf[ks][d0] = cat44(tr_read(vp), tr_read(vp + 8 * A_VSTR)); }
#pragma unroll
    for (int k = 0; k < 16; k += 2) { const f32x2 t = (f32x2){e[k], e[k + 1]} + (f32x2){bias, bias}; e[k] = __builtin_amdgcn_exp2f(t[0]); e[k + 1] = __builtin_amdgcn_exp2f(t[1]); }
    const bf16x8 ones = {0x3f80, 0x3f80, 0x3f80, 0x3f80, 0x3f80, 0x3f80, 0x3f80, 0x3f80};
#pragma unroll
    for (int ks = 0; ks < 2; ++ks) { u32x4 w;
#pragma unroll
        for (int j = 0; j < 4; ++j) w[j] = pkbf(e[8 * ks + 2 * j], e[8 * ks + 2 * j + 1]);
        const bf16x8 pa = __builtin_bit_cast(bf16x8, w);
        c.o[0] = MFMA32(pa, vf[ks][0], c.o[0]); c.o[1] = MFMA32(pa, vf[ks][1], c.o[1]); c.ls = MFMA32(pa, ones, c.ls); }
}
DI void pv_halves(AttnCtx& c, int buf, f32x16& s0, f32x16& s1, float bias) {
    const int q = (c.lane & 15) >> 2, p = c.lane & 3, blk = (c.lane >> 4) & 1;
    const LAS unsigned char* vb = c.lds + A_VT + buf * A_VBYTES + (4 * c.hi + q) * A_VSTR + (16 * blk + 4 * p) * 2;
    half_pv(c, vb, s0, bias);
    half_pv(c, vb + 32 * A_VSTR, s1, bias);
}
DI void softmax_pv(AttnCtx& c, int buf, f32x16& s0, f32x16& s1) { pv_halves(c, buf, s0, s1, 0.f); }
DI void softmax_pv_far(AttnCtx& c, int buf, f32x16& s0, f32x16& s1, float bias) { pv_halves(c, buf, s0, s1, bias); }
template <bool FIRST>
DI void branch_finish(AttnCtx& c, int br) {
    int gofs = ((c.r * 64 + 32 * c.qh + 4 * c.hi) * 3 + br); asm volatile("" : "+v"(gofs));
    const LAS float* gb = (const LAS float*)(c.lds + A_GB) + gofs;
    int sofs = c.wave * 2048 + c.r32 + 256 * c.hi; asm volatile("" : "+v"(sofs));
    LAS bf16_t* oa = (LAS bf16_t*)(c.lds + A_OACC) + sofs;
#pragma unroll
    for (int k = 0; k < 16; ++k) { const float l = c.ls[k]; const float a = l > 0.f ? gb[crow(k, 0) * 3] * __builtin_amdgcn_rcpf(l) : 0.f;
#pragma unroll
        for (int d0 = 0; d0 < 2; ++d0) { LAS bf16_t* p = oa + crow(k, 0) * 64 + 32 * d0; float v = c.o[d0][k] * a; if (!FIRST) v += bf2f(*p); *p = (bf16_t)f2bf(v); } }
#pragma unroll
    for (int k = 0; k < 16; ++k) { c.o[0][k] = 0.f; c.o[1][k] = 0.f; c.ls[k] = 0.f; }
}

struct AttnArgs { const bf16_t *Q, *KVB, *CKP, *CVP; const float *GATES, *rel_table; bf16_t* ONSA; };

DI void attn_prompt_unit(const AttnArgs& A, LAS unsigned char* lds, int b, int g, int i, int tid, int lane, int wave) {
    AttnCtx c; c.lds = lds; c.tid = tid; c.lane = lane; c.wave = wave; c.r32 = lane & 31; c.hi = lane >> 5; c.r = wave >> 1; c.qh = wave & 1;
    const int u = 32 * c.qh + c.r32, h = 4 * g + c.r;
    const size_t qrow = (size_t)b * SEQ + 64 * i + u;
    LAS float* lut = (LAS float*)(lds + A_LUT) + c.r * 132;
    LAS float* IMP = (LAS float*)(lds + A_IMP); LAS float* TOT = (LAS float*)(lds + A_TOT); LAS unsigned* SELM = (LAS unsigned*)(lds + A_SELM);
#pragma unroll
    for (int d0 = 0; d0 < 4; ++d0) c.qr[d0] = *(const bf16x8*)(A.Q + qrow * NSAW + h * 64 + 16 * d0 + 8 * c.hi);
#pragma unroll
    for (int k = 0; k < 16; ++k) { c.o[0][k] = 0.f; c.o[1][k] = 0.f; c.ls[k] = 0.f; }
    u32x4 kreg, vreg;
    const float bias_far = lut[128];

    tile_fetch(A.CKP + (size_t)(b * 2 + g) * 4096, A.CVP + (size_t)(b * 2 + g) * 4096, 64, tid, kreg, vreg);
    __syncthreads();
    for (int e = tid; e < 768; e += NTHREADS) { const int r2 = e / 192, rem = e % 192, q2 = rem / 3, br = rem % 3;
        ((LAS float*)(lds + A_GB))[e] = A.GATES[((size_t)b * SEQ + 64 * i + q2) * 24 + (4 * g + r2) * 3 + br]; }
    tile_store(lds, 0, tid, kreg, vreg);
    __syncthreads();
    {
        f32x16 s0, s1; qk_tile(c, 0, s0, s1);
        int qb = 64 * i + u - 31 - 128 * c.hi; asm volatile("" : "+v"(qb));
        float b0[16], b1[16];
#pragma unroll
        for (int k = 0; k < 16; ++k) { const int d0 = qb - 32 * crow(k, 0), d1 = d0 - 1024;
            b0[k] = lut[min(max(d0, 0), 128)]; b1[k] = lut[min(max(d1, 0), 128)]; }
#pragma unroll
        for (int k = 0; k < 16; ++k) { const int d0 = qb - 32 * crow(k, 0), d1 = d0 - 1024;
            s0[k] = d0 >= 0 ? s0[k] + b0[k] : -INFINITY; s1[k] = d1 >= 0 ? s1[k] + b1[k] : -INFINITY; }
        softmax_pv(c, 0, s0, s1);
        float lsum = 0.f;
#pragma unroll
        for (int k = 0; k < 16; ++k) lsum += s0[k] + s1[k];
        const float lt = swap_sum(lsum), inv = lt > 0.f ? __builtin_amdgcn_rcpf(lt) : 0.f;
        int iofs = (c.r * 64 + u) * 33 + 2 * c.hi; asm volatile("" : "+v"(iofs));
#pragma unroll
        for (int k = 0; k < 16; k += 2) {
            IMP[iofs + (crow(k, 0) >> 1)] = (s0[k] + s0[k + 1]) * inv;
            IMP[iofs + 16 + (crow(k, 0) >> 1)] = (s1[k] + s1[k + 1]) * inv;
        }
        branch_finish<true>(c, 0);
    }
    __syncthreads();
    {
        int tq = tid; asm volatile("" : "+v"(tq));
        const int uq = tq >> 3, sub = tq & 7;
        unsigned mbits = 0u;
        if (i < 16) { mbits = (i >= 31) ? 0xffffffffu : ((1u << (i + 1)) - 1u); }
        else {
#pragma unroll
            for (int jj = 0; jj < 4; ++jj) { const int j = sub * 4 + jj;
                TOT[uq * 33 + j] = (IMP[(0 * 64 + uq) * 33 + j] + IMP[(1 * 64 + uq) * 33 + j]) + (IMP[(2 * 64 + uq) * 33 + j] + IMP[(3 * 64 + uq) * 33 + j]); }
        }
        __syncthreads();
        if (i >= 16) {
            const int ntop = 16 - 3;
            float mine[4]; int cnt[4];
#pragma unroll
            for (int jj = 0; jj < 4; ++jj) { mine[jj] = TOT[uq * 33 + sub * 4 + jj]; cnt[jj] = 0; }
            for (int j2 = 1; j2 < i - 1; ++j2) { const float o2 = TOT[uq * 33 + j2];
#pragma unroll
                for (int jj = 0; jj < 4; ++jj) cnt[jj] += (o2 > mine[jj] || (o2 == mine[jj] && j2 < sub * 4 + jj)) ? 1 : 0; }
#pragma unroll
            for (int jj = 0; jj < 4; ++jj) { const int j = sub * 4 + jj;
                if (j > i) continue;
                if (j == 0 || j >= i - 1) { mbits |= 1u << j; continue; }
                if (cnt[jj] < ntop) mbits |= 1u << j; }
            mbits |= __shfl_xor(mbits, 1); mbits |= __shfl_xor(mbits, 2); mbits |= __shfl_xor(mbits, 4);
        }
        if (sub == 0) SELM[uq] = mbits;
    }
    __syncthreads();
    const unsigned selm = SELM[u];
    unsigned umask = selm;
    { unsigned t = selm; for (int o = 1; o < 32; o <<= 1) t |= __shfl_xor(t, o); if (c.r32 == 0 && c.hi == 0 && c.r == 0) SELM[64 + c.qh] = t; }
    __syncthreads();
    umask = SELM[64] | SELM[65];
    umask = __builtin_amdgcn_readfirstlane(umask);
    __syncthreads();

    {
        const bf16_t* Kb = A.KVB + (size_t)b * SEQ * 512 + 0 * 128 + g * 64; const bf16_t* Vb = Kb + 128;
        unsigned rem = umask & ((i >= 31) ? 0xffffffffu : ((1u << (i + 1)) - 1u));
        int j = __builtin_ctz(rem); rem &= rem - 1u;
        tile_fetch(Kb + (size_t)64 * j * 512, Vb + (size_t)64 * j * 512, 512, tid, kreg, vreg);
        int buf = 0;
#define SEL_STEP(KR, VR) { \
            tile_store(lds, buf, tid, KR, VR); \
            __syncthreads(); \
            const int jn = rem ? __builtin_ctz(rem) : -1; if (rem) rem &= rem - 1u; \
            if (jn >= 0) tile_fetch(Kb + (size_t)64 * jn * 512, Vb + (size_t)64 * jn * 512, 512, tid, KR, VR); \
            { \
                f32x16 s0, s1; qk_tile(c, buf, s0, s1); \
                const bool sel = (selm >> j) & 1u; \
                float bv = sel ? bias_far : -INFINITY;        \
                if (i - j < 3) { \
                    asm volatile("" ::: "memory");     \
                    int dbase = 64 * (i - j) + u - 4 * c.hi; asm volatile("" : "+v"(dbase)); \
                    float b0[16], b1[16]; \
                    _Pragma("unroll") for (int k = 0; k < 16; ++k) { const int d0 = dbase - crow(k, 0), d1 = d0 - 32; b0[k] = lut[min(max(d0, 0), 128)]; b1[k] = lut[min(max(d1, 0), 128)]; } \
                    _Pragma("unroll") for (int k = 0; k < 16; ++k) { const int d0 = dbase - crow(k, 0), d1 = d0 - 32; \
                        s0[k] = (sel && d0 >= 0) ? s0[k] + b0[k] : -INFINITY; s1[k] = (sel && d1 >= 0) ? s1[k] + b1[k] : -INFINITY; } \
                    bv = 0.f; \
                } \
                pv_halves(c, buf, s0, s1, bv);                \
            } \
            if (jn < 0) break; \
            j = jn; buf ^= 1; }
        for (;;) { SEL_STEP(kreg, vreg) }
#undef SEL_STEP
        branch_finish<false>(c, 1);
    }
    __syncthreads();
    {
        const bf16_t* Kb = A.KVB + (size_t)b * SEQ * 512 + 2 * 128 + g * 64; const bf16_t* Vb = Kb + 128;
        int j = i - 8 < 0 ? 0 : i - 8;
        tile_fetch(Kb + (size_t)64 * j * 512, Vb + (size_t)64 * j * 512, 512, tid, kreg, vreg);
        int buf = 0;
#define WIN_STEP(KR, VR) { \
            tile_store(lds, buf, tid, KR, VR); \
            __syncthreads(); \
            if (j + 1 <= i) tile_fetch(Kb + (size_t)64 * (j + 1) * 512, Vb + (size_t)64 * (j + 1) * 512, 512, tid, KR, VR); \
            { \
                f32x16 s0, s1; qk_tile(c, buf, s0, s1); \
                float bv = bias_far; \
                if (!(i - j >= 3 && i - j < 8)) { \
                    asm volatile("" ::: "memory");     \
                    int dbase = 64 * (i - j) + u - 4 * c.hi; asm volatile("" : "+v"(dbase)); \
                    float b0[16], b1[16]; \
                    _Pragma("unroll") for (int k = 0; k < 16; ++k) { const int d0 = dbase - crow(k, 0), d1 = d0 - 32; b0[k] = lut[min(max(d0, 0), 128)]; b1[k] = lut[min(max(d1, 0), 128)]; } \
                    _Pragma("unroll") for (int k = 0; k < 16; ++k) { const int d0 = dbase - crow(k, 0), d1 = d0 - 32; \
                        s0[k] = (d0 >= 0 && d0 <= WIN) ? s0[k] + b0[k] : -INFINITY; s1[k] = (d1 >= 0 && d1 <= WIN) ? s1[k] + b1[k] : -INFINITY; } \
                    bv = 0.f; \
                } \
                pv_halves(c, buf, s0, s1, bv); \
            } \
            if (j >= i) break; \
            ++j; buf ^= 1; }
        for (;;) { WIN_STEP(kreg, vreg) }
#undef WIN_STEP
        branch_finish<false>(c, 2);
    }
    {
        const LAS bf16_t* stg = (const LAS bf16_t*)(lds + A_OACC) + wave * 2048;
        bf16_t* ob = A.ONSA + ((size_t)b * SEQ + 64 * i + 32 * c.qh) * NSAW + h * 64;
#pragma unroll
        for (int i4 = 0; i4 < 4; ++i4) { const int rw = i4 * 8 + (lane >> 3), ch = lane & 7;
            const u32x4 v = *(const LAS u32x4*)(stg + rw * 64 + ch * 8); *(u32x4*)(ob + (size_t)rw * NSAW + ch * 8) = v; }
    }
}

constexpr int H_QT = 0, H_QSTR = 272;
constexpr int H_KS = H_QT + 64 * H_QSTR;
constexpr int H_QR = H_KS + 64 * H_QSTR;
constexpr int H_KT = H_QR + 64 * H_QSTR, H_KTSTR = 144;
constexpr int H_VL = H_KT + 128 * H_KTSTR, H_VSTR = 288;
constexpr int H_AT = H_VL + 64 * H_VSTR, H_ASTR = 144;
constexpr int H_BC = H_AT + 64 * H_ASTR, H_BSTR = 132;
constexpr int H_PT = H_BC + 64 * H_BSTR * 4;
constexpr int H_BR = H_PT + 4 * 128 * 4;
constexpr int H_DB = H_BR + 4 * 128 * 4;
constexpr int H_SS = H_DB + 128 * 4;
constexpr int H_END = H_SS + 8 * 64 * 4;
static_assert(H_END <= MISC_OFF, "hgrn LDS");

DI float ex2(float x) { return __builtin_amdgcn_exp2f(x); }

struct HgArgs { const bf16_t *HQ, *HI, *HGT; const float *GL, *hgn; float *SLOC, *GD; bf16_t* OHG; float* out; };
struct HgChunkRegs { f32x4 gl[4]; u32x4 hq[2], hi[2], hg[2]; };
template <bool WITH_OUT>
DI void hg_fetch(const HgArgs& A, size_t row0, int h, int tid, HgChunkRegs& R) {
#pragma unroll
    for (int i = 0; i < 4; ++i) { const int idx = tid + 512 * i; R.gl[i] = *(const f32x4*)(A.GL + (row0 + (idx >> 5)) * HGW + h * 128 + 4 * (idx & 31)); }
#pragma unroll
    for (int i = 0; i < 2; ++i) { const int idx = tid + 512 * i; const size_t o = (row0 + (idx >> 4)) * HGW + h * 128 + 8 * (idx & 15);
        R.hi[i] = *(const u32x4*)(A.HI + o); if (WITH_OUT) { R.hq[i] = *(const u32x4*)(A.HQ + o); R.hg[i] = *(const u32x4*)(A.HGT + o); } }
}
template <bool WITH_OUT>
DI void hg_stage(LAS unsigned char* lds, int tid, const HgChunkRegs& R) {
#pragma unroll
    for (int i = 0; i < 4; ++i) { const int idx = tid + 512 * i; *(LAS f32x4*)(lds + H_BC + ((idx >> 5) * H_BSTR + 4 * (idx & 31)) * 4) = R.gl[i]; }
#pragma unroll
    for (int i = 0; i < 2; ++i) { const int idx = tid + 512 * i; *(LAS u32x4*)(lds + H_VL + (idx >> 4) * H_VSTR + 16 * (idx & 15)) = R.hi[i];
        if (WITH_OUT) *(LAS u32x4*)(lds + H_QR + (idx >> 4) * H_QSTR + 16 * (idx & 15)) = R.hq[i]; }
}

template <bool WITH_OUT>
DI void hgrn_unit(const HgArgs& A, LAS unsigned char* lds, int unit, int tid, int lane, int wave) {
    const int bh = unit >> 3, grp = unit & 7, b = bh >> 2, h = bh & 3;
    const int gq = lane >> 4, l15 = lane & 15;
    const size_t rowu = (size_t)b * SEQ + 256 * grp;
    HgChunkRegs R;
    hg_fetch<WITH_OUT>(A, rowu, h, tid, R);
    f32x4 acc[8];
#pragma unroll
    for (int kt = 0; kt < 8; ++kt) acc[kt] = (f32x4){0.f, 0.f, 0.f, 0.f};
    if (WITH_OUT) {
        { int lofs = lane; asm volatile("" : "+v"(lofs));
          const f32x4* sl0 = (const f32x4*)A.SLOC + ((size_t)(bh * 8) * 8 + wave) * 8 * 64 + lofs; const float* gd0 = A.GD + (size_t)(bh * 8) * 128 + 4 * gq;
#pragma unroll
          for (int kt = 0; kt < 8; ++kt) {
              if (kt == 4) __builtin_amdgcn_sched_barrier(0);
              f32x4 sv[7], gv[7];
#pragma unroll
              for (int g2 = 0; g2 < 7; ++g2) if (g2 < grp) { sv[g2] = sl0[((size_t)g2 * 64 + kt) * 64]; gv[g2] = *(const f32x4*)(gd0 + (size_t)g2 * 128 + 16 * kt); }
              f32x4 a = (f32x4){0.f, 0.f, 0.f, 0.f};
#pragma unroll
              for (int g2 = 0; g2 < 7; ++g2) if (g2 < grp) {
#pragma unroll
                  for (int r = 0; r < 4; ++r) a[r] = a[r] * __expf(gv[g2][r]) + sv[g2][r]; }
              acc[kt] = a; } }
        for (int e = tid; e < 64 * H_ASTR / 4; e += NTHREADS) ((LAS unsigned*)(lds + H_AT))[e] = 0u;
    }
    const int kch = tid & 127, part = tid >> 7;
    float gdsum = 0.f;
    for (int ch = 0; ch < 4; ++ch) {
        const size_t row0 = rowu + 64 * ch;
        __syncthreads();
        hg_stage<WITH_OUT>(lds, tid, R);
        const u32x4 hg0 = R.hg[0], hg1 = R.hg[1];
        __syncthreads();
        if (ch < 3) hg_fetch<WITH_OUT>(A, row0 + 64, h, tid, R);
        LAS float* bcol = (LAS float*)(lds + H_BC) + (16 * part) * H_BSTR + kch;
        float run = 0.f;
#pragma unroll
        for (int t = 0; t < 16; ++t) run += bcol[t * H_BSTR];
        ((LAS float*)(lds + H_PT))[part * 128 + kch] = run;
        __syncthreads();
        float off = 0.f, btot = 0.f;
        { const LAS float* pt = (const LAS float*)(lds + H_PT);
#pragma unroll
          for (int p2 = 0; p2 < 4; ++p2) { const float v = pt[p2 * 128 + kch]; if (p2 < part) off += v; btot += v; } }
        const float bref = off + run;
        if (part == 0) { ((LAS float*)(lds + H_DB))[kch] = __expf(btot); gdsum += btot; }
        if (WITH_OUT) ((LAS float*)(lds + H_BR))[part * 128 + kch] = bref;
        { float bt = off;
#pragma unroll
          for (int t4 = 0; t4 < 4; ++t4) {
              unsigned kw[2];
#pragma unroll
              for (int t1 = 0; t1 < 4; ++t1) { const int tl = 4 * t4 + t1, tt = 16 * part + tl;
                  const float gl = bcol[tl * H_BSTR]; bt += gl;
                  const float kkv = 1.f - __expf(gl);
                  const unsigned hv = f2bf(kkv * __expf(btot - bt));
                  if (t1 & 1) kw[t1 >> 1] |= hv << 16; else kw[t1 >> 1] = hv;
                  if (WITH_OUT) {
                      const float qv = bf2f(*(const LAS bf16_t*)(lds + H_QR + tt * H_QSTR + kch * 2));
                      *(LAS bf16_t*)(lds + H_QT + tt * H_QSTR + kch * 2) = (bf16_t)f2bf(qv * __expf(bt));
                      *(LAS bf16_t*)(lds + H_KS + tt * H_QSTR + kch * 2) = (bf16_t)f2bf(kkv * __expf(bref - bt));
                      bcol[tl * H_BSTR] = bt;
                  } }
              *(LAS u32x2*)(lds + H_KT + kch * H_KTSTR + part * 32 + t4 * 8) = (u32x2){kw[0], kw[1]}; } }
        __syncthreads();
        if (WITH_OUT) {
            for (int tile = wave; tile < 10; tile += 8) {
                int it, js; { int rem = tile; it = 0; while (rem > it) { rem -= it + 1; ++it; } js = rem; }
                f32x4 a4 = (f32x4){0.f, 0.f, 0.f, 0.f};
                const int trow = 16 * it + l15, srow = 16 * js + l15;
#pragma unroll 2
                for (int ks = 0; ks < 4; ++ks) {
                    const int k0 = 32 * ks + 8 * gq;
                    const u32x4 qraw = *(const LAS u32x4*)(lds + H_QR + trow * H_QSTR + k0 * 2);
                    const LAS float* bp = (const LAS float*)(lds + H_BC) + trow * H_BSTR + k0; const LAS float* rp = (const LAS float*)(lds + H_BR) + js * 128 + k0;
                    const f32x4 b0 = *(const LAS f32x4*)bp, b1 = *(const LAS f32x4*)(bp + 4), r0 = *(const LAS f32x4*)rp, r1 = *(const LAS f32x4*)(rp + 4);
                    float qd[8];
                    qd[0] = bflo(qraw.x) * __expf(b0[0] - r0[0]); qd[1] = bfhi(qraw.x) * __expf(b0[1] - r0[1]); qd[2] = bflo(qraw.y) * __expf(b0[2] - r0[2]); qd[3] = bfhi(qraw.y) * __expf(b0[3] - r0[3]);
                    qd[4] = bflo(qraw.z) * __expf(b1[0] - r1[0]); qd[5] = bfhi(qraw.z) * __expf(b1[1] - r1[1]); qd[6] = bflo(qraw.w) * __expf(b1[2] - r1[2]); qd[7] = bfhi(qraw.w) * __expf(b1[3] - r1[3]);
                    const bf16x8 af = pack8(qd);
                    const bf16x8 bfv = *(const LAS bf16x8*)(lds + H_KS + srow * H_QSTR + k0 * 2);
                    a4 = MFMA16(af, bfv, a4);
                }
#pragma unroll
                for (int r = 0; r < 4; ++r) { const int tl = 4 * gq + r; float v = a4[r]; if (it == js && l15 > tl) v = 0.f;
                    *(LAS bf16_t*)(lds + H_AT + (16 * it + tl) * H_ASTR + (16 * js + l15) * 2) = (bf16_t)f2bf(v); }
            }
            __syncthreads();
        }
        bf16x8 vf[2];
        { const int q = l15 >> 2, p = l15 & 3;
#pragma unroll
          for (int ks = 0; ks < 2; ++ks) { const LAS unsigned char* vp = lds + H_VL + (32 * ks + 4 * gq + q) * H_VSTR + (16 * wave + 4 * p) * 2;
              vf[ks] = cat44(tr_read(vp), tr_read(vp + 16 * H_VSTR)); } }
        if (WITH_OUT) {
            f32x4 o[4];
#pragma unroll
            for (int it = 0; it < 4; ++it) { o[it] = (f32x4){0.f, 0.f, 0.f, 0.f};
                const int trow = 16 * it + l15;
#pragma unroll
                for (int ks = 0; ks < 2; ++ks) { const LAS unsigned char* ap = lds + H_AT + trow * H_ASTR + (32 * ks + 4 * gq) * 2;
                    const bf16x8 af = cat44(*(const LAS s16x4*)ap, *(const LAS s16x4*)(ap + 32)); o[it] = MFMA16(af, vf[ks], o[it]); } }
#pragma unroll
            for (int ks = 0; ks < 4; ++ks) {
                const bf16x8 sf = pack8v(acc[2 * ks], acc[2 * ks + 1]);
#pragma unroll
                for (int it = 0; it < 4; ++it) { const LAS unsigned char* qp = lds + H_QT + (16 * it + l15) * H_QSTR + (32 * ks + 4 * gq) * 2;
                    const bf16x8 af = cat44(*(const LAS s16x4*)qp, *(const LAS s16x4*)(qp + 32)); o[it] = MFMA16(af, sf, o[it]); } }
            LAS float* SS = (LAS float*)(lds + H_SS);
#pragma unroll
            for (int it = 0; it < 4; ++it)
#pragma unroll
                for (int r = 0; r < 4; ++r) { const float s = row16_sum(o[it][r] * o[it][r]);
                    if (l15 == 0) SS[wave * 64 + 16 * it + 4 * gq + r] = s; }
            __syncthreads();
            if (tid < 64) { float tot = 0.f;
#pragma unroll
                for (int w2 = 0; w2 < 8; ++w2) tot += SS[w2 * 64 + tid];
                ((LAS float*)(lds + H_PT))[tid] = 1.f / sqrtf(tot * (1.f / 128.f) + EPS); }
            __syncthreads();
            const float gn = A.hgn[16 * wave + l15];
#pragma unroll
            for (int it = 0; it < 4; ++it) {
                const f32x4 rs4 = *(const LAS f32x4*)((const LAS float*)(lds + H_PT) + 16 * it + 4 * gq);
#pragma unroll
                for (int r = 0; r < 4; ++r) *(LAS bf16_t*)(lds + H_KS + (16 * it + 4 * gq + r) * H_QSTR + (16 * wave + l15) * 2) = (bf16_t)f2bf(o[it][r] * rs4[r] * gn); }
        }
        { const LAS float* DB = (const LAS float*)(lds + H_DB);
#pragma unroll
          for (int kt = 0; kt < 8; ++kt) { const f32x4 d4 = *(const LAS f32x4*)(DB + 16 * kt + 4 * gq); acc[kt] = acc[kt] * d4;
#pragma unroll
              for (int ks = 0; ks < 2; ++ks) { const LAS unsigned char* kp = lds + H_KT + (16 * kt + l15) * H_KTSTR + (32 * ks + 4 * gq) * 2;
                  const bf16x8 af = cat44(*(const LAS s16x4*)kp, *(const LAS s16x4*)(kp + 32)); acc[kt] = MFMA16(af, vf[ks], acc[kt]); } } }
        if (WITH_OUT) {
            __syncthreads();
#pragma unroll
            for (int i = 0; i < 2; ++i) { const int idx = tid + 512 * i, rw = idx >> 4, c16 = idx & 15;
                const u32x4 ov = *(const LAS u32x4*)(lds + H_KS + rw * H_QSTR + 16 * c16);
                const size_t o = (row0 + rw) * HGW + h * 128 + 8 * c16; const u32x4 gv = i ? hg1 : hg0;
                u32x4 w;
                w.x = pk2(bflo(ov.x) * siluf_(bflo(gv.x)), bfhi(ov.x) * siluf_(bfhi(gv.x))); w.y = pk2(bflo(ov.y) * siluf_(bflo(gv.y)), bfhi(ov.y) * siluf_(bfhi(gv.y)));
                w.z = pk2(bflo(ov.z) * siluf_(bflo(gv.z)), bfhi(ov.z) * siluf_(bfhi(gv.z))); w.w = pk2(bflo(ov.w) * siluf_(bflo(gv.w)), bfhi(ov.w) * siluf_(bfhi(gv.w)));
                *(u32x4*)(A.OHG + o) = w; }
        }
    }
    if (!WITH_OUT) {
        int lofs = lane; asm volatile("" : "+v"(lofs));
        f32x4* sl = (f32x4*)A.SLOC + ((size_t)(unit * 8 + wave) * 8) * 64 + lofs;
#pragma unroll
        for (int kt = 0; kt < 8; ++kt) sl[kt * 64] = acc[kt];
        if (part == 0) A.GD[(size_t)unit * 128 + kch] = gdsum;
    } else if (grp == 7) {
        int lofs = (4 * gq) * 128 + 16 * wave + l15; asm volatile("" : "+v"(lofs));
        float* so = A.out + OFF_HGP + (size_t)bh * 16384 + lofs;
#pragma unroll
        for (int kt = 0; kt < 8; ++kt)
#pragma unroll
            for (int r = 0; r < 4; ++r) so[(16 * kt + r) * 128] = acc[kt][r];
    }
}

DI float gelu_tanh(float x) { const float uu = 0.7978845608028654f * (x + 0.044715f * x * x * x); const float t = 1.f - 2.f * __builtin_amdgcn_rcpf(__expf(2.f * uu) + 1.f); return 0.5f * x * (1.f + t); }
struct CmpArgs { const float *cache, *kvout; const int* page_table; const bf16_t *W1K, *W1V; const float *w2k, *w2v, *kg0; float *CKS, *CVS; bf16_t *CKP, *CVP; };
constexpr int C_PART = 0, C_HB = 32768, C_W2 = 36864;
DI void cmp_rows(const CmpArgs& A, int item, int lane, int wave, const float* (&rp)[4]) {
    const bool sample = item < 2048; const int it2 = sample ? item : item - 2048;
    const int bb = it2 >> 4, g = (it2 >> 3) & 1, kv = (it2 >> 2) & 1, rt = it2 & 3;
    const int nl = lane & 15, gq = lane >> 4, n = 16 * rt + nl;
#pragma unroll
    for (int jj = 0; jj < 4; ++jj) { const int t = 32 * n + 4 * wave + jj;
        const float* p = sample ? A.cache + ((size_t)A.page_table[bb * NPAGES + (t >> 7)] * PAGE + (t & 127)) * 512 : A.kvout + ((size_t)bb * SEQ + t) * 512;
        rp[jj] = p + kv * 128 + g * 64 + 8 * gq; }
}
DI void cmp_load(const float* const (&rp)[4], f32x4 (&av)[4][2][2]) {
#pragma unroll
    for (int jj = 0; jj < 4; ++jj)
#pragma unroll
        for (int k2 = 0; k2 < 2; ++k2) { av[jj][k2][0] = *(const f32x4*)(rp[jj] + 32 * k2); av[jj][k2][1] = *(const f32x4*)(rp[jj] + 32 * k2 + 4); }
}
DI void cmp_wload(const bf16_t* W1, int lane, int wave, bf16x8 (&wf)[4][2][4]) {
    const int nl = lane & 15, gq = lane >> 4;
    const bf16_t* wp = W1 + (size_t)nl * 2048 + (4 * wave) * 64 + 8 * gq;
#pragma unroll
    for (int jj = 0; jj < 4; ++jj)
#pragma unroll
        for (int k2 = 0; k2 < 2; ++k2)
#pragma unroll
            for (int nt = 0; nt < 4; ++nt) wf[jj][k2][nt] = *(const bf16x8*)(wp + (size_t)(16 * nt) * 2048 + jj * 64 + 32 * k2);
}
DI void cmp_mfma(const bf16x8 (&wf)[4][2][4], const f32x4 (&av)[4][2][2], f32x4 (&acc)[4]) {
#pragma unroll
    for (int nt = 0; nt < 4; ++nt) acc[nt] = (f32x4){0.f, 0.f, 0.f, 0.f};
#pragma unroll
    for (int jj = 0; jj < 4; ++jj)
#pragma unroll
        for (int k2 = 0; k2 < 2; ++k2) { const bf16x8 af = pack8v(av[jj][k2][0], av[jj][k2][1]);
#pragma unroll
            for (int nt = 0; nt < 4; ++nt) acc[nt] = MFMA16(af, wf[jj][k2][nt], acc[nt]); }
}
DI void cmp_tail(const CmpArgs& A, LAS unsigned char* lds, int item, int tid, int lane, int wave, const f32x4 (&acc)[4]) {
    const bool sample = item < 2048; const int it2 = sample ? item : item - 2048;
    const int bb = it2 >> 4, g = (it2 >> 3) & 1, kv = (it2 >> 2) & 1, rt = it2 & 3;
    const int nl = lane & 15, gq = lane >> 4;
    LAS float* part = (LAS float*)(lds + C_PART); LAS float* hb = (LAS float*)(lds + C_HB);
    __syncthreads();
#pragma unroll
    for (int nt = 0; nt < 4; ++nt)
#pragma unroll
        for (int r = 0; r < 4; ++r) part[wave * 1024 + (4 * gq + r) * 64 + 16 * nt + nl] = acc[nt][r];
    __syncthreads();
    const int row = tid >> 5, e2 = (tid & 31) * 2;
    { float h0 = 0.f, h1 = 0.f;
#pragma unroll
      for (int w2 = 0; w2 < 8; ++w2) { const f32x2 v = *(const LAS f32x2*)(part + w2 * 1024 + row * 64 + e2); h0 += v.x; h1 += v.y; }
      hb[row * 64 + e2] = gelu_tanh(h0); hb[row * 64 + e2 + 1] = gelu_tanh(h1); }
    __syncthreads();
    const LAS float* w2 = (const LAS float*)(lds + C_W2) + kv * 4096;
    float o0 = 0.f, o1 = 0.f;
#pragma unroll 16
    for (int e = 0; e < 64; ++e) { const float hv = hb[row * 64 + e]; const f32x2 w = *(const LAS f32x2*)(w2 + e * 64 + e2); o0 += hv * w.x; o1 += hv * w.y; }
    if (kv == 0) { float ss = o0 * o0 + o1 * o1;
        ss = x16_sum(row16_sum(ss));
        const LAS float* kgl = (const LAS float*)(lds + C_W2) + 8192;
        const float rs = 1.f / sqrtf(ss * (1.f / 64.f) + EPS); o0 *= rs * kgl[e2]; o1 *= rs * kgl[e2 + 1]; }
    const int nn = 16 * rt + row;
    if (sample) { float* dst = (kv ? A.CVS : A.CKS) + ((size_t)(bb * 2 + g) * 64 + nn) * 64 + e2; *(f32x2*)dst = (f32x2){o0, o1}; }
    else { bf16_t* dst = (kv ? A.CVP : A.CKP) + ((size_t)(bb * 2 + g) * 64 + nn) * 64 + e2; *(unsigned*)dst = pk2(o0, o1); }
}
DI int cmp_item_id(int kv, int q) {
    const int sample = q < 1024; const int r = sample ? q : q - 1024;
    const int it2 = ((r >> 3) << 4) | (((r >> 2) & 1) << 3) | (kv << 2) | (r & 3);
    return sample ? it2 : 2048 + it2;
}
DI void compress_phase(const CmpArgs& A, LAS unsigned char* lds, int w, int W, int q0, int q1, int tid, int lane, int wave) {
    __syncthreads();
    { LAS float* w2l = (LAS float*)(lds + C_W2);
      for (int e = tid; e < 4096; e += NTHREADS) { w2l[e] = A.w2k[e]; w2l[4096 + e] = A.w2v[e]; }
      if (tid < 64) w2l[8192 + tid] = A.kg0[tid]; }
    const int kv = w & 1, step = W >> 1;
    int q = q0 + (w >> 1);
    if (q >= q1 || step < 1) return;
    bf16x8 wf[4][2][4];
    cmp_wload(kv ? A.W1V : A.W1K, lane, wave, wf);
    f32x4 av[4][2][2]; const float* rp[4];
    int item = cmp_item_id(kv, q);
    cmp_rows(A, item, lane, wave, rp);
    cmp_load(rp, av);
    for (;;) {
        const int qn = q + step; const bool more = qn < q1; const int next = more ? cmp_item_id(kv, qn) : 0;
        if (more) cmp_rows(A, next, lane, wave, rp);
        f32x4 acc[4];
        cmp_mfma(wf, av, acc);
        asm volatile("" ::: "memory"); __builtin_amdgcn_sched_barrier(0);
        if (more) cmp_load(rp, av);
        asm volatile("" ::: "memory");
        cmp_tail(A, lds, item, tid, lane, wave, acc);
        if (!more) break;
        item = next; q = qn;
    }
}
constexpr int CMP_EARLY_Q = 159;
DI bool cmp_early(int G, int lo, int& rem, int& W) { const int nunits = (MPAD / 256) * (NIN / 256); rem = nunits % G; W = (G - rem) & ~1; return lo == 0 && rem > 0 && W >= 2 && (2 * CMP_EARLY_Q + W - 1) / W <= 3; }

struct HsArgs { const float *S0, *GL, *hgn; const bf16_t *HQ, *HI, *HGT; bf16_t* OHG; float* out; };
DI void hgrn_sample_unit(const HsArgs& A, LAS unsigned char* lds, int unit, int tid, int lane, int wave) {
    const int bs = unit >> 2, h = unit & 3; const size_t row = (size_t)MP + bs;
    const int vq = tid & 31, kg = tid >> 5;
    const float* S0 = A.S0 + (size_t)unit * 16384; float* S1 = A.out + OFF_HGS + (size_t)unit * 16384;
    const f32x4 vv = ld_bf4(A.HI + row * HGW + h * 128 + 4 * vq);
    f32x4 o = (f32x4){0.f, 0.f, 0.f, 0.f};
    f32x4 s[8];
#pragma unroll
    for (int i2 = 0; i2 < 8; ++i2) s[i2] = *(const f32x4*)(S0 + (size_t)(kg + 16 * i2) * 128 + 4 * vq);
#pragma unroll
    for (int i2 = 0; i2 < 8; ++i2) { const int k = kg + 16 * i2;
        const float f = __expf(A.GL[row * HGW + h * 128 + k]), qk = bf2f(A.HQ[row * HGW + h * 128 + k]);
        const f32x4 sn = s[i2] * f + vv * (1.f - f);
        *(f32x4*)(S1 + (size_t)k * 128 + 4 * vq) = sn; o += sn * qk; }
    LAS float* red = (LAS float*)lds; LAS float* ov = red + 16 * 128;
    __syncthreads();
    *(LAS f32x4*)(red + kg * 128 + 4 * vq) = o;
    __syncthreads();
    if (tid < 128) { float t = 0.f;
#pragma unroll
        for (int k2 = 0; k2 < 16; ++k2) t += red[k2 * 128 + tid];
        ov[tid] = t; }
    __syncthreads();
    if (wave == 0) { const float a = ov[lane], b2 = ov[lane + 64]; const float ss = wave_sum(a * a + b2 * b2); const float rs = 1.f / sqrtf(ss * (1.f / 128.f) + EPS);
        const size_t idx = row * HGW + h * 128;
        A.OHG[idx + lane] = (bf16_t)f2bf(a * rs * A.hgn[lane] * siluf_(bf2f(A.HGT[idx + lane])));
        A.OHG[idx + lane + 64] = (bf16_t)f2bf(b2 * rs * A.hgn[lane + 64] * siluf_(bf2f(A.HGT[idx + lane + 64]))); }
}

constexpr int D_SC = 0;
constexpr int D_LUT = D_SC + 4 * 1024 * 4;
constexpr int D_RED = D_LUT + 4 * 132 * 4;
constexpr int D_MISC = D_RED + 32 * 256 * 4;
constexpr int D_OUT = D_MISC + 256;
struct DecArgs { const bf16_t* Q; const float *GATES, *rel_table, *cache, *skw, *CKS, *CVS; const int* page_table; float* out; bf16_t* ONSA; };

#define DEC_BLOAD(dst, k0v, n, RS, OFF) do { _Pragma("unroll") for (int u_ = 0; u_ < 8; ++u_) { const int kk = (k0v) + 32 * u_ + ks; \
        if (kk < (n)) dst[u_] = __builtin_bit_cast(f32x4, __builtin_amdgcn_raw_buffer_load_b128(RS, (unsigned)(OFF) + 16u * l16, 0, 0)); else dst[u_] = (f32x4){0.f, 0.f, 0.f, 0.f}; } } while (0)
#define DEC_SCORE_ROW(kvu_, kk, live, DIST, COPYK) do { \
        float d_[4]; _Pragma("unroll") for (int r_ = 0; r_ < 4; ++r_) { const f32x4 p_ = kvu_ * qv[r_]; d_[r_] = (p_[0] + p_[1]) + (p_[2] + p_[3]); } \
        _Pragma("unroll") for (int r_ = 0; r_ < 4; ++r_) d_[r_] = row16_sum(d_[r_]); \
        if (live) { COPYK; if (l16 < 4) { const int dd_ = (DIST); SC[l16 * 1024 + kk] = d_[l16 == 0 ? 0 : (l16 == 1 ? 1 : (l16 == 2 ? 2 : 3))] + LUT[l16 * 132 + (dd_ > 128 ? 128 : dd_)]; } } } while (0)
#define DEC_KLOAD(dst, k0v, n, RS, OFF) do { _Pragma("unroll") for (int t_ = 0; t_ < 2; ++t_) { const int kb_t_ = (k0v) + 32 * wave + 16 * t_; const int kk = kb_t_ + l16; \
        if (kb_t_ < (n)) { const unsigned o_ = (unsigned)(OFF) + 16u * q4; _Pragma("unroll") for (int j_ = 0; j_ < 4; ++j_) dst[4 * t_ + j_] = __builtin_bit_cast(f32x4, __builtin_amdgcn_raw_buffer_load_b128(RS, o_ + 64u * j_, 0, 0)); } \
        else { _Pragma("unroll") for (int j_ = 0; j_ < 4; ++j_) dst[4 * t_ + j_] = (f32x4){0.f, 0.f, 0.f, 0.f}; } } } while (0)
#define DEC_KSCORE(src, k0v, n, DIST, COPYK) do { _Pragma("unroll") for (int t_ = 0; t_ < 2; ++t_) { const int kb_t_ = (k0v) + 32 * wave + 16 * t_; const int kk = kb_t_ + l16; \
        if (kb_t_ < (n)) { const f32x4 k0_v = src[4 * t_], k1_v = src[4 * t_ + 1], k2_v = src[4 * t_ + 2], k3_v = src[4 * t_ + 3]; \
            f32x4 sc_ = MFMA16(qa[0], pack8v(k0_v, k1_v), ((f32x4){0.f, 0.f, 0.f, 0.f})); sc_ = MFMA16(qa[1], pack8v(k2_v, k3_v), sc_); \
            COPYK; \
            if (lane < 16) { const int dd_ = (DIST); const int di_ = dd_ > 128 ? 128 : dd_; \
                _Pragma("unroll") for (int r_ = 0; r_ < 4; ++r_) SC[r_ * 1024 + kk] = sc_[r_] + LUT[r_ * 132 + di_]; } } } } while (0)
#define DEC_SCORE_PASS(n, RS, OFF, DIST, COPYK, PRELOADED) do { if (!(PRELOADED)) DEC_KLOAD(ka_, 0, n, RS, OFF); \
    _Pragma("nounroll") for (int k0_ = 0; ; k0_ += 512) { \
        if (k0_ + 256 < (n)) DEC_KLOAD(kb_, k0_ + 256, n, RS, OFF); \
        DEC_KSCORE(ka_, k0_, n, DIST, COPYK); \
        if (k0_ + 256 >= (n)) break; \
        if (k0_ + 512 < (n)) DEC_KLOAD(ka_, k0_ + 512, n, RS, OFF); \
        DEC_KSCORE(kb_, k0_ + 256, n, DIST, COPYK); \
        if (k0_ + 512 >= (n)) break; } } while (0)
#define DEC_SCORE_ONE(kidx, PTR, DISTV) do { const f32x4 kone_ = (ks == 0) ? *(const f32x4*)((PTR) + 4 * l16) : (f32x4){0.f, 0.f, 0.f, 0.f}; const int kk = (kidx); \
        DEC_SCORE_ROW(kone_, kk, ks == 0, DISTV, (void)0); } while (0)
#define DEC_SOFTMAX(nkeys) do { __syncthreads(); if (wave < 4) { float m_ = -INFINITY; for (int kk = lane; kk < (nkeys); kk += 64) m_ = fmaxf(m_, SC[wave * 1024 + kk]); \
        m_ = wave_max(m_); float s_ = 0.f; \
        for (int kk = lane; kk < (nkeys); kk += 64) { const float e_ = ex2(SC[wave * 1024 + kk] - m_); SC[wave * 1024 + kk] = e_; s_ += e_; } \
        s_ = wave_sum(s_); if (lane == 0) MISCF[wave] = s_; } __syncthreads(); } while (0)
#define DEC_PV_BODY(src, k0v, n, COPYV) do { _Pragma("unroll") for (int u_ = 0; u_ < 8; ++u_) { const int kk = (k0v) + 32 * u_ + ks; const f32x4 vvu_ = src[u_]; \
        if (kk < (n)) { COPYV; _Pragma("unroll") for (int r_ = 0; r_ < 4; ++r_) oa_[r_] += vvu_ * SC[r_ * 1024 + kk]; } } } while (0)
#define DEC_PV_PASS(n, ntot, RS, OFF, COPYV, GATE, MIDDLE, TAILHOOK, HAS1, PTR1) do { f32x4 oa_[4]; _Pragma("unroll") for (int r_ = 0; r_ < 4; ++r_) oa_[r_] = (f32x4){0.f, 0.f, 0.f, 0.f}; \
    { f32x4 va_[8], vb_[8]; DEC_BLOAD(va_, 0, n, RS, OFF);        \
    f32x4 vone_ = (f32x4){0.f, 0.f, 0.f, 0.f}; if ((HAS1) && ks == 0) vone_ = *(const f32x4*)((PTR1) + 4 * l16); \
    DEC_SOFTMAX(ntot); MIDDLE; \
    if ((HAS1) && ks == 0) { _Pragma("unroll") for (int r_ = 0; r_ < 4; ++r_) oa_[r_] += vone_ * SC[r_ * 1024 + (n)]; } \
    _Pragma("nounroll") for (int k0_ = 0; ; k0_ += 512) { \
        if (k0_ + 256 < (n)) DEC_BLOAD(vb_, k0_ + 256, n, RS, OFF); \
        DEC_PV_BODY(va_, k0_, n, COPYV); \
        if (k0_ + 256 >= (n)) break; \
        if (k0_ + 512 < (n)) DEC_BLOAD(va_, k0_ + 512, n, RS, OFF); \
        DEC_PV_BODY(vb_, k0_ + 256, n, COPYV); \
        if (k0_ + 512 >= (n)) break; } } \
    _Pragma("unroll") for (int r_ = 0; r_ < 4; ++r_) *(LAS f32x4*)(RED + (ks * 4 + r_) * 64 + 4 * l16) = oa_[r_]; \
    __syncthreads(); \
    TAILHOOK;        \
    if (tid < 256) { const int r_ = tid >> 6, d_ = tid & 63; float t_ = 0.f; _Pragma("unroll 8") for (int s_ = 0; s_ < 32; ++s_) t_ += RED[(s_ * 4 + r_) * 64 + d_]; \
        const float L_ = MISCF[r_]; OUTB[tid] += (L_ > 0.f ? (GATE) / L_ : 0.f) * t_; } \
    __syncthreads(); } while (0)

DI void decode_unit(const DecArgs& A, LAS unsigned char* lds, int unit, int tid, int lane, int wave) {
    const int bs = unit >> 1, g = unit & 1; const size_t row = (size_t)MP + bs;
    asm volatile("" : "+v"(tid));
    const int l16 = tid & 15, ks = tid >> 4, q4 = lane >> 4;
    LAS float* SC = (LAS float*)(lds + D_SC); LAS float* LUT = (LAS float*)(lds + D_LUT); LAS float* RED = (LAS float*)(lds + D_RED);
    LAS float* MISCF = (LAS float*)(lds + D_MISC); LAS int* SELB = (LAS int*)(lds + D_MISC + 64); LAS float* OUTB = (LAS float*)(lds + D_OUT);
    __syncthreads();
    build_lut(LUT, A.rel_table, g, tid);
    f32x4 ka_[8], kb_[8];
    f32x4 qv[4];
#pragma unroll
    for (int r = 0; r < 4; ++r) qv[r] = ld_bf4(A.Q + row * NSAW + (4 * g + r) * 64 + 4 * l16);
    bf16x8 qa[2];
#pragma unroll
    for (int s2 = 0; s2 < 2; ++s2) { const bf16_t* qp = A.Q + row * NSAW + (4 * g + (l16 & 3)) * 64 + 32 * s2 + 4 * q4;
        const s16x4 z4 = {0, 0, 0, 0}; qa[s2] = (l16 < 4) ? cat44(*(const s16x4*)qp, *(const s16x4*)(qp + 16)) : cat44(z4, z4); }
    float gate0 = 0.f, gate1 = 0.f, gate2 = 0.f;
    if (tid < 256) { const int r = tid >> 6; const float* gp = A.GATES + row * 24 + (4 * g + r) * 3;
        gate0 = gp[0]; gate1 = gp[1]; gate2 = gp[2];
        OUTB[tid] = 0.f; }
    if (tid < NPAGES) ((LAS int*)(lds + D_MISC + 128))[tid] = A.page_table[bs * NPAGES + tid];
    __syncthreads();
    const auto rs_ck = __builtin_amdgcn_make_buffer_rsrc((void*)A.CKS, 0, BS * 2 * 4096 * 4, 0x00020000);
    const auto rs_cv = __builtin_amdgcn_make_buffer_rsrc((void*)A.CVS, 0, BS * 2 * 4096 * 4, 0x00020000);
    const auto rs_cache = __builtin_amdgcn_make_buffer_rsrc((void*)A.cache, 0, 2560u * PAGE * 512u * 4u, 0x00020000);
    const auto rs_win = __builtin_amdgcn_make_buffer_rsrc((void*)A.skw, 0, (unsigned)BS * WIN * 256 * 4, 0x00020000);
    const LAS int* pt = (const LAS int*)(lds + D_MISC + 128);
    const float* snewk = A.out + OFF_KV + (row * 4 + 2) * 128 + g * 64; const float* snewv = A.out + OFF_KV + (row * 4 + 3) * 128 + g * 64;
    float* wo = A.out + OFF_WINS + (size_t)bs * WIN * 256 + g * 64;
    const float* wnewk = wo + (size_t)(WIN - 1) * 256; const float* wnewv = wnewk + 128;
    const unsigned ckoff = (unsigned)(bs * 2 + g) * 4096u * 4u, wkoff = ((unsigned)bs * WIN * 256u + g * 64u) * 4u;
#define SEL_T(kk) (64 * SELB[(kk) >> 6] + ((kk) & 63))
#define SEL_OFF(kk, slot) ((((unsigned)pt[SEL_T(kk) >> 7] * PAGE + (SEL_T(kk) & 127)) * 512u + (slot) * 128u + g * 64u) * 4u)
    DEC_SCORE_PASS(64, rs_ck, ckoff + kk * 256u, PAST - (32 * kk + 31), (void)0, 0);
#define DEC_CMP_MIDDLE \
      if (wave == 0) { float imp = 0.f; \
          if (lane < 32) { _Pragma("unroll") for (int r = 0; r < 4; ++r) imp += (SC[r * 1024 + 2 * lane] + SC[r * 1024 + 2 * lane + 1]) / MISCF[r]; } \
          const bool cand = lane >= 1 && lane <= 30; int cnt = 0; \
          for (int j2 = 1; j2 <= 30; ++j2) { const float o2 = __shfl(imp, j2); cnt += (cand && (o2 > imp || (o2 == imp && j2 < lane))) ? 1 : 0; } \
          const bool sel = (lane == 0) || (lane == 31) || (cand && cnt < 13); \
          const unsigned long long bal = __ballot(sel); \
          if (sel) SELB[__builtin_popcountll(bal & ((1ull << lane) - 1ull))] = lane; }
    DEC_PV_PASS(64, 64, rs_cv, ckoff + kk * 256u, (void)0, gate0, DEC_CMP_MIDDLE, DEC_KLOAD(ka_, 0, 960, rs_cache, SEL_OFF(kk, 2)), 0, snewv);
#undef DEC_CMP_MIDDLE
    DEC_SCORE_PASS(960, rs_cache, SEL_OFF(kk, 2), PAST - SEL_T(kk), (void)0, 1);
    DEC_SCORE_ONE(960, snewk, 0);
    DEC_PV_PASS(960, 961, rs_cache, SEL_OFF(kk, 3), (void)0, gate1, (void)0, DEC_KLOAD(ka_, 0, 512, rs_win, wkoff + kk * 1024u), 1, snewv);
    DEC_SCORE_PASS(512, rs_win, wkoff + kk * 1024u, (WIN - (kk)), { if (kk >= 1) { float* wr_ = wo + (size_t)(kk - 1) * 256 + 4 * q4; *(f32x4*)wr_ = k0_v; *(f32x4*)(wr_ + 16) = k1_v; *(f32x4*)(wr_ + 32) = k2_v; *(f32x4*)(wr_ + 48) = k3_v; } }, 1);
    DEC_SCORE_ONE(512, wnewk, 0);
    DEC_PV_PASS(512, 513, rs_win, wkoff + 512u + kk * 1024u, { if (kk >= 1) *(f32x4*)(wo + (size_t)(kk - 1) * 256 + 128 + 4 * l16) = vvu_; }, gate2, (void)0, (void)0, 1, wnewv);
#undef SEL_T
#undef SEL_OFF
    if (tid < 256) A.ONSA[row * NSAW + (4 * g) * 64 + tid] = (bf16_t)f2bf(OUTB[tid]);
}

DI void phase_2a(const KParams& P, LAS unsigned char* lds, int vcu, int G, int tid, int lane, int wave) {
    unsigned char* ws = P.ws;
    { CmpArgs A{P.in[2], P.out + OFF_KV, P.page_table, (const bf16_t*)(ws + WS_W1K), (const bf16_t*)(ws + WS_W1V), P.in[14], P.in[16], P.in[12],
                (float*)(ws + WS_CKS), (float*)(ws + WS_CVS), (bf16_t*)(ws + WS_CKP), (bf16_t*)(ws + WS_CVP)};
#ifndef NO_CMP
      int rem_, W_; const bool early_ = cmp_early(G, P.ph_lo, rem_, W_);
      REP_LOOP(16) compress_phase(A, lds, vcu, G, early_ ? CMP_EARLY_Q : 0, 1024 + 64, tid, lane, wave);
#endif
    }
    __syncthreads();
    { HgArgs A{(const bf16_t*)(ws + WS_HQ), (const bf16_t*)(ws + WS_HI), (const bf16_t*)(ws + WS_HGT), (const float*)(ws + WS_GL), P.in[17],
               (float*)(ws + WS_SLOC), (float*)(ws + WS_GD), (bf16_t*)(ws + WS_OHG), P.out};
#ifndef NO_HG1
      REP_LOOP(17) for (int u = vcu; u < 256; u += G) hgrn_unit<false>(A, lds, u, tid, lane, wave);
#endif
    }
    __syncthreads();
    { HsArgs A{P.in[5], (const float*)(ws + WS_GL), P.in[17], (const bf16_t*)(ws + WS_HQ), (const bf16_t*)(ws + WS_HI), (const bf16_t*)(ws + WS_HGT), (bf16_t*)(ws + WS_OHG), P.out};
#ifndef NO_HGS
      REP_LOOP(18) for (int u = vcu; u < 512; u += G) hgrn_sample_unit(A, lds, u, tid, lane, wave);
#endif
    }
}
DI void phase_2b(const KParams& P, LAS unsigned char* lds, int vcu, int G, int tid0, int lane0, int wave0) {
    unsigned char* ws = P.ws;
#define IDS2() int tid = threadIdx.x; asm volatile("" : "+v"(tid)); const int lane = tid & 63, wave = __builtin_amdgcn_readfirstlane(tid >> 6)
    { IDS2(); AttnArgs A{(const bf16_t*)(ws + WS_Q), (const bf16_t*)(ws + WS_KVB), (const bf16_t*)(ws + WS_CKP), (const bf16_t*)(ws + WS_CVP), (const float*)(ws + WS_GATES), P.in[7], (bf16_t*)(ws + WS_ONSA)};
#ifndef NO_ATT
      __syncthreads();
      if (wave == 0) { int l2 = lane; asm volatile("" : "+v"(l2)); const float cb_ = score_bound(P.in[11], P.in[12], P.in[7], l2); if (l2 == 0) *(LAS float*)(lds + A_CSH) = cb_; }
      REP_LOOP(19) for (int pu = vcu; pu < 256; pu += G) { const int b = pu >> 5, g = (pu >> 4) & 1, i0 = pu & 15;
          __syncthreads();
          build_lut((LAS float*)(lds + A_LUT), A.rel_table, g, tid, *(const LAS float*)(lds + A_CSH));
          __syncthreads();
          attn_prompt_unit(A, lds, b, g, 31 - i0, tid, lane, wave);
          attn_prompt_unit(A, lds, b, g, i0, tid, lane, wave); }
#endif
    }
    __syncthreads();
    { IDS2(); HgArgs A{(const bf16_t*)(ws + WS_HQ), (const bf16_t*)(ws + WS_HI), (const bf16_t*)(ws + WS_HGT), (const float*)(ws + WS_GL), P.in[17],
               (float*)(ws + WS_SLOC), (float*)(ws + WS_GD), (bf16_t*)(ws + WS_OHG), P.out};
#ifndef NO_HG3
      REP_LOOP(20) for (int u = vcu; u < 256; u += G) hgrn_unit<true>(A, lds, u, tid, lane, wave);
#endif
    }
    __syncthreads();
    { IDS2(); DecArgs A{(const bf16_t*)(ws + WS_Q), (const float*)(ws + WS_GATES), P.in[7], P.in[2], P.in[4], (const float*)(ws + WS_CKS), (const float*)(ws + WS_CVS), P.page_table, P.out, (bf16_t*)(ws + WS_ONSA)};
#ifndef NO_DEC
      REP_LOOP(21) for (int u = vcu; u < 256; u += G) decode_unit(A, lds, u, tid, lane, wave);
#endif
    }
}

#ifndef MK_SINGLE
#define MK_SINGLE 1
#endif
constexpr int N_PHASES = 9;
__global__ void __launch_bounds__(NTHREADS, 2) hybrid_fwd(KParams P) {
    extern __shared__ __attribute__((aligned(16))) unsigned char lds_raw[];
    LAS unsigned char* lds = (LAS unsigned char*)lds_raw;
    volatile LAS unsigned* MISC = (volatile LAS unsigned*)(lds + MISC_OFF);
    const int G = gridDim.x, bx = blockIdx.x;
    const int vcu = (G % 8 == 0) ? (bx % 8) * (G / 8) + bx / 8 : bx;
    unsigned char* ws = P.ws;
    if (threadIdx.x < 64) MISC[threadIdx.x] = 0u;
    __syncthreads();
    XcdBarrier bar; bar.bar = (unsigned*)(ws + WS_CTL) + CW_BAR; bar.x = 0; bar.st = nullptr;
    const int lo = P.ph_lo, hi = P.ph_hi;
    if (hi - lo > 1) bar = xcd_barrier_post((unsigned*)(ws + WS_CTL) + CW_BAR, MISC + 8);
#define IN(k) (lo <= (k) && (k) < hi)
#define SEAM(k) do { if (IN(k) && IN((k) + 1)) xcd_barrier(bar); } while (0)
    float* out = P.out;
#define WSP(T_, off) ((T_*)(ws + (off)))
#define FRESH_IDS() int tid = threadIdx.x; asm volatile("" : "+v"(tid)); const int lane = tid & 63, wave = __builtin_amdgcn_readfirstlane(tid >> 6); (void)lane; (void)wave
    if (IN(0)) REP_LOOP(0) { FRESH_IDS();
        P0Args a{P.in[10], P.in[18], P.in[19], P.in[20], P.in[22], P.in[23], P.in[26], P.in[13], P.in[15], P.in[0], P.in[1], P.in[9], P.in[21],
                 WSP(bf16_t, WS_WIN), WSP(bf16_t, WS_WA), WSP(bf16_t, WS_WB), WSP(bf16_t, WS_WO), WSP(bf16_t, WS_WG), WSP(bf16_t, WS_WU), WSP(bf16_t, WS_WD), WSP(bf16_t, WS_W1K), WSP(bf16_t, WS_W1V), WSP(bf16_t, WS_XN)};
        p0_prologue(a, lds, vcu * NWAVES + wave, G * NWAVES, lane, wave);
    }
    SEAM(0);
    if (IN(1)) REP_LOOP(1) {
        pg8::Gemm g{WSP(bf16_t, WS_XN), WSP(bf16_t, WS_WIN), MPAD, NIN, DM}; pg8::StaticOrder S; S.init(MPAD, NIN, G, bx);
        EpiInProj E{WSP(bf16_t, WS_Q), WSP(bf16_t, WS_KVB), WSP(bf16_t, WS_HQ), WSP(bf16_t, WS_HI), WSP(bf16_t, WS_HGT), WSP(bf16_t, WS_MG), WSP(float, WS_GL), WSP(float, WS_GATES), out, P.in[11], P.in[12], P.in[8]};
#ifndef NO_GEMM
        pg8::gemm_phase<EpiInProj, pg8::StaticOrder, true, true>(lds, g, S, E);
#endif
        { int rem, W;
          if (cmp_early(G, lo, rem, W) && bx >= rem && bx - rem < W) { FRESH_IDS();
              CmpArgs A{P.in[2], P.out + OFF_KV, P.page_table, WSP(bf16_t, WS_W1K), WSP(bf16_t, WS_W1V), P.in[14], P.in[16], P.in[12],
                        WSP(float, WS_CKS), WSP(float, WS_CVS), WSP(bf16_t, WS_CKP), WSP(bf16_t, WS_CVP)};
              compress_phase(A, lds, bx - rem, W, 0, CMP_EARLY_Q, tid, lane, wave); } }
    }
    SEAM(1);
    if (IN(2)) { FRESH_IDS(); phase_2a(P, lds, vcu, G, tid, lane, wave); }
    SEAM(2);
    if (IN(3)) { FRESH_IDS(); phase_2b(P, lds, vcu, G, tid, lane, wave); }
    SEAM(3);
    if (IN(4)) REP_LOOP(4) {
        { pg8::Gemm g{WSP(bf16_t, WS_OHG), WSP(bf16_t, WS_WB), MP, DM, HGW}; pg8::StaticOrder S; S.init(MP, DM, G, bx); EpiMergeB E{WSP(bf16_t, WS_MG), WSP(bf16_t, WS_T)};
#ifndef NO_GEMM
          pg8::gemm_phase<EpiMergeB, pg8::StaticOrder, true, true>(lds, g, S, E);
#endif
        }
        { pg8::Gemm g{WSP(bf16_t, WS_ONSA), WSP(bf16_t, WS_WA), MP, DM, NSAW}; pg8::StaticOrder S; S.init(MP, DM, G, bx); EpiMergeA E{WSP(bf16_t, WS_MG), WSP(bf16_t, WS_T), WSP(bf16_t, WS_MB)};
#ifndef NO_GEMM
          pg8::gemm_phase<EpiMergeA, pg8::StaticOrder, true, true>(lds, g, S, E);
#endif
        }
        FRESH_IDS();
        skinny_gemm<2>(WSP(bf16_t, WS_OHG) + (size_t)MP * HGW, WSP(bf16_t, WS_WB), HGW, WSP(bf16_t, WS_ONSA) + (size_t)MP * NSAW, WSP(bf16_t, WS_WA), NSAW, lds, bx, G, lane, wave,
            SkMerge{WSP(bf16_t, WS_MG), WSP(bf16_t, WS_MB)});
    }
    SEAM(4);
    if (IN(5)) REP_LOOP(5) {
        pg8::Gemm g{WSP(bf16_t, WS_MB), WSP(bf16_t, WS_WO), MP, DM, DM}; pg8::StaticOrder S; S.init(MP, DM, G, bx);
        EpiWo E{P.in[0], P.in[1], WSP(bf16_t, WS_T + 33 * MiB), WSP(float, WS_SSQ)};
#ifndef NO_GEMM
        pg8::gemm_phase<EpiWo, pg8::StaticOrder, true, true>(lds, g, S, E);
#endif
        FRESH_IDS();
        skinny_gemm<1>(WSP(bf16_t, WS_MB) + (size_t)MP * DM, WSP(bf16_t, WS_WO), DM, nullptr, nullptr, 0, lds, bx, G, lane, wave,
            SkWo{P.in[1], WSP(bf16_t, WS_T + 33 * MiB), WSP(float, WS_SSQ) + SSQS_OFF});
    }
    SEAM(5);
    if (IN(6)) REP_LOOP(6) { FRESH_IDS();
        for (int r_ = bx * NTHREADS + tid; r_ < MROWS; r_ += G * NTHREADS) WSP(float, WS_SSQ)[RSTD_OFF + r_] = row_rstd(WSP(float, WS_SSQ), r_);
        halo_gemm(WSP(bf16_t, WS_T + 33 * MiB), WSP(bf16_t, WS_WG), WSP(float, WS_SSQ), WSP(float, WS_G), lds, bx, G, lane, wave);
    }
    SEAM(6);
    if (IN(7)) REP_LOOP(7) {
        pg8::Gemm g{WSP(bf16_t, WS_T + 33 * MiB), WSP(bf16_t, WS_WG), MPAD, 2 * DFF, DM}; pg8::StaticOrder S; S.init(MPAD, 2 * DFF, G, bx);
        EpiGU E{WSP(float, WS_SSQ), WSP(float, WS_G), WSP(bf16_t, WS_H), out, P.in[6], P.in[24], P.in[25], lds};
#ifndef NO_GEMM
        pg8::gemm_phase<EpiGU, pg8::StaticOrder, true, true>(lds, g, S, E);
#endif
    }
    SEAM(7);
    if (IN(8)) REP_LOOP(8) {
        pg8::Gemm g{WSP(bf16_t, WS_H), WSP(bf16_t, WS_WD), MP, DM, DFF}; pg8::StaticOrder S; S.init(MP, DM, G, bx);
        EpiDown E{WSP(bf16_t, WS_T + 33 * MiB), out + OFF_Y};
#ifndef NO_GEMM
        pg8::gemm_phase<EpiDown, pg8::StaticOrder, true, true>(lds, g, S, E);
#endif
        FRESH_IDS();
        skinny_gemm<1>(WSP(bf16_t, WS_H) + (size_t)MP * DFF, WSP(bf16_t, WS_WD), DFF, nullptr, nullptr, 0, lds, bx, G, lane, wave,
            SkDown{WSP(bf16_t, WS_T + 33 * MiB), out + OFF_Y});
    }
#ifdef MK_EXTRA_BARRIERS
    if (hi - lo > 1) for (int eb_ = 0; eb_ < MK_EXTRA_BARRIERS; ++eb_) xcd_barrier(bar);
#endif
#ifdef MK_EXTRA_PHASE
    if (IN(13)) { pg8::Gemm g{WSP(bf16_t, WS_XN), WSP(bf16_t, WS_WIN), MPAD, NIN, DM}; pg8::StaticOrder S; S.init(MPAD, NIN, G, bx); EpiNull E{WSP(float, WS_G) + 4000000};
        pg8::gemm_phase<EpiNull, pg8::StaticOrder, true, true>(lds, g, S, E); }
    if (IN(10)) { pg8::Gemm g{WSP(bf16_t, WS_OHG), WSP(bf16_t, WS_WB), MP, DM, HGW}; pg8::StaticOrder S; S.init(MP, DM, G, bx); EpiMergeB E{WSP(bf16_t, WS_MG), WSP(bf16_t, WS_T)};
        pg8::gemm_phase<EpiMergeB, pg8::StaticOrder, true, true>(lds, g, S, E); }
    if (IN(11)) { pg8::Gemm g{WSP(bf16_t, WS_ONSA), WSP(bf16_t, WS_WA), MP, DM, NSAW}; pg8::StaticOrder S; S.init(MP, DM, G, bx); EpiMergeA E{WSP(bf16_t, WS_MG), WSP(bf16_t, WS_T), WSP(bf16_t, WS_MB)};
        pg8::gemm_phase<EpiMergeA, pg8::StaticOrder, true, true>(lds, g, S, E); }
    if (IN(12)) { FRESH_IDS();
        skinny_gemm<2>(WSP(bf16_t, WS_OHG) + (size_t)MP * HGW, WSP(bf16_t, WS_WB), HGW, WSP(bf16_t, WS_ONSA) + (size_t)MP * NSAW, WSP(bf16_t, WS_WA), NSAW, lds, bx, G, lane, wave,
            SkMerge{WSP(bf16_t, WS_MG), WSP(bf16_t, WS_MB)}); }
#endif
#undef IN
#undef SEAM
}

extern "C" void kernel_launch(void* const* d_in, const int* in_sizes, int n_in, void* d_out, int out_size, void* d_ws, size_t ws_size, hipStream_t stream) {
    static int grid = 0;
    if (grid == 0) {
        if (n_in != 27 || (size_t)out_size != OUT_TOTAL || ws_size < WS_END) {
            fprintf(stderr, "kernel_launch: unexpected problem: n_in %d out %d ws %zu (need %zu)\n", n_in, out_size, ws_size, (size_t)WS_END); grid = -1; return; }
        int dev = 0, cus = 0, per_cu = 0;
        if (hipGetDevice(&dev) != hipSuccess || hipDeviceGetAttribute(&cus, hipDeviceAttributeMultiprocessorCount, dev) != hipSuccess) { grid = -1; return; }
        if (hipFuncSetAttribute((const void*)hybrid_fwd, hipFuncAttributeMaxDynamicSharedMemorySize, LDS_BYTES) != hipSuccess) { fprintf(stderr, "kernel_launch: hipFuncSetAttribute failed\n"); grid = -1; return; }
        if (hipOccupancyMaxActiveBlocksPerMultiprocessor(&per_cu, (const void*)hybrid_fwd, NTHREADS, LDS_BYTES) != hipSuccess || per_cu < 1) {
            fprintf(stderr, "kernel_launch: occupancy query reports %d workgroups per CU\n", per_cu); }
        (void)hipGetLastError();
        grid = cus;
    }
    if (grid < 0) return;
    (void)hipMemsetAsync((char*)d_ws + WS_CTL, 0, CTL_ZERO_BYTES, stream);
    KParams p{};
    for (int i = 0; i < 27; ++i) p.in[i] = (const float*)d_in[i];
    p.page_table = (const int*)d_in[3]; p.out = (float*)d_out; p.ws = (unsigned char*)d_ws;
#if MK_SINGLE
    p.ph_lo = 0; p.ph_hi = N_PHASES; p.rep = MK_REP;
    hipLaunchKernelGGL(hybrid_fwd, dim3(grid), dim3(NTHREADS), LDS_BYTES, stream, p);
#ifdef MK_EXTRA_PHASE
    p.ph_lo = MK_EXTRA_PHASE; p.ph_hi = MK_EXTRA_PHASE + 1;
    hipLaunchKernelGGL(hybrid_fwd, dim3(grid), dim3(NTHREADS), LDS_BYTES, stream, p);
#endif
#else
    for (int k = 0; k < N_PHASES; ++k) { p.ph_lo = k; p.ph_hi = k + 1; hipLaunchKernelGGL(hybrid_fwd, dim3(grid), dim3(NTHREADS), LDS_BYTES, stream, p); }
#endif
}
```

```cpp
#include <hip/hip_runtime.h>
#include <cstdio>
#include <cstdint>
#include <cmath>
namespace pg8 {
#define PG8_LAS __attribute__((address_space(3)))
typedef unsigned short bf16_t;
typedef short bf16x8 __attribute__((ext_vector_type(8)));
typedef float f32x4 __attribute__((ext_vector_type(4)));
typedef unsigned u32x4 __attribute__((ext_vector_type(4)));
constexpr int BM = 256, BK = 64, HALF = 128, HTB = HALF * BK * 2  , STAGE_BYTES = 8 * HTB, NXCD = 8, WGM = 8;

__host__ __device__ __forceinline__ int lds_byte(int r, int c) { const int st = (r >> 4) * 2 + (c >> 5), rr = r & 15, cc = c & 31, ob = rr * 64 + cc * 2; return st * 1024 + (ob ^ (((ob >> 9) & 1) << 5)); }
__host__ __device__ __forceinline__ void stage_rc(int b, int& R, int& C) { const int st = b / 1024, sb = b % 1024, swz = sb ^ (((sb >> 9) & 1) << 5); R = (st >> 1) * 16 + swz / 64; C = (st & 1) * 32 + (swz % 64) / 2; }
__host__ __device__ __forceinline__ int perm32(int rho) { const int n = rho >> 4, i = rho & 15; return 8 * (i >> 2) + 4 * n + (i & 3); }

struct Unit { int pm, pn; };
struct Gemm { const bf16_t* A; const bf16_t* Bt; int M, N, K; };

struct StaticOrder {
    int nM, nN, nwg, G, c;
    __host__ __device__ void init(int M, int N, int G_, int c_) { nM = M / BM; nN = N / BM; nwg = nM * nN; G = G_; c = c_; }
    __host__ __device__ bool next(int i, Unit& u) const {
        const long L = (long)i * G + c; if (L >= nwg) return false;
        int wgid = (int)L; { const int q = nwg / NXCD, r = nwg % NXCD, xcd = wgid % NXCD, off = wgid / NXCD; wgid = (xcd < r ? xcd * (q + 1) : r * (q + 1) + (xcd - r) * q) + off; }
        const int nig = WGM * nN, gid = wgid / nig, fm = gid * WGM, gsz = (nM - fm) < WGM ? (nM - fm) : WGM;
        u.pm = fm + ((wgid % nig) % gsz); u.pn = (wgid % nig) / gsz; return true;
    }
    __device__ __forceinline__ void a_ready(const Unit&) const {}
    __device__ __forceinline__ void done(const Unit&) const {}
};

template <class Epi, class Sched, bool ALIGN_EPI = false, bool SP2 = false>
__device__ __forceinline__ void gemm_phase(PG8_LAS unsigned char* lds, const Gemm g, const Sched& S, const Epi& E) {
    const int tid = threadIdx.x, wid = __builtin_amdgcn_readfirstlane(tid >> 6), lane = tid & 63, wr = wid >> 2, wc = wid & 3, fr = lane & 15, fq = lane >> 4;
    const int K = g.K, nt = K / BK;
    unsigned voffA[2], voffB[2];
#pragma unroll
    for (int i = 0; i < 2; ++i) { int R, C; stage_rc(tid * 16 + i * 8192, R, C); const int Rb = Epi::PERM ? ((R & ~31) + perm32(R & 31)) : R;
        voffA[i] = (unsigned)(R * K + C) * 2u; voffB[i] = (unsigned)(Rb * K + C) * 2u; }
    const size_t kstep = (size_t)(BK * 2);
    const size_t hstep = (size_t)HALF * K * 2;
    const size_t tstep = 2 * hstep;
    const unsigned ldsw = (unsigned)wid * 1024u;
    const int aoff = lds_byte(wr * 64 + fr, fq * 8), boff = lds_byte(wc * 32 + fr, fq * 8);
#define PG8_SA(b, h) (((b) * 2 + (h)) * HTB)
#define PG8_SB(b, h) ((4 + (b) * 2 + (h)) * HTB)
#define PG8_STAGE(bufoff, gbase, voff) do { _Pragma("unroll") for (int _i = 0; _i < 2; ++_i) \
        __builtin_amdgcn_global_load_lds((const unsigned*)((const char*)(gbase) + (voff)[_i]), (PG8_LAS unsigned*)(lds + (bufoff) + ldsw + _i * 8192), 16, 0, 0); } while (0)
#define PG8_LDA(dst, b, h) do { _Pragma("unroll") for (int m = 0; m < 4; ++m) _Pragma("unroll") for (int k = 0; k < 2; ++k) dst[m][k] = *(const PG8_LAS bf16x8*)(lds + PG8_SA(b, h) + aoff + m * 2048 + k * 1024); } while (0)
#define PG8_LDB(dst, b, h) do { _Pragma("unroll") for (int n = 0; n < 2; ++n) _Pragma("unroll") for (int k = 0; k < 2; ++k) dst[n][k] = *(const PG8_LAS bf16x8*)(lds + PG8_SB(b, h) + boff + n * 2048 + k * 1024); } while (0)
#define PG8_MMA(ai, bj, At, Bt) do { __builtin_amdgcn_s_setprio(1); _Pragma("unroll") for (int m = 0; m < 4; ++m) _Pragma("unroll") for (int n = 0; n < 2; ++n) _Pragma("unroll") for (int k = 0; k < 2; ++k) \
        acc[ai][bj][m][n] = __builtin_amdgcn_mfma_f32_16x16x32_bf16(Bt[n][k], At[m][k], acc[ai][bj][m][n], 0, 0, 0); __builtin_amdgcn_s_setprio(0); } while (0)
#define PG8_WAIT_V(n) asm volatile("s_waitcnt vmcnt(" #n ")" ::: "memory")
#define PG8_WAIT_L(n) asm volatile("s_waitcnt lgkmcnt(" #n ")" ::: "memory")
#define PG8_BAR __builtin_amdgcn_s_barrier()
#define PG8_SCHED __builtin_amdgcn_sched_barrier(0)
    Unit cur, nxt; int ui = 0;
    if (!S.next(0, cur)) return;
    f32x4 acc[2][2][4][2];
#pragma unroll
    for (int a = 0; a < 2; ++a)
#pragma unroll
        for (int b = 0; b < 2; ++b)
#pragma unroll
            for (int m = 0; m < 4; ++m)
#pragma unroll
                for (int n = 0; n < 2; ++n) acc[a][b][m][n] = (f32x4){0.f, 0.f, 0.f, 0.f};
    bf16x8 At[4][2], B0[2][2], B1[2][2];
    const char* cA = (const char*)g.A + (size_t)cur.pm * tstep; const char* cB = (const char*)g.Bt + (size_t)cur.pn * tstep;
    S.a_ready(cur);
    if constexpr (SP2) {
        PG8_STAGE(PG8_SB(0, 0), cB, voffB); PG8_STAGE(PG8_SB(0, 1), cB + hstep, voffB); PG8_STAGE(PG8_SA(0, 0), cA, voffA); PG8_STAGE(PG8_SA(0, 1), cA + hstep, voffA);
        if (wr == 1) PG8_BAR;
        PG8_WAIT_V(2); PG8_BAR;
        PG8_STAGE(PG8_SB(1, 0), cB + kstep, voffB); PG8_STAGE(PG8_SA(1, 0), cA + kstep, voffA); PG8_STAGE(PG8_SB(1, 1), cB + hstep + kstep, voffB);
        PG8_WAIT_V(6); PG8_BAR;
    } else {
        PG8_STAGE(PG8_SB(0, 0), cB, voffB); PG8_STAGE(PG8_SA(0, 0), cA, voffA); PG8_STAGE(PG8_SB(0, 1), cB + hstep, voffB); PG8_STAGE(PG8_SA(0, 1), cA + hstep, voffA);
        if (wr == 1) PG8_BAR;
        PG8_WAIT_V(4); PG8_BAR;
        PG8_STAGE(PG8_SB(1, 0), cB + kstep, voffB); PG8_STAGE(PG8_SA(1, 0), cA + kstep, voffA); PG8_STAGE(PG8_SB(1, 1), cB + hstep + kstep, voffB);
        PG8_WAIT_V(6); PG8_BAR;
    }
    for (;;) {
        const bool has_next = S.next(ui + 1, nxt);
        const char* nA = has_next ? (const char*)g.A + (size_t)nxt.pm * tstep : cA; const char* nB = has_next ? (const char*)g.Bt + (size_t)nxt.pn * tstep : cB;
        for (int t = 0; t < nt; t += 2) {
            const bool last = (t == nt - 2);
            const char* a1 = cA + (size_t)(t + 1) * kstep;
            const char* a2 = last ? nA : cA + (size_t)(t + 2) * kstep; const char* b2 = last ? nB : cB + (size_t)(t + 2) * kstep;
            const char* a3 = a2 + kstep; const char* b3 = b2 + kstep;
            if (last && has_next) S.a_ready(nxt);
            if constexpr (SP2) {
            PG8_LDB(B0, 0, 0); PG8_LDB(B1, 0, 1); PG8_SCHED; PG8_LDA(At, 0, 0); PG8_STAGE(PG8_SA(1, 1), a1 + hstep, voffA);
            PG8_WAIT_V(8); PG8_WAIT_L(0); PG8_BAR; PG8_MMA(0, 0, At, B0); PG8_MMA(0, 1, At, B1); PG8_BAR; PG8_SCHED;
            PG8_LDA(At, 0, 1); PG8_STAGE(PG8_SB(0, 0), b2, voffB); PG8_STAGE(PG8_SB(0, 1), b2 + hstep, voffB); PG8_STAGE(PG8_SA(0, 0), a2, voffA);
            PG8_WAIT_V(8); PG8_WAIT_L(0); PG8_BAR; PG8_MMA(1, 0, At, B0); PG8_MMA(1, 1, At, B1); PG8_BAR; PG8_SCHED;
            PG8_LDB(B0, 1, 0); PG8_LDB(B1, 1, 1); PG8_SCHED; PG8_LDA(At, 1, 0); PG8_STAGE(PG8_SA(0, 1), a2 + hstep, voffA);
            PG8_WAIT_V(8); PG8_WAIT_L(0); PG8_BAR; PG8_MMA(0, 0, At, B0); PG8_MMA(0, 1, At, B1); PG8_BAR; PG8_SCHED;
            PG8_LDA(At, 1, 1); PG8_STAGE(PG8_SB(1, 0), b3, voffB); PG8_STAGE(PG8_SB(1, 1), b3 + hstep, voffB); PG8_STAGE(PG8_SA(1, 0), a3, voffA);
            PG8_WAIT_V(8); PG8_WAIT_L(0); PG8_BAR; PG8_MMA(1, 0, At, B0); PG8_MMA(1, 1, At, B1); PG8_BAR; PG8_SCHED;
            } else {
            PG8_LDB(B0, 0, 0); PG8_SCHED; PG8_LDA(At, 0, 0); PG8_STAGE(PG8_SA(1, 1), a1 + hstep, voffA);
            PG8_WAIT_L(8); PG8_BAR; PG8_WAIT_L(0); PG8_MMA(0, 0, At, B0); PG8_BAR; PG8_SCHED;
            PG8_LDB(B1, 0, 1); PG8_STAGE(PG8_SB(0, 0), b2, voffB);
            PG8_BAR; PG8_WAIT_L(0); PG8_MMA(0, 1, At, B1); PG8_BAR;
            PG8_LDA(At, 0, 1); PG8_STAGE(PG8_SA(0, 0), a2, voffA);
            PG8_BAR; PG8_WAIT_L(0); PG8_MMA(1, 0, At, B0); PG8_BAR; PG8_SCHED;
            PG8_STAGE(PG8_SB(0, 1), b2 + hstep, voffB);
            PG8_WAIT_V(6); PG8_BAR; PG8_MMA(1, 1, At, B1); PG8_BAR;
            PG8_LDB(B0, 1, 0); PG8_SCHED; PG8_LDA(At, 1, 0); PG8_STAGE(PG8_SA(0, 1), a2 + hstep, voffA);
            PG8_WAIT_L(8); PG8_BAR; PG8_WAIT_L(0); PG8_MMA(0, 0, At, B0); PG8_BAR; PG8_SCHED;
            PG8_LDB(B1, 1, 1); PG8_STAGE(PG8_SB(1, 0), b3, voffB);
            PG8_BAR; PG8_WAIT_L(0); PG8_MMA(0, 1, At, B1); PG8_BAR;
            PG8_LDA(At, 1, 1); PG8_STAGE(PG8_SA(1, 0), a3, voffA);
            PG8_BAR; PG8_WAIT_L(0); PG8_MMA(1, 0, At, B0); PG8_BAR; PG8_SCHED;
            PG8_STAGE(PG8_SB(1, 1), b3 + hstep, voffB);
            PG8_WAIT_V(6); PG8_BAR; PG8_MMA(1, 1, At, B1); PG8_BAR;
            }
        }
        if constexpr (ALIGN_EPI) { if (wr == 0) PG8_BAR; }
        if constexpr (!Epi::AFTER_DRAIN) { E(acc, cur, wr, wc, fr, fq); S.done(cur); }
        if (!has_next) break;
#pragma unroll
        for (int a = 0; a < 2; ++a)
#pragma unroll
            for (int b = 0; b < 2; ++b)
#pragma unroll
                for (int m = 0; m < 4; ++m)
#pragma unroll
                    for (int n = 0; n < 2; ++n) acc[a][b][m][n] = (f32x4){0.f, 0.f, 0.f, 0.f};
        cur = nxt; cA = nA; cB = nB; ++ui;
        if constexpr (ALIGN_EPI) { if (wr == 1) PG8_BAR; }
    }
    PG8_WAIT_V(0);
    if constexpr (!ALIGN_EPI) { if (wr == 0) PG8_BAR; }
    PG8_BAR;
    if constexpr (Epi::AFTER_DRAIN) { E.fused(acc, cur, wr, wc, fr, fq, lds, wid, lane); S.done(cur); }
#undef PG8_SA
#undef PG8_SB
#undef PG8_STAGE
#undef PG8_LDA
#undef PG8_LDB
#undef PG8_MMA
#undef PG8_WAIT_V
#undef PG8_WAIT_L
#undef PG8_BAR
#undef PG8_SCHED
}
}

namespace pg8 {
struct Gemm2 { const bf16_t* A; const bf16_t* Bt; const bf16_t* A2; const bf16_t* Bt2; int M, N, K; };
template <class Epi, class Hook, class Sched, bool ALIGN_EPI = false, bool SP2 = false>
__device__ __forceinline__ void gemm_phase_dual(PG8_LAS unsigned char* lds, const Gemm2 g, const Sched& S, const Hook& H, const Epi& E) {
    const int tid = threadIdx.x, wid = __builtin_amdgcn_readfirstlane(tid >> 6), lane = tid & 63, wr = wid >> 2, wc = wid & 3, fr = lane & 15, fq = lane >> 4;
    const int K = g.K, nh = K / BK, nt = 2 * nh;
    unsigned voffA[2], voffB[2];
#pragma unroll
    for (int i = 0; i < 2; ++i) { int R, C; stage_rc(tid * 16 + i * 8192, R, C); const int Rb = Epi::PERM ? ((R & ~31) + perm32(R & 31)) : R;
        voffA[i] = (unsigned)(R * K + C) * 2u; voffB[i] = (unsigned)(Rb * K + C) * 2u; }
    const size_t kstep = (size_t)(BK * 2);
    const size_t hstep = (size_t)HALF * K * 2;
    const size_t tstep = 2 * hstep;
    const unsigned ldsw = (unsigned)wid * 1024u;
    const int aoff = lds_byte(wr * 64 + fr, fq * 8), boff = lds_byte(wc * 32 + fr, fq * 8);
#define PG8_SA(b, h) (((b) * 2 + (h)) * HTB)
#define PG8_SB(b, h) ((4 + (b) * 2 + (h)) * HTB)
#define PG8_STAGE(bufoff, gbase, voff) do { _Pragma("unroll") for (int _i = 0; _i < 2; ++_i) \
        __builtin_amdgcn_global_load_lds((const unsigned*)((const char*)(gbase) + (voff)[_i]), (PG8_LAS unsigned*)(lds + (bufoff) + ldsw + _i * 8192), 16, 0, 0); } while (0)
#define PG8_LDA(dst, b, h) do { _Pragma("unroll") for (int m = 0; m < 4; ++m) _Pragma("unroll") for (int k = 0; k < 2; ++k) dst[m][k] = *(const PG8_LAS bf16x8*)(lds + PG8_SA(b, h) + aoff + m * 2048 + k * 1024); } while (0)
#define PG8_LDB(dst, b, h) do { _Pragma("unroll") for (int n = 0; n < 2; ++n) _Pragma("unroll") for (int k = 0; k < 2; ++k) dst[n][k] = *(const PG8_LAS bf16x8*)(lds + PG8_SB(b, h) + boff + n * 2048 + k * 1024); } while (0)
#define PG8_MMA(ai, bj, At, Bt) do { __builtin_amdgcn_s_setprio(1); _Pragma("unroll") for (int m = 0; m < 4; ++m) _Pragma("unroll") for (int n = 0; n < 2; ++n) _Pragma("unroll") for (int k = 0; k < 2; ++k) \
        acc[ai][bj][m][n] = __builtin_amdgcn_mfma_f32_16x16x32_bf16(Bt[n][k], At[m][k], acc[ai][bj][m][n], 0, 0, 0); __builtin_amdgcn_s_setprio(0); } while (0)
#define PG8_WAIT_V(n) asm volatile("s_waitcnt vmcnt(" #n ")" ::: "memory")
#define PG8_WAIT_L(n) asm volatile("s_waitcnt lgkmcnt(" #n ")" ::: "memory")
#define PG8_BAR __builtin_amdgcn_s_barrier()
#define PG8_SCHED __builtin_amdgcn_sched_barrier(0)
    Unit cur, nxt; int ui = 0;
    if (!S.next(0, cur)) return;
    f32x4 acc[2][2][4][2];
#pragma unroll
    for (int a = 0; a < 2; ++a)
#pragma unroll
        for (int b = 0; b < 2; ++b)
#pragma unroll
            for (int m = 0; m < 4; ++m)
#pragma unroll
                for (int n = 0; n < 2; ++n) acc[a][b][m][n] = (f32x4){0.f, 0.f, 0.f, 0.f};
    bf16x8 At[4][2], B0[2][2], B1[2][2];
    const char* cA = (const char*)g.A + (size_t)cur.pm * tstep; const char* cB = (const char*)g.Bt + (size_t)cur.pn * tstep;
    const char* cA2 = (const char*)g.A2 + (size_t)cur.pm * tstep; const char* cB2 = (const char*)g.Bt2 + (size_t)cur.pn * tstep;
#define PG8_KTA(t_) ((t_) < nh ? cA + (size_t)(t_) * kstep : cA2 + (size_t)((t_) - nh) * kstep)
#define PG8_KTB(t_) ((t_) < nh ? cB + (size_t)(t_) * kstep : cB2 + (size_t)((t_) - nh) * kstep)
    S.a_ready(cur);
    if constexpr (SP2) {
        PG8_STAGE(PG8_SB(0, 0), cB, voffB); PG8_STAGE(PG8_SB(0, 1), cB + hstep, voffB); PG8_STAGE(PG8_SA(0, 0), cA, voffA); PG8_STAGE(PG8_SA(0, 1), cA + hstep, voffA);
        if (wr == 1) PG8_BAR;
        PG8_WAIT_V(2); PG8_BAR;
        PG8_STAGE(PG8_SB(1, 0), cB + kstep, voffB); PG8_STAGE(PG8_SA(1, 0), cA + kstep, voffA); PG8_STAGE(PG8_SB(1, 1), cB + hstep + kstep, voffB);
        PG8_WAIT_V(6); PG8_BAR;
    } else {
        PG8_STAGE(PG8_SB(0, 0), cB, voffB); PG8_STAGE(PG8_SA(0, 0), cA, voffA); PG8_STAGE(PG8_SB(0, 1), cB + hstep, voffB); PG8_STAGE(PG8_SA(0, 1), cA + hstep, voffA);
        if (wr == 1) PG8_BAR;
        PG8_WAIT_V(4); PG8_BAR;
        PG8_STAGE(PG8_SB(1, 0), cB + kstep, voffB); PG8_STAGE(PG8_SA(1, 0), cA + kstep, voffA); PG8_STAGE(PG8_SB(1, 1), cB + hstep + kstep, voffB);
        PG8_WAIT_V(6); PG8_BAR;
    }
    for (;;) {
        const bool has_next = S.next(ui + 1, nxt);
        const char* nA = has_next ? (const char*)g.A + (size_t)nxt.pm * tstep : cA; const char* nB = has_next ? (const char*)g.Bt + (size_t)nxt.pn * tstep : cB;
        for (int t = 0; t < nt; t += 2) {
            const bool last = (t == nt - 2);
            if (t == nh) H(acc, cur, wr, wc, fr, fq);
            const char* a1 = PG8_KTA(t + 1);
            const char* a2 = last ? nA : PG8_KTA(t + 2); const char* b2 = last ? nB : PG8_KTB(t + 2);
            const char* a3 = last ? nA + kstep : PG8_KTA(t + 3); const char* b3 = last ? nB + kstep : PG8_KTB(t + 3);
            if (last && has_next) S.a_ready(nxt);
            if constexpr (SP2) {
            PG8_LDB(B0, 0, 0); PG8_LDB(B1, 0, 1); PG8_SCHED; PG8_LDA(At, 0, 0); PG8_STAGE(PG8_SA(1, 1), a1 + hstep, voffA);
            PG8_WAIT_V(8); PG8_WAIT_L(0); PG8_BAR; PG8_MMA(0, 0, At, B0); PG8_MMA(0, 1, At, B1); PG8_BAR; PG8_SCHED;
            PG8_LDA(At, 0, 1); PG8_STAGE(PG8_SB(0, 0), b2, voffB); PG8_STAGE(PG8_SB(0, 1), b2 + hstep, voffB); PG8_STAGE(PG8_SA(0, 0), a2, voffA);
            PG8_WAIT_V(8); PG8_WAIT_L(0); PG8_BAR; PG8_MMA(1, 0, At, B0); PG8_MMA(1, 1, At, B1); PG8_BAR; PG8_SCHED;
            PG8_LDB(B0, 1, 0); PG8_LDB(B1, 1, 1); PG8_SCHED; PG8_LDA(At, 1, 0); PG8_STAGE(PG8_SA(0, 1), a2 + hstep, voffA);
            PG8_WAIT_V(8); PG8_WAIT_L(0); PG8_BAR; PG8_MMA(0, 0, At, B0); PG8_MMA(0, 1, At, B1); PG8_BAR; PG8_SCHED;
            PG8_LDA(At, 1, 1); PG8_STAGE(PG8_SB(1, 0), b3, voffB); PG8_STAGE(PG8_SB(1, 1), b3 + hstep, voffB); PG8_STAGE(PG8_SA(1, 0), a3, voffA);
            PG8_WAIT_V(8); PG8_WAIT_L(0); PG8_BAR; PG8_MMA(1, 0, At, B0); PG8_MMA(1, 1, At, B1); PG8_BAR; PG8_SCHED;
            } else {
            PG8_LDB(B0, 0, 0); PG8_SCHED; PG8_LDA(At, 0, 0); PG8_STAGE(PG8_SA(1, 1), a1 + hstep, voffA);
            PG8_WAIT_L(8); PG8_BAR; PG8_WAIT_L(0); PG8_MMA(0, 0, At, B0); PG8_BAR; PG8_SCHED;
            PG8_LDB(B1, 0, 1); PG8_STAGE(PG8_SB(0, 0), b2, voffB);
            PG8_BAR; PG8_WAIT_L(0); PG8_MMA(0, 1, At, B1); PG8_BAR;
            PG8_LDA(At, 0, 1); PG8_STAGE(PG8_SA(0, 0), a2, voffA);
            PG8_BAR; PG8_WAIT_L(0); PG8_MMA(1, 0, At, B0); PG8_BAR; PG8_SCHED;
            PG8_STAGE(PG8_SB(0, 1), b2 + hstep, voffB);
            PG8_WAIT_V(6); PG8_BAR; PG8_MMA(1, 1, At, B1); PG8_BAR;
            PG8_LDB(B0, 1, 0); PG8_SCHED; PG8_LDA(At, 1, 0); PG8_STAGE(PG8_SA(0, 1), a2 + hstep, voffA);
            PG8_WAIT_L(8); PG8_BAR; PG8_WAIT_L(0); PG8_MMA(0, 0, At, B0); PG8_BAR; PG8_SCHED;
            PG8_LDB(B1, 1, 1); PG8_STAGE(PG8_SB(1, 0), b3, voffB);
            PG8_BAR; PG8_WAIT_L(0); PG8_MMA(0, 1, At, B1); PG8_BAR;
            PG8_LDA(At, 1, 1); PG8_STAGE(PG8_SA(1, 0), a3, voffA);
            PG8_BAR; PG8_WAIT_L(0); PG8_MMA(1, 0, At, B0); PG8_BAR; PG8_SCHED;
            PG8_STAGE(PG8_SB(1, 1), b3 + hstep, voffB);
            PG8_WAIT_V(6); PG8_BAR; PG8_MMA(1, 1, At, B1); PG8_BAR;
            }
        }
        if constexpr (ALIGN_EPI) { if (wr == 0) PG8_BAR; }
        if constexpr (!Epi::AFTER_DRAIN) { E(acc, cur, wr, wc, fr, fq); S.done(cur); }
        if (!has_next) break;
#pragma unroll
        for (int a = 0; a < 2; ++a)
#pragma unroll
            for (int b = 0; b < 2; ++b)
#pragma unroll
                for (int m = 0; m < 4; ++m)
#pragma unroll
                    for (int n = 0; n < 2; ++n) acc[a][b][m][n] = (f32x4){0.f, 0.f, 0.f, 0.f};
        cur = nxt; cA = nA; cB = nB; cA2 = (const char*)g.A2 + (size_t)cur.pm * tstep; cB2 = (const char*)g.Bt2 + (size_t)cur.pn * tstep; ++ui;
        if constexpr (ALIGN_EPI) { if (wr == 1) PG8_BAR; }
    }
    PG8_WAIT_V(0);
    if constexpr (!ALIGN_EPI) { if (wr == 0) PG8_BAR; }
    PG8_BAR;
    if constexpr (Epi::AFTER_DRAIN) { E.fused(acc, cur, wr, wc, fr, fq, lds, wid, lane); S.done(cur); }
#undef PG8_KTA
#undef PG8_KTB
#undef PG8_SA
#undef PG8_SB
#undef PG8_STAGE
#undef PG8_LDA
#undef PG8_LDB
#undef PG8_MMA
#undef PG8_WAIT_V
#undef PG8_WAIT_L
#undef PG8_BAR
#undef PG8_SCHED
}
}
#define GAS __attribute__((address_space(1)))
#define LAS __attribute__((address_space(3)))
typedef unsigned short bf16;
typedef unsigned v4u __attribute__((ext_vector_type(4)));
typedef float f32x4 __attribute__((ext_vector_type(4)));
typedef short bf16x8 __attribute__((ext_vector_type(8)));
typedef GAS unsigned gu32;
typedef GAS unsigned long long gu64;
#define RLX_AGENT __ATOMIC_RELAXED, __HIP_MEMORY_SCOPE_AGENT
#define LDS_WAIT() asm volatile("s_waitcnt lgkmcnt(0)" ::: "memory")
#define VM_WAIT() asm volatile("s_waitcnt vmcnt(0)" ::: "memory")
__device__ __forceinline__ unsigned long long rt() { return __builtin_amdgcn_s_memrealtime(); }
__device__ __forceinline__ unsigned f2bf(float f) { unsigned u = __builtin_bit_cast(unsigned, f); return (u + 0x7fffu + ((u >> 16) & 1u)) >> 16; }
__device__ __forceinline__ unsigned pk2(float lo, float hi) { return f2bf(lo) | (f2bf(hi) << 16); }

#define XB_TMO      128
#define XB_XCNT(j)  (256  + 64 * (j))
#define XB_XSUB(j)  (1280 + 64 * (j))
#define XB_XGEN(j)  (2304 + 64 * (j))
#define XB_TOP      3328
#define XB_TOPGEN   3392
#define XCD_BAR_WORDS 3456
#define XB_SPIN_CAP (1u << 18)

__device__ __forceinline__ unsigned xb_ld(unsigned* p)              { return __hip_atomic_load(p, __ATOMIC_RELAXED, __HIP_MEMORY_SCOPE_AGENT); }
__device__ __forceinline__ unsigned xb_add(unsigned* p, unsigned v) { return __hip_atomic_fetch_add(p, v, __ATOMIC_RELAXED, __HIP_MEMORY_SCOPE_AGENT); }
__device__ __forceinline__ unsigned xb_xcc_id() { return (unsigned)__builtin_amdgcn_s_getreg((3 << 11) | 20) & 0xFu; }
#define XB_SPIN(cond, bar) do { unsigned _sp = 0; while (cond) { __builtin_amdgcn_s_sleep(1); \
    if ((++_sp & 255u) == 0u) { if (xb_ld(&(bar)[XB_TMO])) break; if (_sp > XB_SPIN_CAP) { atomicAdd(&(bar)[XB_TMO], 1u); break; } } } } while (0)

struct XcdBarrier {
    unsigned* bar; unsigned x;
    volatile LAS unsigned* st;
};

__device__ __forceinline__ XcdBarrier xcd_barrier_post(unsigned* bar, volatile LAS unsigned* st) {
    XcdBarrier b; b.bar = bar; b.x = xb_xcc_id(); b.st = st;
    if (threadIdx.x == 0) (void)xb_add(&bar[XB_XCNT(b.x)], 1u);
    return b;
}
__device__ __forceinline__ void xcd_barrier_complete(unsigned* bar, unsigned x, unsigned& nloc, unsigned& nx) {
    const unsigned G = gridDim.x * gridDim.y * gridDim.z;
    unsigned sum, cnt, mine, sp = 0u;
    for (;;) {
        sum = 0u; cnt = 0u; mine = 0u;
#pragma unroll
        for (unsigned j = 0; j < 16; ++j) { const unsigned c = xb_ld(&bar[XB_XCNT(j)]); sum += c; cnt += (c > 0u) ? 1u : 0u; mine = (j == x) ? c : mine; }
        if (sum == G) break;
        __builtin_amdgcn_s_sleep(1);
        if ((++sp & 255u) == 0u) { if (xb_ld(&bar[XB_TMO])) break; if (sp > XB_SPIN_CAP) { atomicAdd(&bar[XB_TMO], 1u); break; } }
    }
    nloc = mine > 0u ? mine : 1u; nx = cnt > 0u ? cnt : 1u;
}

__device__ __forceinline__ void xcd_barrier(const XcdBarrier& b) {
    asm volatile("s_waitcnt vmcnt(0)" ::: "memory");
    __syncthreads();
    if (threadIdx.x == 0) {
        unsigned* bar = b.bar;
        __builtin_amdgcn_s_waitcnt(0);
        unsigned nloc = b.st[0], nx = b.st[1];
        if (nloc == 0u) { xcd_barrier_complete(bar, b.x, nloc, nx); b.st[0] = nloc; b.st[1] = nx; }
        const unsigned old = xb_add(&bar[XB_XSUB(b.x)], 1u);
        const unsigned gen = old / nloc;
        if (old + 1u == (gen + 1u) * nloc) {
            __builtin_amdgcn_fence(__ATOMIC_RELEASE, "agent");
            asm volatile("s_waitcnt vmcnt(0)" ::: "memory");
            const unsigned og = xb_add(&bar[XB_TOP], 1u);
            const unsigned tg = og / nx;
            if (og + 1u == (tg + 1u) * nx) xb_add(&bar[XB_TOPGEN], 1u);
            else XB_SPIN(xb_ld(&bar[XB_TOPGEN]) == tg, bar);
            __builtin_amdgcn_fence(__ATOMIC_ACQUIRE, "agent");
            xb_add(&bar[XB_XGEN(b.x)], 1u);
            asm volatile("s_waitcnt vmcnt(0)" ::: "memory");
        } else {
            XB_SPIN(xb_ld(&bar[XB_XGEN(b.x)]) == gen, bar);
            __builtin_amdgcn_fence(__ATOMIC_ACQUIRE, "agent");
            asm volatile("s_waitcnt vmcnt(0)" ::: "memory");
        }
    }
    __syncthreads();
}

constexpr int NWAVES = 8, NTHREADS = 512;
constexpr int DM = 1024, BATCH_P = 8, SEQ = 2048, MP = BATCH_P * SEQ  , BS = 128  ;
constexpr int MROWS = MP + BS  , MPAD = 16640  ;
constexpr int NH = 8, NG = 2, NR = 4, HD = 64, NSAW = 512, KVW = 128;
constexpr int HGH = 4, HGD = 128, HGW = 512;
constexpr int DFF = 2816, CIN = 5400, NIN = 5632  ;
constexpr int PAST = 2048, PAGE = 128, NPAGES = 16, WIN = 512;
constexpr float EPS = 1e-6f, LOG2E = 1.4426950408889634f;
constexpr float QSCALE = 0.125f * LOG2E;
constexpr float HG_SCALE = 0.08838834764831845f;

constexpr size_t OFF_Y = 0, OFF_KV = 16908288, OFF_WINP = 25362432, OFF_WINS = 26411008, OFF_HGP = 43188224, OFF_HGS = 43712512,
                 OFF_CVP = 52101120, OFF_CVS = 52146176, OUT_TOTAL = 52867072;

typedef unsigned short bf16_t;
typedef short bf16x8 __attribute__((ext_vector_type(8)));
typedef short s16x4 __attribute__((ext_vector_type(4)));
typedef float f32x4 __attribute__((ext_vector_type(4)));
typedef float f32x2 __attribute__((ext_vector_type(2)));
typedef float f32x16 __attribute__((ext_vector_type(16)));
typedef unsigned u32x4 __attribute__((ext_vector_type(4)));
typedef unsigned u32x2 __attribute__((ext_vector_type(2)));
#define DI __device__ __forceinline__

typedef __bf16 hw_bf16x2 __attribute__((ext_vector_type(2)));
DI unsigned pkbf(float lo, float hi) { const f32x2 v = {lo, hi}; return __builtin_bit_cast(unsigned, __builtin_convertvector(v, hw_bf16x2)); }
#define pk2 pkbf
DI float bf2f(unsigned short b) { return __builtin_bit_cast(float, (unsigned)b << 16); }
DI float bflo(unsigned w) { return __builtin_bit_cast(float, w << 16); }
DI float bfhi(unsigned w) { return __builtin_bit_cast(float, w & 0xffff0000u); }
DI float sigmoidf_(float x) { return __builtin_amdgcn_rcpf(1.f + __expf(-x)); }
DI float siluf_(float x) { return x * __builtin_amdgcn_rcpf(1.f + __expf(-x)); }
template <int CTRL> DI float dppf(float x) { return __int_as_float(__builtin_amdgcn_update_dpp(0, __float_as_int(x), CTRL, 0xf, 0xf, true)); }
template <int CTRL> DI unsigned dppu(unsigned x) { return (unsigned)__builtin_amdgcn_update_dpp(0, (int)x, CTRL, 0xf, 0xf, true); }
DI float row16_sum(float s) { s += dppf<0xB1>(s); s += dppf<0x4E>(s); s += dppf<0x141>(s); s += dppf<0x140>(s); return s; }
DI float row16_max(float s) { s = fmaxf(s, dppf<0xB1>(s)); s = fmaxf(s, dppf<0x4E>(s)); s = fmaxf(s, dppf<0x141>(s)); s = fmaxf(s, dppf<0x140>(s)); return s; }
DI float x16_sum(float v) { auto rr = __builtin_amdgcn_permlane16_swap(__float_as_uint(v), __float_as_uint(v), false, false); return __uint_as_float(rr[0]) + __uint_as_float(rr[1]); }
DI float x32_sum(float v) { auto rr = __builtin_amdgcn_permlane32_swap(__float_as_uint(v), __float_as_uint(v), false, false); return __uint_as_float(rr[0]) + __uint_as_float(rr[1]); }
DI float x16_max(float v) { auto rr = __builtin_amdgcn_permlane16_swap(__float_as_uint(v), __float_as_uint(v), false, false); return fmaxf(__uint_as_float(rr[0]), __uint_as_float(rr[1])); }
DI float x32_max(float v) { auto rr = __builtin_amdgcn_permlane32_swap(__float_as_uint(v), __float_as_uint(v), false, false); return fmaxf(__uint_as_float(rr[0]), __uint_as_float(rr[1])); }
DI float wave_sum(float v) { return x32_sum(x16_sum(row16_sum(v))); }
DI float wave_max(float v) { return x32_max(x16_max(row16_max(v))); }
DI bf16x8 pack8(const float* v) { u32x4 p; p.x = pk2(v[0], v[1]); p.y = pk2(v[2], v[3]); p.z = pk2(v[4], v[5]); p.w = pk2(v[6], v[7]); return __builtin_bit_cast(bf16x8, p); }
DI bf16x8 pack8v(f32x4 a, f32x4 b) { u32x4 p; p.x = pk2(a[0], a[1]); p.y = pk2(a[2], a[3]); p.z = pk2(b[0], b[1]); p.w = pk2(b[2], b[3]); return __builtin_bit_cast(bf16x8, p); }
#define MFMA16(a, b, c) __builtin_amdgcn_mfma_f32_16x16x32_bf16((a), (b), (c), 0, 0, 0)
#define MFMA32(a, b, c) __builtin_amdgcn_mfma_f32_32x32x16_bf16((a), (b), (c), 0, 0, 0)
#define LAS __attribute__((address_space(3)))
typedef short v4i16_t __attribute__((ext_vector_type(4)));
DI s16x4 tr_read(const LAS void* p) { return __builtin_bit_cast(s16x4, __builtin_amdgcn_ds_read_tr16_b64_v4i16((LAS v4i16_t*)p)); }
DI bf16x8 cat44(s16x4 lo, s16x4 hi) { return __builtin_shufflevector(lo, hi, 0, 1, 2, 3, 4, 5, 6, 7); }

constexpr size_t MiB = 1u << 20;
constexpr size_t WS_CTL = 0, CTL_ZERO_BYTES = 1 * MiB;
constexpr size_t WS_WIN = 2 * MiB;
constexpr size_t WS_WA = 14 * MiB, WS_WB = 15 * MiB;
constexpr size_t WS_WO = 16 * MiB;
constexpr size_t WS_WG = 18 * MiB, WS_WU = 24 * MiB, WS_WD = 30 * MiB;
constexpr size_t WS_W1K = 36 * MiB, WS_W1V = 37 * MiB;
constexpr size_t WS_XN = 40 * MiB;
constexpr size_t WS_Q = 76 * MiB;
constexpr size_t WS_KVB = 94 * MiB;
constexpr size_t WS_HQ = 112 * MiB, WS_HI = 130 * MiB, WS_HGT = 148 * MiB;
constexpr size_t WS_GL = 166 * MiB;
constexpr size_t WS_MG = 200 * MiB;
constexpr size_t WS_GATES = 266 * MiB;
constexpr size_t WS_CKP = 268 * MiB, WS_CVP = 269 * MiB;
constexpr size_t WS_CKS = 270 * MiB, WS_CVS = 275 * MiB;
constexpr size_t WS_SLOC = 280 * MiB;
constexpr size_t WS_GD = 297 * MiB;
constexpr size_t WS_ONSA = 298 * MiB, WS_OHG = 316 * MiB;
constexpr size_t WS_T = 334 * MiB;
constexpr size_t WS_MB = 400 * MiB;
constexpr size_t WS_SSQ = 434 * MiB;
constexpr size_t WS_G = 436 * MiB;
constexpr size_t WS_H = 527 * MiB;
constexpr size_t WS_END = 618 * MiB;
constexpr int CW_BAR = 4096;

constexpr int RING_BYTES = 131072;
constexpr int LDS_BYTES = 147456;
constexpr int MISC_OFF = LDS_BYTES - 256;

struct KParams {
    const float* in[27];
    const int* page_table;
    float* out;
    unsigned char* ws;
    int ph_lo, ph_hi;
    int rep, pad_;
};

#ifndef MK_REP_BIT
#define MK_REP_BIT (-1)
#endif
#define MK_REP 0
#define REP_LOOP(k) _Pragma("nounroll") for (int rp_ = 0; rp_ < (((k) == MK_REP_BIT) ? 2 : 1); ++rp_)

DI void p0_transpose_item(const float* W, int K, int N, bf16_t* WT, int prow0, int src_col0, int nvalid, int k0, LAS float* scr, int lane, const float* kscale = nullptr) {
    float tv[32];
#pragma unroll
    for (int i = 0; i < 32; ++i) { const int kk = 2 * i + (lane >> 5), c = lane & 31; tv[i] = (c < nvalid) ? W[(size_t)(k0 + kk) * N + src_col0 + c] : 0.f; }
#pragma unroll
    for (int i = 0; i < 32; ++i) { const int kk = 2 * i + (lane >> 5), c = lane & 31; scr[kk * 33 + c] = kscale ? tv[i] * kscale[k0 + kk] : tv[i]; }
    asm volatile("s_waitcnt lgkmcnt(0)" ::: "memory");
    const int c = lane & 7;
#pragma unroll
    for (int j = 0; j < 4; ++j) { const int n = (lane >> 3) + 8 * j; const LAS float* s = scr + (8 * c) * 33 + n;
        u32x4 o; o.x = pk2(s[0 * 33], s[1 * 33]); o.y = pk2(s[2 * 33], s[3 * 33]); o.z = pk2(s[4 * 33], s[5 * 33]); o.w = pk2(s[6 * 33], s[7 * 33]);
        *(u32x4*)(WT + (size_t)(prow0 + n) * K + k0 + 8 * c) = o; }
    asm volatile("s_waitcnt lgkmcnt(0)" ::: "memory");
}
DI void inproj_src(int p0, int& src, int& nvalid) {
    const int pn = p0 >> 8, within = p0 & 255, bj = within >> 7, wc = (within >> 5) & 3;
    nvalid = 32;
    if (pn < 5) src = 64 * (4 * pn + wc) + 32 * bj;
    else if (pn < 21) src = p0 + 24;
    else { src = 1280; nvalid = (within < 32) ? 24 : 0; }
}
DI void rms_row_to_bf16(const float* xrow, const float* g, bf16_t* orow, int lane) {
    const f32x4* xr = (const f32x4*)xrow + lane; const f32x4* gr = (const f32x4*)g + lane;
    f32x4 v[4]; float s = 0.f;
#pragma unroll
    for (int j = 0; j < 4; ++j) { v[j] = xr[64 * j]; s += (v[j].x * v[j].x + v[j].y * v[j].y) + (v[j].z * v[j].z + v[j].w * v[j].w); }
    const float rs = 1.f / sqrtf(wave_sum(s) * (1.f / DM) + EPS);
    unsigned long long* o8 = (unsigned long long*)orow + lane;
#pragma unroll
    for (int j = 0; j < 4; ++j) { const f32x4 gg = gr[64 * j];
        o8[64 * j] = (unsigned long long)pk2(v[j].x * rs * gg.x, v[j].y * rs * gg.y) | ((unsigned long long)pk2(v[j].z * rs * gg.z, v[j].w * rs * gg.w) << 32); }
}
DI void rms_2rows_to_bf16(const float* xa, const float* xb, const float* g, bf16_t* oa, bf16_t* ob, int lane) {
    const f32x4* pa = (const f32x4*)xa + lane; const f32x4* pb = (const f32x4*)xb + lane; const f32x4* gr = (const f32x4*)g + lane;
    f32x4 va[4], vb[4], gg[4]; float sa = 0.f, sb = 0.f;
#pragma unroll
    for (int j = 0; j < 4; ++j) { va[j] = pa[64 * j]; vb[j] = pb[64 * j]; gg[j] = gr[64 * j]; }
#pragma unroll
    for (int j = 0; j < 4; ++j) { sa += (va[j].x * va[j].x + va[j].y * va[j].y) + (va[j].z * va[j].z + va[j].w * va[j].w); sb += (vb[j].x * vb[j].x + vb[j].y * vb[j].y) + (vb[j].z * vb[j].z + vb[j].w * vb[j].w); }
    const float ra = 1.f / sqrtf(wave_sum(sa) * (1.f / DM) + EPS), rb = 1.f / sqrtf(wave_sum(sb) * (1.f / DM) + EPS);
    unsigned long long* o8a = (unsigned long long*)oa + lane; unsigned long long* o8b = (unsigned long long*)ob + lane;
#pragma unroll
    for (int j = 0; j < 4; ++j) {
        o8a[64 * j] = (unsigned long long)pk2(va[j].x * ra * gg[j].x, va[j].y * ra * gg[j].y) | ((unsigned long long)pk2(va[j].z * ra * gg[j].z, va[j].w * ra * gg[j].w) << 32);
        o8b[64 * j] = (unsigned long long)pk2(vb[j].x * rb * gg[j].x, vb[j].y * rb * gg[j].y) | ((unsigned long long)pk2(vb[j].z * rb * gg[j].z, vb[j].w * rb * gg[j].w) << 32); }
}
struct P0Args {
    const float *w_in, *w_a, *w_b, *w_o, *w_g, *w_u, *w_d, *w1k, *w1v, *xp, *xs, *g1, *g2;
    bf16_t *WIN, *WA, *WB, *WO, *WG, *WU, *WD, *W1K, *W1V, *XN;
};
DI void p0_prologue(const P0Args& a, LAS unsigned char* lds, int gw, int NGW, int lane, int wave) {
    LAS float* scr = (LAS float*)(lds + wave * 16384);
    constexpr int I_IN = 16 * (NIN / 32), I_A = 8 * 32, I_O = 16 * 32, I_G = 16 * (DFF / 32), I_D = (DFF / 64) * 32, I_W1 = 32 * 2;
    constexpr int NITEMS = I_IN + 2 * I_A + I_O + 2 * I_G + I_D + 2 * I_W1;
    for (int it = gw; it < NITEMS; it += NGW) {
        int r = it;
        if (r < I_IN) { const int nb = NIN / 32, kb = r / nb, pb = r % nb; int src, nv; inproj_src(pb * 32, src, nv);
            p0_transpose_item(a.w_in, DM, CIN, a.WIN, pb * 32, src, nv, kb * 64, scr, lane); continue; } r -= I_IN;
        if (r < I_A) { const int kb = r / 32, pb = r % 32; p0_transpose_item(a.w_a, NSAW, DM, a.WA, pb * 32, pb * 32, 32, kb * 64, scr, lane); continue; } r -= I_A;
        if (r < I_A) { const int kb = r / 32, pb = r % 32; p0_transpose_item(a.w_b, HGW, DM, a.WB, pb * 32, pb * 32, 32, kb * 64, scr, lane); continue; } r -= I_A;
        if (r < I_O) { const int kb = r / 32, pb = r % 32; p0_transpose_item(a.w_o, DM, DM, a.WO, pb * 32, pb * 32, 32, kb * 64, scr, lane); continue; } r -= I_O;
        if (r < 2 * I_G) { const int nb = 2 * DFF / 32, kb = r / nb, pb = r % nb, pn = pb >> 3, w = pb & 7;
            p0_transpose_item(w < 4 ? a.w_g : a.w_u, DM, DFF, a.WG, pb * 32, 128 * pn + 32 * (w & 3), 32, kb * 64, scr, lane, a.g2); continue; } r -= 2 * I_G;
        if (r < I_D) { const int kb = r / 32, pb = r % 32; p0_transpose_item(a.w_d, DFF, DM, a.WD, pb * 32, pb * 32, 32, kb * 64, scr, lane); continue; } r -= I_D;
        if (r < I_W1) { const int kb = r / 2, pb = r % 2; p0_transpose_item(a.w1k, 2048, 64, a.W1K, pb * 32, pb * 32, 32, kb * 64, scr, lane); continue; } r -= I_W1;
        { const int kb = r / 2, pb = r % 2; p0_transpose_item(a.w1v, 2048, 64, a.W1V, pb * 32, pb * 32, 32, kb * 64, scr, lane); }
    }
    for (int m = gw; m < MROWS; m += 2 * NGW) {
        const int m2 = m + NGW; const bool two = m2 < MROWS;
        const float* xr = (m < MP) ? a.xp + (size_t)m * DM : a.xs + (size_t)(m - MP) * DM;
        const float* xr2 = two ? ((m2 < MP) ? a.xp + (size_t)m2 * DM : a.xs + (size_t)(m2 - MP) * DM) : xr;
        rms_2rows_to_bf16(xr, xr2, a.g1, a.XN + (size_t)m * DM, a.XN + (size_t)(two ? m2 : m) * DM, lane);
    }
}

typedef const f32x4 (&AccRef)[2][2][4][2];
DI void st_bf4(bf16_t* p, f32x4 v) { u32x2 w; w.x = pk2(v[0], v[1]); w.y = pk2(v[2], v[3]); *(u32x2*)p = w; }
DI f32x4 ld_bf4(const bf16_t* p) { const u32x2 w = *(const u32x2*)p; return (f32x4){bflo(w.x), bfhi(w.x), bflo(w.y), bfhi(w.y)}; }
DI f32x4 sig4(f32x4 v) { return (f32x4){sigmoidf_(v[0]), sigmoidf_(v[1]), sigmoidf_(v[2]), sigmoidf_(v[3])}; }

DI void st_bf8(bf16_t* p, f32x4 a, f32x4 b) { u32x4 w; w.x = pk2(a[0], a[1]); w.y = pk2(a[2], a[3]); w.z = pk2(b[0], b[1]); w.w = pk2(b[2], b[3]); *(u32x4*)p = w; }
struct EpiInProj {
    static constexpr bool PERM = true, AFTER_DRAIN = false;
    bf16_t *Q, *KVB, *HQ, *HI, *HGT, *MG; float *GL, *GATES, *out; const float *qg, *kg, *lbl;
    DI void operator()(AccRef acc, const pg8::Unit& u, int wr, int wc, int fr, int fq) const {
        const int pn = u.pn, rbase = u.pm * 256 + wr * 64 + fr;
        if (pn < 5) {
            const int hu = 4 * pn + wc;
            const int uu0 = hu - 8, slot0 = uu0 >> 1;
            const float* gsrc = (hu < 8) ? qg : kg + (slot0 == 2 ? 64 : 128);
            f32x4 gn4[2][2];
#pragma unroll
            for (int bj = 0; bj < 2; ++bj)
#pragma unroll
                for (int n = 0; n < 2; ++n) gn4[bj][n] = *(const f32x4*)(gsrc + 32 * bj + 8 * fq + 4 * n);
#pragma unroll
            for (int ai = 0; ai < 2; ++ai)
#pragma unroll
                for (int m = 0; m < 4; ++m) {
                    const int row = rbase + ai * 128 + m * 16;
                    float ss = 0.f;
#pragma unroll
                    for (int bj = 0; bj < 2; ++bj)
#pragma unroll
                        for (int n = 0; n < 2; ++n) { const f32x4 x = acc[ai][bj][m][n]; ss += (x[0] * x[0] + x[1] * x[1]) + (x[2] * x[2] + x[3] * x[3]); }
                    ss = x32_sum(x16_sum(ss));
                    if (row >= MROWS) continue;
                    const float rs = __builtin_amdgcn_rsqf(ss * (1.f / 64.f) + EPS);
                    if (hu < 8) {
#pragma unroll
                        for (int bj = 0; bj < 2; ++bj) st_bf8(Q + (size_t)row * NSAW + hu * 64 + 32 * bj + 8 * fq, acc[ai][bj][m][0] * gn4[bj][0] * (rs * QSCALE), acc[ai][bj][m][1] * gn4[bj][1] * (rs * QSCALE));
                    } else {
                        const int uu = hu - 8, slot = uu >> 1, g = uu & 1; const bool normed = (slot == 2 || slot == 4);
                        float* fdst;
                        if (slot < 4) fdst = out + OFF_KV + ((size_t)row * 4 + slot) * 128 + g * 64;
                        else if (row < MP) { const int b = row >> 11, t = row & 2047; fdst = (t >= SEQ - WIN) ? out + OFF_WINP + (((size_t)b * WIN + (t - (SEQ - WIN))) * 2 + (slot - 4)) * 128 + g * 64 : nullptr; }
                        else fdst = out + OFF_WINS + (((size_t)(row - MP) * WIN + (WIN - 1)) * 2 + (slot - 4)) * 128 + g * 64;
#pragma unroll
                        for (int bj = 0; bj < 2; ++bj) { const int d = 32 * bj + 8 * fq; f32x4 v0 = acc[ai][bj][m][0], v1 = acc[ai][bj][m][1];
                            if (normed) { v0 = v0 * gn4[bj][0] * rs; v1 = v1 * gn4[bj][1] * rs; }
                            if (fdst) { *(f32x4*)(fdst + d) = v0; *(f32x4*)(fdst + d + 4) = v1; }
                            if (slot >= 2) st_bf8(KVB + (size_t)row * 512 + (slot - 2) * 128 + g * 64 + d, v0, v1); }
                    }
                }
        } else if (pn < 21) {
            const int kind = (pn < 13) ? ((pn - 5) >> 1) : 4, cb = (pn < 13) ? 256 * ((pn - 5) & 1) : 256 * (pn - 13);
            f32x4 lb4[2][2];
            if (kind == 1) {
#pragma unroll
                for (int bj = 0; bj < 2; ++bj)
#pragma unroll
                    for (int n = 0; n < 2; ++n) { const int c = cb + 128 * bj + 32 * wc + 8 * fq + 4 * n; const f32x4 l0 = *(const f32x4*)(lbl + c), l1 = *(const f32x4*)(lbl + HGW + c);
#pragma unroll
                        for (int j = 0; j < 4; ++j) lb4[bj][n][j] = __builtin_amdgcn_rcpf(1.f + __expf(l1[j] - l0[j])); }
            }
#pragma unroll
            for (int ai = 0; ai < 2; ++ai)
#pragma unroll
                for (int m = 0; m < 4; ++m) {
                    const int row = rbase + ai * 128 + m * 16;
                    if (row >= MROWS) continue;
#pragma unroll
                    for (int bj = 0; bj < 2; ++bj) { const int c = cb + 128 * bj + 32 * wc + 8 * fq; const f32x4 x0 = acc[ai][bj][m][0], x1 = acc[ai][bj][m][1];
                        if (kind == 0) st_bf8(HQ + (size_t)row * HGW + c, x0 * HG_SCALE, x1 * HG_SCALE);
                        else if (kind == 1) { f32x4 o0, o1;
#pragma unroll
                            for (int j = 0; j < 4; ++j) { const float la = lb4[bj][0][j], lb = lb4[bj][1][j];
                                o0[j] = __logf(la + (1.f - la) * __builtin_amdgcn_rcpf(1.f + __expf(-x0[j]))); o1[j] = __logf(lb + (1.f - lb) * __builtin_amdgcn_rcpf(1.f + __expf(-x1[j]))); }
                            *(f32x4*)(GL + (size_t)row * HGW + c) = o0; *(f32x4*)(GL + (size_t)row * HGW + c + 4) = o1; }
                        else if (kind == 2) st_bf8(HI + (size_t)row * HGW + c, x0, x1);
                        else if (kind == 3) st_bf8(HGT + (size_t)row * HGW + c, x0, x1);
                        else st_bf8(MG + (size_t)row * 2048 + c, x0, x1); }
                }
        } else {
            if (wc == 0 && fq < 3) {
#pragma unroll
                for (int ai = 0; ai < 2; ++ai)
#pragma unroll
                    for (int m = 0; m < 4; ++m) {
                        const int row = rbase + ai * 128 + m * 16;
                        if (row >= MROWS) continue;
                        *(f32x4*)(GATES + (size_t)row * 24 + 8 * fq) = sig4(acc[ai][0][m][0]);
                        *(f32x4*)(GATES + (size_t)row * 24 + 8 * fq + 4) = sig4(acc[ai][0][m][1]);
                    }
            }
        }
    }
};

DI void bf8_to_f32(u32x4 w, f32x4& a, f32x4& b) { a = (f32x4){bflo(w.x), bfhi(w.x), bflo(w.y), bfhi(w.y)}; b = (f32x4){bflo(w.z), bfhi(w.z), bflo(w.w), bfhi(w.w)}; }
struct EpiMergeB {
    static constexpr bool PERM = true, AFTER_DRAIN = false;
    const bf16_t* MG; bf16_t* T;
    DI void operator()(AccRef acc, const pg8::Unit& u, int wr, int wc, int fr, int fq) const {
        const int rbase = u.pm * 256 + wr * 64 + fr, cbase = u.pn * 256 + 32 * wc + 8 * fq;
        u32x4 gv[2][4][2];
#pragma unroll
        for (int ai = 0; ai < 2; ++ai)
#pragma unroll
            for (int m = 0; m < 4; ++m)
#pragma unroll
                for (int bj = 0; bj < 2; ++bj) gv[ai][m][bj] = *(const u32x4*)(MG + (size_t)(rbase + ai * 128 + m * 16) * 2048 + DM + cbase + 128 * bj);
#pragma unroll
        for (int ai = 0; ai < 2; ++ai)
#pragma unroll
            for (int m = 0; m < 4; ++m)
#pragma unroll
                for (int bj = 0; bj < 2; ++bj) { f32x4 g0, g1; bf8_to_f32(gv[ai][m][bj], g0, g1);
                    st_bf8(T + (size_t)(rbase + ai * 128 + m * 16) * DM + cbase + 128 * bj, sig4(g0) * acc[ai][bj][m][0], sig4(g1) * acc[ai][bj][m][1]); }
    }
};
struct EpiMergeA {
    static constexpr bool PERM = true, AFTER_DRAIN = false;
    const bf16_t* MG; const bf16_t* T; bf16_t* MB;
    DI void operator()(AccRef acc, const pg8::Unit& u, int wr, int wc, int fr, int fq) const {
        const int rbase = u.pm * 256 + wr * 64 + fr, cbase = u.pn * 256 + 32 * wc + 8 * fq;
#pragma unroll
        for (int ai = 0; ai < 2; ++ai) {
            u32x4 gv[4][2], tv[4][2];
#pragma unroll
            for (int m = 0; m < 4; ++m)
#pragma unroll
                for (int bj = 0; bj < 2; ++bj) { const size_t row = rbase + ai * 128 + m * 16; const int c = cbase + 128 * bj;
                    gv[m][bj] = *(const u32x4*)(MG + row * 2048 + c); tv[m][bj] = *(const u32x4*)(T + row * DM + c); }
#pragma unroll
            for (int m = 0; m < 4; ++m)
#pragma unroll
                for (int bj = 0; bj < 2; ++bj) { f32x4 g0, g1, t0, t1; bf8_to_f32(gv[m][bj], g0, g1); bf8_to_f32(tv[m][bj], t0, t1);
                    st_bf8(MB + (size_t)(rbase + ai * 128 + m * 16) * DM + cbase + 128 * bj, sig4(g0) * acc[ai][bj][m][0] + t0, sig4(g1) * acc[ai][bj][m][1] + t1); }
        }
    }
};
struct EpiWo {
    static constexpr bool PERM = true, AFTER_DRAIN = false;
    const float *xp, *xs; bf16_t* X1B; float* SSQ;
    DI void operator()(AccRef acc, const pg8::Unit& u, int wr, int wc, int fr, int fq) const {
        const int rbase = u.pm * 256 + wr * 64 + fr, cbase = u.pn * 256 + 32 * wc + 8 * fq;
#pragma unroll
        for (int ai = 0; ai < 2; ++ai) {
            f32x4 xv[4][2][2];
#pragma unroll
            for (int m = 0; m < 4; ++m)
#pragma unroll
                for (int bj = 0; bj < 2; ++bj)
#pragma unroll
                    for (int n = 0; n < 2; ++n) xv[m][bj][n] = *(const f32x4*)(xp + (size_t)(rbase + ai * 128 + m * 16) * DM + cbase + 128 * bj + 4 * n);
#pragma unroll
            for (int m = 0; m < 4; ++m) { const size_t row = rbase + ai * 128 + m * 16; float ss = 0.f;
#pragma unroll
                for (int bj = 0; bj < 2; ++bj) { const int c = cbase + 128 * bj; const f32x4 v0 = xv[m][bj][0] + acc[ai][bj][m][0], v1 = xv[m][bj][1] + acc[ai][bj][m][1];
                    ss += ((v0[0] * v0[0] + v0[1] * v0[1]) + (v0[2] * v0[2] + v0[3] * v0[3])) + ((v1[0] * v1[0] + v1[1] * v1[1]) + (v1[2] * v1[2] + v1[3] * v1[3]));
                    st_bf8(X1B + row * DM + c, v0, v1); }
                ss = x32_sum(x16_sum(ss));
                if (fq == 0) SSQ[row * 16 + u.pn * 4 + wc] = ss; }
        }
    }
};
constexpr size_t RSTD_OFF = 458752;
constexpr size_t SSQS_OFF = 393216;
DI float row_rstd(const float* SSQ, int row) {
    if (row < MP) {
        const f32x4* p = (const f32x4*)(SSQ + (size_t)row * 16); const f32x4 a = p[0], b = p[1], c = p[2], d = p[3];
        const float s = ((a[0] + a[1]) + (a[2] + a[3])) + ((b[0] + b[1]) + (b[2] + b[3])) + ((c[0] + c[1]) + (c[2] + c[3])) + ((d[0] + d[1]) + (d[2] + d[3]));
        return 1.f / sqrtf(s * (1.f / DM) + EPS);
    }
    const f32x4* p = (const f32x4*)(SSQ + SSQS_OFF + (size_t)(row - MP) * 64); float s = 0.f;
#pragma unroll 4
    for (int i = 0; i < 16; ++i) { const f32x4 a = p[i]; s += (a[0] + a[1]) + (a[2] + a[3]); }
    return 1.f / sqrtf(s * (1.f / DM) + EPS);
}
DI f32x4 dpp_prev(f32x4 prev, f32x4 cur, int which) {
    const int fr = threadIdx.x & 15;
    f32x4 o;
#pragma unroll
    for (int j = 0; j < 4; ++j) { const float push = (fr > 15 - which) ? prev[j] : cur[j];
        const int pi = __builtin_bit_cast(int, push);
        const int r = (which == 1) ? __builtin_amdgcn_update_dpp(pi, pi, 0x121, 0xf, 0xf, false) : __builtin_amdgcn_update_dpp(pi, pi, 0x122, 0xf, 0xf, false);
        o[j] = __builtin_bit_cast(float, r); }
    return o;
}
constexpr int EX_OFF = RING_BYTES;
DI int halo_index(int pm) { return 2 * (pm - 1 - (pm >> 3)); }
struct EpiGU {
    static constexpr bool PERM = true, AFTER_DRAIN = false;
    const float* SSQ; const float* HALO; bf16_t* H; float* out; const float *state_conv, *cw, *cb; LAS unsigned char* lds;
    DI void operator()(AccRef acc, const pg8::Unit& u, int wr, int wc, int fr, int fq) const {
        const int rbase = u.pm * 256 + wr * 64 + fr, cl = 32 * wc + 8 * fq, cbase = u.pn * 128 + cl;
        LAS float* EX = (LAS float*)(lds + EX_OFF);
        float rs[8];
#pragma unroll
        for (int q = 0; q < 8; ++q) { const int row = rbase + (q >> 2) * 128 + (q & 3) * 16; rs[q] = (row < MROWS) ? SSQ[RSTD_OFF + row] : 0.f; }
        if (fr >= 14) {
#pragma unroll
            for (int ai = 0; ai < 2; ++ai)
#pragma unroll
                for (int n = 0; n < 2; ++n) *(LAS f32x4*)(EX + ((ai * 2 + wr) * 2 + (fr - 14)) * 128 + cl + 4 * n) = acc[ai][0][3][n] * rs[ai * 4 + 3];
        }
        asm volatile("s_waitcnt lgkmcnt(0)" ::: "memory"); __builtin_amdgcn_s_barrier(); asm volatile("" ::: "memory");
        if (u.pm < 64) {
            f32x4 hal[2];
#pragma unroll
            for (int n = 0; n < 2; ++n) hal[n] = (fr >= 14 && wr == 0 && (u.pm & 7) != 0) ? *(const f32x4*)(HALO + (size_t)(halo_index(u.pm) + (fr - 14)) * DFF + cbase + 4 * n) : (f32x4){0.f, 0.f, 0.f, 0.f};
            f32x4 cc[2][4];
#pragma unroll
            for (int n = 0; n < 2; ++n) { const int c = cbase + 4 * n; cc[n][0] = *(const f32x4*)(cb + c); cc[n][1] = *(const f32x4*)(cw + c); cc[n][2] = *(const f32x4*)(cw + DFF + c); cc[n][3] = *(const f32x4*)(cw + 2 * DFF + c); }
#pragma unroll
            for (int ai = 0; ai < 2; ++ai) {
                f32x4 prev[2];
#pragma unroll
                for (int n = 0; n < 2; ++n) { f32x4 pbv = (f32x4){0.f, 0.f, 0.f, 0.f};
                    if (fr >= 14) {
                        if (wr == 1) pbv = *(const LAS f32x4*)(EX + ((ai * 2 + 0) * 2 + (fr - 14)) * 128 + cl + 4 * n);
                        else if (ai == 1) pbv = *(const LAS f32x4*)(EX + ((0 * 2 + 1) * 2 + (fr - 14)) * 128 + cl + 4 * n);
                        else pbv = hal[n];
                    }
                    prev[n] = pbv; }
#pragma unroll
                for (int m = 0; m < 4; ++m) { const int row = rbase + ai * 128 + m * 16; const float r1 = rs[ai * 4 + m]; const int t = row & 2047;
                    f32x4 hv[2];
#pragma unroll
                    for (int n = 0; n < 2; ++n) {
                        const f32x4 g0 = acc[ai][0][m][n] * r1, g1 = dpp_prev(prev[n], g0, 1), g2 = dpp_prev(prev[n], g0, 2);
                        const f32x4 cv = cc[n][0] + cc[n][1] * g2 + cc[n][2] * g1 + cc[n][3] * g0;
                        const f32x4 up = acc[ai][1][m][n] * r1;
                        hv[n] = (f32x4){siluf_(cv[0]) * up[0], siluf_(cv[1]) * up[1], siluf_(cv[2]) * up[2], siluf_(cv[3]) * up[3]};
                        if (t >= SEQ - 2) *(f32x4*)(out + OFF_CVP + ((size_t)(row >> 11) * 2 + (t - (SEQ - 2))) * DFF + cbase + 4 * n) = g0;
                        prev[n] = g0; }
                    st_bf8(H + (size_t)row * DFF + cbase, hv[0], hv[1]); }
            }
        } else {
#pragma unroll
            for (int m = 0; m < 4; ++m) { const int row = rbase + m * 16; if (row >= MROWS) continue;
                const float r1 = rs[m]; const int bs = row - MP;
                f32x4 hv[2];
#pragma unroll
                for (int n = 0; n < 2; ++n) { const int c = cbase + 4 * n;
                    const f32x4 g0 = acc[0][0][m][n] * r1;
                    const f32x4 g1 = *(const f32x4*)(state_conv + ((size_t)bs * 2 + 1) * DFF + c), g2 = *(const f32x4*)(state_conv + ((size_t)bs * 2) * DFF + c);
                    const f32x4 cv = *(const f32x4*)(cb + c) + *(const f32x4*)(cw + c) * g2 + *(const f32x4*)(cw + DFF + c) * g1 + *(const f32x4*)(cw + 2 * DFF + c) * g0;
                    const f32x4 up = acc[0][1][m][n] * r1;
                    hv[n] = (f32x4){siluf_(cv[0]) * up[0], siluf_(cv[1]) * up[1], siluf_(cv[2]) * up[2], siluf_(cv[3]) * up[3]};
                    *(f32x4*)(out + OFF_CVS + ((size_t)bs * 2 + 1) * DFF + c) = g0;
                    *(f32x4*)(out + OFF_CVS + ((size_t)bs * 2) * DFF + c) = g1; }
                st_bf8(H + (size_t)row * DFF + cbase, hv[0], hv[1]); }
        }
    }
};
struct EpiDown {
    static constexpr bool PERM = true, AFTER_DRAIN = false;
    const bf16_t* X1; float* Y;
    DI void operator()(AccRef acc, const pg8::Unit& u, int wr, int wc, int fr, int fq) const {
        const int rbase = u.pm * 256 + wr * 64 + fr, cbase = u.pn * 256 + 32 * wc + 8 * fq;
        u32x4 xv[2][4][2];
#pragma unroll
        for (int ai = 0; ai < 2; ++ai)
#pragma unroll
            for (int m = 0; m < 4; ++m)
#pragma unroll
                for (int bj = 0; bj < 2; ++bj) xv[ai][m][bj] = *(const u32x4*)(X1 + (size_t)(rbase + ai * 128 + m * 16) * DM + cbase + 128 * bj);
#pragma unroll
        for (int ai = 0; ai < 2; ++ai)
#pragma unroll
            for (int m = 0; m < 4; ++m)
#pragma unroll
                for (int bj = 0; bj < 2; ++bj) { f32x4 x0, x1; bf8_to_f32(xv[ai][m][bj], x0, x1); float* yp = Y + (size_t)(rbase + ai * 128 + m * 16) * DM + cbase + 128 * bj;
                    *(f32x4*)yp = x0 + acc[ai][bj][m][0]; *(f32x4*)(yp + 4) = x1 + acc[ai][bj][m][1]; }
    }
};

#ifdef MK_EXTRA_PHASE
struct EpiNull {
    static constexpr bool PERM = false, AFTER_DRAIN = false;
    float* sink;
    DI void operator()(AccRef acc, const pg8::Unit& u, int wr, int wc, int fr, int fq) const {
        f32x4 t = (f32x4){0.f, 0.f, 0.f, 0.f};
#pragma unroll
        for (int ai = 0; ai < 2; ++ai)
#pragma unroll
            for (int bj = 0; bj < 2; ++bj)
#pragma unroll
                for (int m = 0; m < 4; ++m)
#pragma unroll
                    for (int n = 0; n < 2; ++n) t += acc[ai][bj][m][n];
        if (t[0] == 1234.5f) sink[0] = t[1] + t[2] + t[3];
    }
};
#endif

template <int NP, class F>
DI void skinny_gemm(const bf16_t* A0, const bf16_t* B0, int K0, const bf16_t* A1, const bf16_t* B1, int K1, LAS unsigned char* lds, int cu, int G, int lane, int wave, F epi) {
    const int ts = wave >> 2, kq = wave & 3, l15 = lane & 15, gq = lane >> 4;
    LAS f32x4* red = (LAS f32x4*)lds;
    for (int t0 = 2 * cu; t0 < 512; t0 += 2 * G) {
        const int t = t0 + ts, rt = t & 7, ct = t >> 3;
        f32x4 acc[2] = {(f32x4){0.f, 0.f, 0.f, 0.f}, (f32x4){0.f, 0.f, 0.f, 0.f}};
#pragma unroll
        for (int p = 0; p < NP; ++p) {
            const bf16_t* A = p ? A1 : A0; const bf16_t* B = p ? B1 : B0; const int K = p ? K1 : K0;
            const bf16_t* ap = A + (size_t)(16 * rt + l15) * K + (size_t)kq * (K / 4) + 8 * gq;
            const bf16_t* bp = B + (size_t)(16 * ct + l15) * K + (size_t)kq * (K / 4) + 8 * gq;
            const int nsteps = K / 128;
            for (int s0 = 0; s0 < nsteps; s0 += 8) {
                bf16x8 af[8], bfv[8];
#pragma unroll
                for (int s = 0; s < 8; ++s) if (s0 + s < nsteps) { af[s] = *(const bf16x8*)(ap + (s0 + s) * 32); bfv[s] = *(const bf16x8*)(bp + (s0 + s) * 32); }
#pragma unroll
                for (int s = 0; s < 8; ++s) if (s0 + s < nsteps) acc[p] = MFMA16(af[s], bfv[s], acc[p]);
            }
        }
        __syncthreads();
#pragma unroll
        for (int p = 0; p < NP; ++p) red[(p * 8 + wave) * 64 + lane] = acc[p];
        __syncthreads();
        if (kq == 0) {
#pragma unroll
            for (int p = 0; p < NP; ++p) { acc[p] = (red[(p * 8 + wave) * 64 + lane] + red[(p * 8 + wave + 1) * 64 + lane]) + (red[(p * 8 + wave + 2) * 64 + lane] + red[(p * 8 + wave + 3) * 64 + lane]); }
            epi(16 * rt + 4 * gq, 16 * ct + l15, ct, acc[0], acc[1]);
        }
    }
}

struct SkMerge { const bf16_t* MG; bf16_t* MB;
    DI void operator()(int r0, int col, int ct, const f32x4& ab, const f32x4& aa) const {
#pragma unroll
        for (int r = 0; r < 4; ++r) { const size_t row = (size_t)MP + r0 + r;
            const float ga = bf2f(MG[row * 2048 + col]), gb = bf2f(MG[row * 2048 + DM + col]);
            MB[row * DM + col] = (bf16_t)f2bf(sigmoidf_(ga) * aa[r] + sigmoidf_(gb) * ab[r]); } } };
struct SkWo { const float* xs; bf16_t* X1B; float* SSQS;
    DI void operator()(int r0, int col, int ct, const f32x4& a0, const f32x4&) const {
#pragma unroll
        for (int r = 0; r < 4; ++r) { const int rs_ = r0 + r; const size_t row = (size_t)MP + rs_;
            const float x1 = xs[(size_t)rs_ * DM + col] + a0[r];
            X1B[row * DM + col] = (bf16_t)f2bf(x1);
            float ss = row16_sum(x1 * x1);
            if ((col & 15) == 0) SSQS[(size_t)rs_ * 64 + ct] = ss; } } };
struct SkDown { const bf16_t* X1; float* Y;
    DI void operator()(int r0, int col, int ct, const f32x4& a0, const f32x4&) const {
#pragma unroll
        for (int r = 0; r < 4; ++r) { const size_t row = (size_t)MP + r0 + r; Y[row * DM + col] = bf2f(X1[row * DM + col]) + a0[r]; } } };

DI int halo_row(int h) { const int idx = h >> 1; return 256 * (idx + 1 + idx / 7) - 2 + (h & 1); }
DI void halo_gemm(const bf16_t* X1G, const bf16_t* WGU, const float* SSQ, float* HALO, LAS unsigned char* lds, int cu, int G, int lane, int wave) {
    const int ts = wave >> 2, kq = wave & 3, l15 = lane & 15, gq = lane >> 4;
    LAS f32x4* red = (LAS f32x4*)lds;
    constexpr int NT = 7 * 176;
    for (int t0 = 2 * cu; t0 < NT; t0 += 2 * G) {
        const int t = t0 + ts; const bool live = t < NT; const int tt = live ? t : 0, rt = tt % 7, ct = tt / 7;
        const int c0 = 16 * ct, prow = 256 * (c0 >> 7) + (c0 & 127);
        const bf16_t* ap = X1G + (size_t)halo_row(16 * rt + l15) * DM + kq * 256 + 8 * gq;
        const bf16_t* bp = WGU + (size_t)(prow + l15) * DM + kq * 256 + 8 * gq;
        bf16x8 af[8], bfv[8];
#pragma unroll
        for (int s2 = 0; s2 < 8; ++s2) { af[s2] = *(const bf16x8*)(ap + s2 * 32); bfv[s2] = *(const bf16x8*)(bp + s2 * 32); }
        f32x4 acc = (f32x4){0.f, 0.f, 0.f, 0.f};
#pragma unroll
        for (int s2 = 0; s2 < 8; ++s2) acc = MFMA16(af[s2], bfv[s2], acc);
        __syncthreads();
        red[wave * 64 + lane] = acc;
        __syncthreads();
        if (kq == 0 && live) {
            acc = (red[wave * 64 + lane] + red[(wave + 1) * 64 + lane]) + (red[(wave + 2) * 64 + lane] + red[(wave + 3) * 64 + lane]);
#pragma unroll
            for (int r = 0; r < 4; ++r) { const int h = 16 * rt + 4 * gq + r; HALO[(size_t)h * DFF + c0 + l15] = acc[r] * row_rstd(SSQ, halo_row(h)); }
        }
    }
}

struct HookMerge {
    const bf16_t* MG;
    DI void operator()(f32x4 (&acc)[2][2][4][2], const pg8::Unit& u, int wr, int wc, int fr, int fq) const {
        const int rbase = u.pm * 256 + wr * 64 + fr, cbase = u.pn * 256 + 32 * wc + 8 * fq;
#pragma unroll
        for (int ai = 0; ai < 2; ++ai) {
            u32x4 av[4][2], bv[4][2];
#pragma unroll
            for (int m = 0; m < 4; ++m)
#pragma unroll
                for (int bj = 0; bj < 2; ++bj) { const bf16_t* p = MG + (size_t)(rbase + ai * 128 + m * 16) * 2048 + cbase + 128 * bj;
                    av[m][bj] = *(const u32x4*)p; bv[m][bj] = *(const u32x4*)(p + DM); }
#pragma unroll
            for (int m = 0; m < 4; ++m)
#pragma unroll
                for (int bj = 0; bj < 2; ++bj) { f32x4 a0, a1, b0, b1; bf8_to_f32(av[m][bj], a0, a1); bf8_to_f32(bv[m][bj], b0, b1);
#pragma unroll
                    for (int j = 0; j < 4; ++j) {
                        acc[ai][bj][m][0][j] *= (1.f + __expf(-fmaxf(a0[j], -30.f))) * __builtin_amdgcn_rcpf(1.f + __expf(-b0[j]));
                        acc[ai][bj][m][1][j] *= (1.f + __expf(-fmaxf(a1[j], -30.f))) * __builtin_amdgcn_rcpf(1.f + __expf(-b1[j])); } }
        }
    }
};
struct EpiMergeF {
    static constexpr bool PERM = true, AFTER_DRAIN = false;
    const bf16_t* MG; bf16_t* MB;
    DI void operator()(AccRef acc, const pg8::Unit& u, int wr, int wc, int fr, int fq) const {
        const int rbase = u.pm * 256 + wr * 64 + fr, cbase = u.pn * 256 + 32 * wc + 8 * fq;
        u32x4 gv[2][4][2];
#pragma unroll
        for (int ai = 0; ai < 2; ++ai)
#pragma unroll
            for (int m = 0; m < 4; ++m)
#pragma unroll
                for (int bj = 0; bj < 2; ++bj) gv[ai][m][bj] = *(const u32x4*)(MG + (size_t)(rbase + ai * 128 + m * 16) * 2048 + cbase + 128 * bj);
#pragma unroll
        for (int ai = 0; ai < 2; ++ai)
#pragma unroll
            for (int m = 0; m < 4; ++m)
#pragma unroll
                for (int bj = 0; bj < 2; ++bj) { f32x4 g0, g1; bf8_to_f32(gv[ai][m][bj], g0, g1);
#pragma unroll
                    for (int j = 0; j < 4; ++j) { g0[j] = __builtin_amdgcn_rcpf(1.f + __expf(-fmaxf(g0[j], -30.f))); g1[j] = __builtin_amdgcn_rcpf(1.f + __expf(-fmaxf(g1[j], -30.f))); }
                    st_bf8(MB + (size_t)(rbase + ai * 128 + m * 16) * DM + cbase + 128 * bj, g0 * acc[ai][bj][m][0], g1 * acc[ai][bj][m][1]); }
    }
};

DI int crow(int reg, int hi) { return (reg & 3) + 8 * (reg >> 2) + 4 * hi; }
constexpr int A_KT = 0, A_KSTR = 144, A_KBYTES = 64 * A_KSTR;
constexpr int A_VT = 2 * A_KBYTES, A_VSTR = 192, A_VBYTES = 64 * A_VSTR;
constexpr int A_LUT = A_VT + 2 * A_VBYTES;
constexpr int A_IMP = A_LUT + 4 * 132 * 4;
constexpr int A_TOT = A_IMP + 4 * 64 * 33 * 4;
constexpr int A_SELM = A_TOT + 64 * 33 * 4;
constexpr int A_WS = A_SELM + 512;
constexpr int A_OACC = A_WS + 8 * 64 * 4;
constexpr int A_GB = A_OACC + 8 * 32 * 64 * 2;
constexpr int A_CSH = A_GB + 768 * 4;
constexpr int A_END = A_CSH + 64;
static_assert(A_END <= RING_BYTES, "attention LDS");

DI float swap_max(float v) { auto rr = __builtin_amdgcn_permlane32_swap(__float_as_uint(v), __float_as_uint(v), false, false); return fmaxf(__uint_as_float(rr[0]), __uint_as_float(rr[1])); }
DI float swap_sum(float v) { auto rr = __builtin_amdgcn_permlane32_swap(__float_as_uint(v), __float_as_uint(v), false, false); return __uint_as_float(rr[0]) + __uint_as_float(rr[1]); }

DI float score_bound(const float* qg, const float* kg, const float* rel_table, int lane) {
    float a = fabsf(qg[lane]), b = fmaxf(fmaxf(fabsf(kg[lane]), fabsf(kg[64 + lane])), fabsf(kg[128 + lane]));
    float c = fmaxf(fmaxf(fabsf(rel_table[lane]), fabsf(rel_table[64 + lane])), fmaxf(fabsf(rel_table[128 + lane]), fabsf(rel_table[192 + lane])));
#pragma unroll
    for (int o = 1; o < 64; o <<= 1) { a = fmaxf(a, __shfl_xor(a, o)); b = fmaxf(b, __shfl_xor(b, o)); c = fmaxf(c, __shfl_xor(c, o)); }
    return 64.f * QSCALE * a * b + c * LOG2E + 0.5f;
}
DI void build_lut(LAS float* lut, const float* rel_table, int g, int tid, float shift = 0.f) {
    for (int e = tid; e < 4 * 129; e += NTHREADS) { const int r = e / 129, dd = e % 129;
        int bk; if (dd < 16) bk = dd; else { bk = 16 + (int)(logf((float)dd / 16.f) / 2.0794415416798357f * 16.f); bk = bk > 31 ? 31 : bk; }
        lut[r * 132 + dd] = rel_table[bk * NH + 4 * g + r] * LOG2E - shift; }
}

struct AttnCtx {
    LAS unsigned char* lds; int tid, lane, wave, r32, hi, r, qh;
    bf16x8 qr[4];
    f32x16 o[2], ls;
};
DI void tile_fetch(const bf16_t* Ksrc, const bf16_t* Vsrc, int stride, int tid, u32x4& kreg, u32x4& vreg) {
    asm volatile("" : "+v"(tid));
    const int key = tid >> 3, ch = tid & 7;
    kreg = *(const u32x4*)(Ksrc + (size_t)key * stride + ch * 8); vreg = *(const u32x4*)(Vsrc + (size_t)key * stride + ch * 8);
}
DI void tile_store(LAS unsigned char* lds, int buf, int tid, const u32x4& kreg, const u32x4& vreg) {
    asm volatile("" : "+v"(tid));
    const int key = tid >> 3, ch = tid & 7;
    static_assert(A_KSTR == 144 && A_VSTR == 192, "row strides as shifts");
    *(LAS u32x4*)(lds + A_KT + buf * A_KBYTES + ((key << 7) + (key << 4)) + ch * 16) = kreg;
    *(LAS u32x4*)(lds + A_VT + buf * A_VBYTES + ((key << 7) + (key << 6)) + ch * 16) = vreg;
}
DI void qk_tile(const AttnCtx& c, int buf, f32x16& p0, f32x16& p1) {
    const LAS unsigned char* kb = c.lds + A_KT + buf * A_KBYTES + c.r32 * A_KSTR + c.hi * 16;
    bf16x8 a0[4], a1[4];
#pragma unroll
    for (int d0 = 0; d0 < 4; ++d0) { a0[d0] = *(const LAS bf16x8*)(kb + d0 * 32); a1[d0] = *(const LAS bf16x8*)(kb + 32 * A_KSTR + d0 * 32); }
    __builtin_amdgcn_sched_barrier(0);
#pragma unroll
    for (int k = 0; k < 16; ++k) { p0[k] = 0.f; p1[k] = 0.f; }
    __builtin_amdgcn_s_setprio(1);
#pragma unroll
    for (int d0 = 0; d0 < 4; ++d0) p0 = MFMA32(a0[d0], c.qr[d0], p0);
#pragma unroll
    for (int d0 = 0; d0 < 4; ++d0) p1 = MFMA32(a1[d0], c.qr[d0], p1);
    __builtin_amdgcn_s_setprio(0);
}
DI void half_pv(AttnCtx& c, const LAS unsigned char* vb, f32x16& e, float bias) {
    bf16x8 vf[2][2];
#pragma unroll
    for (int ks = 0; ks < 2; ++ks)
#pragma unroll
        for (int d0 = 0; d0 < 2; ++d0) { const LAS unsigned char* vp = vb + (16 * ks) * A_VSTR + d0 * 64; vf[ks][d0] = cat44(tr_read(vp), tr_read(vp + 8 * A_VSTR)); }
#pragma unroll
    for (int k = 0; k < 16; k += 2) { const f32x2 t = (f32x2){e[k], e[k + 1]} + (f32x2){bias, bias}; e[k] = __builtin_amdgcn_exp2f(t[0]); e[k + 1] = __builtin_amdgcn_exp2f(t[1]); }
    const bf16x8 ones = {0x3f80, 0x3f80, 0x3f80, 0x3f80, 0x3f80, 0x3f80, 0x3f80, 0x3f80};
#pragma unroll
    for (int ks = 0; ks < 2; ++ks) { u32x4 w;
#pragma unroll
        for (int j = 0; j < 4; ++j) w[j] = pkbf(e[8 * ks + 2 * j], e[8 * ks + 2 * j + 1]);
        const bf16x8 pa = __builtin_bit_cast(bf16x8, w);
        c.o[0] = MFMA32(pa, vf[ks][0], c.o[0]); c.o[1] = MFMA32(pa, vf[ks][1], c.o[1]); c.ls = MFMA32(pa, ones, c.ls); }
}
DI void pv_halves(AttnCtx& c, int buf, f32x16& s0, f32x16& s1, float bias) {
    const int q = (c.lane & 15) >> 2, p = c.lane & 3, blk = (c.lane >> 4) & 1;
    const LAS unsigned char* vb = c.lds + A_VT + buf * A_VBYTES + (4 * c.hi + q) * A_VSTR + (16 * blk + 4 * p) * 2;
    half_pv(c, vb, s0, bias);
    half_pv(c, vb + 32 * A_VSTR, s1, bias);
}
DI void softmax_pv(AttnCtx& c, int buf, f32x16& s0, f32x16& s1) { pv_halves(c, buf, s0, s1, 0.f); }
DI void softmax_pv_far(AttnCtx& c, int buf, f32x16& s0, f32x16& s1, float bias) { pv_halves(c, buf, s0, s1, bias); }
template <bool FIRST>
DI void branch_finish(AttnCtx& c, int br) {
    int gofs = ((c.r * 64 + 32 * c.qh + 4 * c.hi) * 3 + br); asm volatile("" : "+v"(gofs));
    const LAS float* gb = (const LAS float*)(c.lds + A_GB) + gofs;
    int sofs = c.wave * 2048 + c.r32 + 256 * c.hi; asm volatile("" : "+v"(sofs));
    LAS bf16_t* oa = (LAS bf16_t*)(c.lds + A_OACC) + sofs;
#pragma unroll
    for (int k = 0; k < 16; ++k) { const float l = c.ls[k]; const float a = l > 0.f ? gb[crow(k, 0) * 3] * __builtin_amdgcn_rcpf(l) : 0.f;
#pragma unroll
        for (int d0 = 0; d0 < 2; ++d0) { LAS bf16_t* p = oa + crow(k, 0) * 64 + 32 * d0; float v = c.o[d0][k] * a; if (!FIRST) v += bf2f(*p); *p = (bf16_t)f2bf(v); } }
#pragma unroll
    for (int k = 0; k < 16; ++k) { c.o[0][k] = 0.f; c.o[1][k] = 0.f; c.ls[k] = 0.f; }
}

struct AttnArgs { const bf16_t *Q, *KVB, *CKP, *CVP; const float *GATES, *rel_table; bf16_t* ONSA; };

DI void attn_prompt_unit(const AttnArgs& A, LAS unsigned char* lds, int b, int g, int i, int tid, int lane, int wave) {
    AttnCtx c; c.lds = lds; c.tid = tid; c.lane = lane; c.wave = wave; c.r32 = lane & 31; c.hi = lane >> 5; c.r = wave >> 1; c.qh = wave & 1;
    const int u = 32 * c.qh + c.r32, h = 4 * g + c.r;
    const size_t qrow = (size_t)b * SEQ + 64 * i + u;
    LAS float* lut = (LAS float*)(lds + A_LUT) + c.r * 132;
    LAS float* IMP = (LAS float*)(lds + A_IMP); LAS float* TOT = (LAS float*)(lds + A_TOT); LAS unsigned* SELM = (LAS unsigned*)(lds + A_SELM);
#pragma unroll
    for (int d0 = 0; d0 < 4; ++d0) c.qr[d0] = *(const bf16x8*)(A.Q + qrow * NSAW + h * 64 + 16 * d0 + 8 * c.hi);
#pragma unroll
    for (int k = 0; k < 16; ++k) { c.o[0][k] = 0.f; c.o[1][k] = 0.f; c.ls[k] = 0.f; }
    u32x4 kreg, vreg;
    const float bias_far = lut[128];

    tile_fetch(A.CKP + (size_t)(b * 2 + g) * 4096, A.CVP + (size_t)(b * 2 + g) * 4096, 64, tid, kreg, vreg);
    __syncthreads();
    for (int e = tid; e < 768; e += NTHREADS) { const int r2 = e / 192, rem = e % 192, q2 = rem / 3, br = rem % 3;
        ((LAS float*)(lds + A_GB))[e] = A.GATES[((size_t)b * SEQ + 64 * i + q2) * 24 + (4 * g + r2) * 3 + br]; }
    tile_store(lds, 0, tid, kreg, vreg);
    __syncthreads();
    {
        f32x16 s0, s1; qk_tile(c, 0, s0, s1);
        int qb = 64 * i + u - 31 - 128 * c.hi; asm volatile("" : "+v"(qb));
        float b0[16], b1[16];
#pragma unroll
        for (int k = 0; k < 16; ++k) { const int d0 = qb - 32 * crow(k, 0), d1 = d0 - 1024;
            b0[k] = lut[min(max(d0, 0), 128)]; b1[k] = lut[min(max(d1, 0), 128)]; }
#pragma unroll
        for (int k = 0; k < 16; ++k) { const int d0 = qb - 32 * crow(k, 0), d1 = d0 - 1024;
            s0[k] = d0 >= 0 ? s0[k] + b0[k] : -INFINITY; s1[k] = d1 >= 0 ? s1[k] + b1[k] : -INFINITY; }
        softmax_pv(c, 0, s0, s1);
        float lsum = 0.f;
#pragma unroll
        for (int k = 0; k < 16; ++k) lsum += s0[k] + s1[k];
        const float lt = swap_sum(lsum), inv = lt > 0.f ? __builtin_amdgcn_rcpf(lt) : 0.f;
        int iofs = (c.r * 64 + u) * 33 + 2 * c.hi; asm volatile("" : "+v"(iofs));
#pragma unroll
        for (int k = 0; k < 16; k += 2) {
            IMP[iofs + (crow(k, 0) >> 1)] = (s0[k] + s0[k + 1]) * inv;
            IMP[iofs + 16 + (crow(k, 0) >> 1)] = (s1[k] + s1[k + 1]) * inv;
        }
        branch_finish<true>(c, 0);
    }
    __syncthreads();
    {
        int tq = tid; asm volatile("" : "+v"(tq));
        const int uq = tq >> 3, sub = tq & 7;
        unsigned mbits = 0u;
        if (i < 16) { mbits = (i >= 31) ? 0xffffffffu : ((1u << (i + 1)) - 1u); }
        else {
#pragma unroll
            for (int jj = 0; jj < 4; ++jj) { const int j = sub * 4 + jj;
                TOT[uq * 33 + j] = (IMP[(0 * 64 + uq) * 33 + j] + IMP[(1 * 64 + uq) * 33 + j]) + (IMP[(2 * 64 + uq) * 33 + j] + IMP[(3 * 64 + uq) * 33 + j]); }
        }
        __syncthreads();
        if (i >= 16) {
            const int ntop = 16 - 3;
            float mine[4]; int cnt[4];
#pragma unroll
            for (int jj = 0; jj < 4; ++jj) { mine[jj] = TOT[uq * 33 + sub * 4 + jj]; cnt[jj] = 0; }
            for (int j2 = 1; j2 < i - 1; ++j2) { const float o2 = TOT[uq * 33 + j2];
#pragma unroll
                for (int jj = 0; jj < 4; ++jj) cnt[jj] += (o2 > mine[jj] || (o2 == mine[jj] && j2 < sub * 4 + jj)) ? 1 : 0; }
#pragma unroll
            for (int jj = 0; jj < 4; ++jj) { const int j = sub * 4 + jj;
                if (j > i) continue;
                if (j == 0 || j >= i - 1) { mbits |= 1u << j; continue; }
                if (cnt[jj] < ntop) mbits |= 1u << j; }
            mbits |= __shfl_xor(mbits, 1); mbits |= __shfl_xor(mbits, 2); mbits |= __shfl_xor(mbits, 4);
        }
        if (sub == 0) SELM[uq] = mbits;
    }
    __syncthreads();
    const unsigned selm = SELM[u];
    unsigned umask = selm;
    { unsigned t = selm; for (int o = 1; o < 32; o <<= 1) t |= __shfl_xor(t, o); if (c.r32 == 0 && c.hi == 0 && c.r == 0) SELM[64 + c.qh] = t; }
    __syncthreads();
    umask = SELM[64] | SELM[65];
    umask = __builtin_amdgcn_readfirstlane(umask);
    __syncthreads();

    {
        const bf16_t* Kb = A.KVB + (size_t)b * SEQ * 512 + 0 * 128 + g * 64; const bf16_t* Vb = Kb + 128;
        unsigned rem = umask & ((i >= 31) ? 0xffffffffu : ((1u << (i + 1)) - 1u));
        int j = __builtin_ctz(rem); rem &= rem - 1u;
        tile_fetch(Kb + (size_t)64 * j * 512, Vb + (size_t)64 * j * 512, 512, tid, kreg, vreg);
        int buf = 0;
#define SEL_STEP(KR, VR) { \
            tile_store(lds, buf, tid, KR, VR); \
            __syncthreads(); \
            const int jn = rem ? __builtin_ctz(rem) : -1; if (rem) rem &= rem - 1u; \
            if (jn >= 0) tile_fetch(Kb + (size_t)64 * jn * 512, Vb + (size_t)64 * jn * 512, 512, tid, KR, VR); \
            { \
                f32x16 s0, s1; qk_tile(c, buf, s0, s1); \
                const bool sel = (selm >> j) & 1u; \
                float bv = sel ? bias_far : -INFINITY;        \
                if (i - j < 3) { \
                    asm volatile("" ::: "memory");     \
                    int dbase = 64 * (i - j) + u - 4 * c.hi; asm volatile("" : "+v"(dbase)); \
                    float b0[16], b1[16]; \
                    _Pragma("unroll") for (int k = 0; k < 16; ++k) { const int d0 = dbase - crow(k, 0), d1 = d0 - 32; b0[k] = lut[min(max(d0, 0), 128)]; b1[k] = lut[min(max(d1, 0), 128)]; } \
                    _Pragma("unroll") for (int k = 0; k < 16; ++k) { const int d0 = dbase - crow(k, 0), d1 = d0 - 32; \
                        s0[k] = (sel && d0 >= 0) ? s0[k] + b0[k] : -INFINITY; s1[k] = (sel && d1 >= 0) ? s1[k] + b1[k] : -INFINITY; } \
                    bv = 0.f; \
                } \
                pv_halves(c, buf, s0, s1, bv);                \
            } \
            if (jn < 0) break; \
            j = jn; buf ^= 1; }
        for (;;) { SEL_STEP(kreg, vreg) }
#undef SEL_STEP
        branch_finish<false>(c, 1);
    }
    __syncthreads();
    {
        const bf16_t* Kb = A.KVB + (size_t)b * SEQ * 512 + 2 * 128 + g * 64; const bf16_t* Vb = Kb + 128;
        int j = i - 8 < 0 ? 0 : i - 8;
        tile_fetch(Kb + (size_t)64 * j * 512, Vb + (size_t)64 * j * 512, 512, tid, kreg, vreg);
        int buf = 0;
#define WIN_STEP(KR, VR) { \
            tile_store(lds, buf, tid, KR, VR); \
            __syncthreads(); \
            if (j + 1 <= i) tile_fetch(Kb + (size_t)64 * (j + 1) * 512, Vb + (size_t)64 * (j + 1) * 512, 512, tid, KR, VR); \
            { \
                f32x16 s0, s1; qk_tile(c, buf, s0, s1); \
                float bv = bias_far; \
                if (!(i - j >= 3 && i - j < 8)) { \
                    asm volatile("" ::: "memory");     \
                    int dbase = 64 * (i - j) + u - 4 * c.hi; asm volatile("" : "+v"(dbase)); \
                    float b0[16], b1[16]; \
                    _Pragma("unroll") for (int k = 0; k < 16; ++k) { const int d0 = dbase - crow(k, 0), d1 = d0 - 32; b0[k] = lut[min(max(d0, 0), 128)]; b1[k] = lut[min(max(d1, 0), 128)]; } \
                    _Pragma("unroll") for (int k = 0; k < 16; ++k) { const int d0 = dbase - crow(k, 0), d1 = d0 - 32; \
                        s0[k] = (d0 >= 0 && d0 <= WIN) ? s0[k] + b0[k] : -INFINITY; s1[k] = (d1 >= 0 && d1 <= WIN) ? s1[k] + b1[k] : -INFINITY; } \
                    bv = 0.f; \
                } \
                pv_halves(c, buf, s0, s1, bv); \
            } \
            if (j >= i) break; \
            ++j; buf ^= 1; }
        for (;;) { WIN_STEP(kreg, vreg) }
#undef WIN_STEP
        branch_finish<false>(c, 2);
    }
    {
        const LAS bf16_t* stg = (const LAS bf16_t*)(lds + A_OACC) + wave * 2048;
        bf16_t* ob = A.ONSA + ((size_t)b * SEQ + 64 * i + 32 * c.qh) * NSAW + h * 64;
#pragma unroll
        for (int i4 = 0; i4 < 4; ++i4) { const int rw = i4 * 8 + (lane >> 3), ch = lane & 7;
            const u32x4 v = *(const LAS u32x4*)(stg + rw * 64 + ch * 8); *(u32x4*)(ob + (size_t)rw * NSAW + ch * 8) = v; }
    }
}

constexpr int H_QT = 0, H_QSTR = 272;
constexpr int H_KS = H_QT + 64 * H_QSTR;
constexpr int H_QR = H_KS + 64 * H_QSTR;
constexpr int H_KT = H_QR + 64 * H_QSTR, H_KTSTR = 144;
constexpr int H_VL = H_KT + 128 * H_KTSTR, H_VSTR = 288;
constexpr int H_AT = H_VL + 64 * H_VSTR, H_ASTR = 144;
constexpr int H_BC = H_AT + 64 * H_ASTR, H_BSTR = 132;
constexpr int H_PT = H_BC + 64 * H_BSTR * 4;
constexpr int H_BR = H_PT + 4 * 128 * 4;
constexpr int H_DB = H_BR + 4 * 128 * 4;
constexpr int H_SS = H_DB + 128 * 4;
constexpr int H_END = H_SS + 8 * 64 * 4;
static_assert(H_END <= MISC_OFF, "hgrn LDS");

DI float ex2(float x) { return __builtin_amdgcn_exp2f(x); }

struct HgArgs { const bf16_t *HQ, *HI, *HGT; const float *GL, *hgn; float *SLOC, *GD; bf16_t* OHG; float* out; };
struct HgChunkRegs { f32x4 gl[4]; u32x4 hq[2], hi[2], hg[2]; };
template <bool WITH_OUT>
DI void hg_fetch(const HgArgs& A, size_t row0, int h, int tid, HgChunkRegs& R) {
#pragma unroll
    for (int i = 0; i < 4; ++i) { const int idx = tid + 512 * i; R.gl[i] = *(const f32x4*)(A.GL + (row0 + (idx >> 5)) * HGW + h * 128 + 4 * (idx & 31)); }
#pragma unroll
    for (int i = 0; i < 2; ++i) { const int idx = tid + 512 * i; const size_t o = (row0 + (idx >> 4)) * HGW + h * 128 + 8 * (idx & 15);
        R.hi[i] = *(const u32x4*)(A.HI + o); if (WITH_OUT) { R.hq[i] = *(const u32x4*)(A.HQ + o); R.hg[i] = *(const u32x4*)(A.HGT + o); } }
}
template <bool WITH_OUT>
DI void hg_stage(LAS unsigned char* lds, int tid, const HgChunkRegs& R) {
#pragma unroll
    for (int i = 0; i < 4; ++i) { const int idx = tid + 512 * i; *(LAS f32x4*)(lds + H_BC + ((idx >> 5) * H_BSTR + 4 * (idx & 31)) * 4) = R.gl[i]; }
#pragma unroll
    for (int i = 0; i < 2; ++i) { const int idx = tid + 512 * i; *(LAS u32x4*)(lds + H_VL + (idx >> 4) * H_VSTR + 16 * (idx & 15)) = R.hi[i];
        if (WITH_OUT) *(LAS u32x4*)(lds + H_QR + (idx >> 4) * H_QSTR + 16 * (idx & 15)) = R.hq[i]; }
}

template <bool WITH_OUT>
DI void hgrn_unit(const HgArgs& A, LAS unsigned char* lds, int unit, int tid, int lane, int wave) {
    const int bh = unit >> 3, grp = unit & 7, b = bh >> 2, h = bh & 3;
    const int gq = lane >> 4, l15 = lane & 15;
    const size_t rowu = (size_t)b * SEQ + 256 * grp;
    HgChunkRegs R;
    hg_fetch<WITH_OUT>(A, rowu, h, tid, R);
    f32x4 acc[8];
#pragma unroll
    for (int kt = 0; kt < 8; ++kt) acc[kt] = (f32x4){0.f, 0.f, 0.f, 0.f};
    if (WITH_OUT) {
        { int lofs = lane; asm volatile("" : "+v"(lofs));
          const f32x4* sl0 = (const f32x4*)A.SLOC + ((size_t)(bh * 8) * 8 + wave) * 8 * 64 + lofs; const float* gd0 = A.GD + (size_t)(bh * 8) * 128 + 4 * gq;
#pragma unroll
          for (int kt = 0; kt < 8; ++kt) {
              if (kt == 4) __builtin_amdgcn_sched_barrier(0);
              f32x4 sv[7], gv[7];
#pragma unroll
              for (int g2 = 0; g2 < 7; ++g2) if (g2 < grp) { sv[g2] = sl0[((size_t)g2 * 64 + kt) * 64]; gv[g2] = *(const f32x4*)(gd0 + (size_t)g2 * 128 + 16 * kt); }
              f32x4 a = (f32x4){0.f, 0.f, 0.f, 0.f};
#pragma unroll
              for (int g2 = 0; g2 < 7; ++g2) if (g2 < grp) {
#pragma unroll
                  for (int r = 0; r < 4; ++r) a[r] = a[r] * __expf(gv[g2][r]) + sv[g2][r]; }
              acc[kt] = a; } }
        for (int e = tid; e < 64 * H_ASTR / 4; e += NTHREADS) ((LAS unsigned*)(lds + H_AT))[e] = 0u;
    }
    const int kch = tid & 127, part = tid >> 7;
    float gdsum = 0.f;
    for (int ch = 0; ch < 4; ++ch) {
        const size_t row0 = rowu + 64 * ch;
        __syncthreads();
        hg_stage<WITH_OUT>(lds, tid, R);
        const u32x4 hg0 = R.hg[0], hg1 = R.hg[1];
        __syncthreads();
        if (ch < 3) hg_fetch<WITH_OUT>(A, row0 + 64, h, tid, R);
        LAS float* bcol = (LAS float*)(lds + H_BC) + (16 * part) * H_BSTR + kch;
        float run = 0.f;
#pragma unroll
        for (int t = 0; t < 16; ++t) run += bcol[t * H_BSTR];
        ((LAS float*)(lds + H_PT))[part * 128 + kch] = run;
        __syncthreads();
        float off = 0.f, btot = 0.f;
        { const LAS float* pt = (const LAS float*)(lds + H_PT);
#pragma unroll
          for (int p2 = 0; p2 < 4; ++p2) { const float v = pt[p2 * 128 + kch]; if (p2 < part) off += v; btot += v; } }
        const float bref = off + run;
        if (part == 0) { ((LAS float*)(lds + H_DB))[kch] = __expf(btot); gdsum += btot; }
        if (WITH_OUT) ((LAS float*)(lds + H_BR))[part * 128 + kch] = bref;
        { float bt = off;
#pragma unroll
          for (int t4 = 0; t4 < 4; ++t4) {
              unsigned kw[2];
#pragma unroll
              for (int t1 = 0; t1 < 4; ++t1) { const int tl = 4 * t4 + t1, tt = 16 * part + tl;
                  const float gl = bcol[tl * H_BSTR]; bt += gl;
                  const float kkv = 1.f - __expf(gl);
                  const unsigned hv = f2bf(kkv * __expf(btot - bt));
                  if (t1 & 1) kw[t1 >> 1] |= hv << 16; else kw[t1 >> 1] = hv;
                  if (WITH_OUT) {
                      const float qv = bf2f(*(const LAS bf16_t*)(lds + H_QR + tt * H_QSTR + kch * 2));
                      *(LAS bf16_t*)(lds + H_QT + tt * H_QSTR + kch * 2) = (bf16_t)f2bf(qv * __expf(bt));
                      *(LAS bf16_t*)(lds + H_KS + tt * H_QSTR + kch * 2) = (bf16_t)f2bf(kkv * __expf(bref - bt));
                      bcol[tl * H_BSTR] = bt;
                  } }
              *(LAS u32x2*)(lds + H_KT + kch * H_KTSTR + part * 32 + t4 * 8) = (u32x2){kw[0], kw[1]}; } }
        __syncthreads();
        if (WITH_OUT) {
            for (int tile = wave; tile < 10; tile += 8) {
                int it, js; { int rem = tile; it = 0; while (rem > it) { rem -= it + 1; ++it; } js = rem; }
                f32x4 a4 = (f32x4){0.f, 0.f, 0.f, 0.f};
                const int trow = 16 * it + l15, srow = 16 * js + l15;
#pragma unroll 2
                for (int ks = 0; ks < 4; ++ks) {
                    const int k0 = 32 * ks + 8 * gq;
                    const u32x4 qraw = *(const LAS u32x4*)(lds + H_QR + trow * H_QSTR + k0 * 2);
                    const LAS float* bp = (const LAS float*)(lds + H_BC) + trow * H_BSTR + k0; const LAS float* rp = (const LAS float*)(lds + H_BR) + js * 128 + k0;
                    const f32x4 b0 = *(const LAS f32x4*)bp, b1 = *(const LAS f32x4*)(bp + 4), r0 = *(const LAS f32x4*)rp, r1 = *(const LAS f32x4*)(rp + 4);
                    float qd[8];
                    qd[0] = bflo(qraw.x) * __expf(b0[0] - r0[0]); qd[1] = bfhi(qraw.x) * __expf(b0[1] - r0[1]); qd[2] = bflo(qraw.y) * __expf(b0[2] - r0[2]); qd[3] = bfhi(qraw.y) * __expf(b0[3] - r0[3]);
                    qd[4] = bflo(qraw.z) * __expf(b1[0] - r1[0]); qd[5] = bfhi(qraw.z) * __expf(b1[1] - r1[1]); qd[6] = bflo(qraw.w) * __expf(b1[2] - r1[2]); qd[7] = bfhi(qraw.w) * __expf(b1[3] - r1[3]);
                    const bf16x8 af = pack8(qd);
                    const bf16x8 bfv = *(const LAS bf16x8*)(lds + H_KS + srow * H_QSTR + k0 * 2);
                    a4 = MFMA16(af, bfv, a4);
                }
#pragma unroll
                for (int r = 0; r < 4; ++r) { const int tl = 4 * gq + r; float v = a4[r]; if (it == js && l15 > tl) v = 0.f;
                    *(LAS bf16_t*)(lds + H_AT + (16 * it + tl) * H_ASTR + (16 * js + l15) * 2) = (bf16_t)f2bf(v); }
            }
            __syncthreads();
        }
        bf16x8 vf[2];
        { const int q = l15 >> 2, p = l15 & 3;
#pragma unroll
          for (int ks = 0; ks < 2; ++ks) { const LAS unsigned char* vp = lds + H_VL + (32 * ks + 4 * gq + q) * H_VSTR + (16 * wave + 4 * p) * 2;
              vf[ks] = cat44(tr_read(vp), tr_read(vp + 16 * H_VSTR)); } }
        if (WITH_OUT) {
            f32x4 o[4];
#pragma unroll
            for (int it = 0; it < 4; ++it) { o[it] = (f32x4){0.f, 0.f, 0.f, 0.f};
                const int trow = 16 * it + l15;
#pragma unroll
                for (int ks = 0; ks < 2; ++ks) { const LAS unsigned char* ap = lds + H_AT + trow * H_ASTR + (32 * ks + 4 * gq) * 2;
                    const bf16x8 af = cat44(*(const LAS s16x4*)ap, *(const LAS s16x4*)(ap + 32)); o[it] = MFMA16(af, vf[ks], o[it]); } }
#pragma unroll
            for (int ks = 0; ks < 4; ++ks) {
                const bf16x8 sf = pack8v(acc[2 * ks], acc[2 * ks + 1]);
#pragma unroll
                for (int it = 0; it < 4; ++it) { const LAS unsigned char* qp = lds + H_QT + (16 * it + l15) * H_QSTR + (32 * ks + 4 * gq) * 2;
                    const bf16x8 af = cat44(*(const LAS s16x4*)qp, *(const LAS s16x4*)(qp + 32)); o[it] = MFMA16(af, sf, o[it]); } }
            LAS float* SS = (LAS float*)(lds + H_SS);
#pragma unroll
            for (int it = 0; it < 4; ++it)
#pragma unroll
                for (int r = 0; r < 4; ++r) { const float s = row16_sum(o[it][r] * o[it][r]);
                    if (l15 == 0) SS[wave * 64 + 16 * it + 4 * gq + r] = s; }
            __syncthreads();
            if (tid < 64) { float tot = 0.f;
#pragma unroll
                for (int w2 = 0; w2 < 8; ++w2) tot += SS[w2 * 64 + tid];
                ((LAS float*)(lds + H_PT))[tid] = 1.f / sqrtf(tot * (1.f / 128.f) + EPS); }
            __syncthreads();
            const float gn = A.hgn[16 * wave + l15];
#pragma unroll
            for (int it = 0; it < 4; ++it) {
                const f32x4 rs4 = *(const LAS f32x4*)((const LAS float*)(lds + H_PT) + 16 * it + 4 * gq);
#pragma unroll
                for (int r = 0; r < 4; ++r) *(LAS bf16_t*)(lds + H_KS + (16 * it + 4 * gq + r) * H_QSTR + (16 * wave + l15) * 2) = (bf16_t)f2bf(o[it][r] * rs4[r] * gn); }
        }
        { const LAS float* DB = (const LAS float*)(lds + H_DB);
#pragma unroll
          for (int kt = 0; kt < 8; ++kt) { const f32x4 d4 = *(const LAS f32x4*)(DB + 16 * kt + 4 * gq); acc[kt] = acc[kt] * d4;
#pragma unroll
              for (int ks = 0; ks < 2; ++ks) { const LAS unsigned char* kp = lds + H_KT + (16 * kt + l15) * H_KTSTR + (32 * ks + 4 * gq) * 2;
                  const bf16x8 af = cat44(*(const LAS s16x4*)kp, *(const LAS s16x4*)(kp + 32)); acc[kt] = MFMA16(af, vf[ks], acc[kt]); } } }
        if (WITH_OUT) {
            __syncthreads();
#pragma unroll
            for (int i = 0; i < 2; ++i) { const int idx = tid + 512 * i, rw = idx >> 4, c16 = idx & 15;
                const u32x4 ov = *(const LAS u32x4*)(lds + H_KS + rw * H_QSTR + 16 * c16);
                const size_t o = (row0 + rw) * HGW + h * 128 + 8 * c16; const u32x4 gv = i ? hg1 : hg0;
                u32x4 w;
                w.x = pk2(bflo(ov.x) * siluf_(bflo(gv.x)), bfhi(ov.x) * siluf_(bfhi(gv.x))); w.y = pk2(bflo(ov.y) * siluf_(bflo(gv.y)), bfhi(ov.y) * siluf_(bfhi(gv.y)));
                w.z = pk2(bflo(ov.z) * siluf_(bflo(gv.z)), bfhi(ov.z) * siluf_(bfhi(gv.z))); w.w = pk2(bflo(ov.w) * siluf_(bflo(gv.w)), bfhi(ov.w) * siluf_(bfhi(gv.w)));
                *(u32x4*)(A.OHG + o) = w; }
        }
    }
    if (!WITH_OUT) {
        int lofs = lane; asm volatile("" : "+v"(lofs));
        f32x4* sl = (f32x4*)A.SLOC + ((size_t)(unit * 8 + wave) * 8) * 64 + lofs;
#pragma unroll
        for (int kt = 0; kt < 8; ++kt) sl[kt * 64] = acc[kt];
        if (part == 0) A.GD[(size_t)unit * 128 + kch] = gdsum;
    } else if (grp == 7) {
        int lofs = (4 * gq) * 128 + 16 * wave + l15; asm volatile("" : "+v"(lofs));
        float* so = A.out + OFF_HGP + (size_t)bh * 16384 + lofs;
#pragma unroll
        for (int kt = 0; kt < 8; ++kt)
#pragma unroll
            for (int r = 0; r < 4; ++r) so[(16 * kt + r) * 128] = acc[kt][r];
    }
}

DI float gelu_tanh(float x) { const float uu = 0.7978845608028654f * (x + 0.044715f * x * x * x); const float t = 1.f - 2.f * __builtin_amdgcn_rcpf(__expf(2.f * uu) + 1.f); return 0.5f * x * (1.f + t); }
struct CmpArgs { const float *cache, *kvout; const int* page_table; const bf16_t *W1K, *W1V; const float *w2k, *w2v, *kg0; float *CKS, *CVS; bf16_t *CKP, *CVP; };
constexpr int C_PART = 0, C_HB = 32768, C_W2 = 36864;
DI void cmp_rows(const CmpArgs& A, int item, int lane, int wave, const float* (&rp)[4]) {
    const bool sample = item < 2048; const int it2 = sample ? item : item - 2048;
    const int bb = it2 >> 4, g = (it2 >> 3) & 1, kv = (it2 >> 2) & 1, rt = it2 & 3;
    const int nl = lane & 15, gq = lane >> 4, n = 16 * rt + nl;
#pragma unroll
    for (int jj = 0; jj < 4; ++jj) { const int t = 32 * n + 4 * wave + jj;
        const float* p = sample ? A.cache + ((size_t)A.page_table[bb * NPAGES + (t >> 7)] * PAGE + (t & 127)) * 512 : A.kvout + ((size_t)bb * SEQ + t) * 512;
        rp[jj] = p + kv * 128 + g * 64 + 8 * gq; }
}
DI void cmp_load(const float* const (&rp)[4], f32x4 (&av)[4][2][2]) {
#pragma unroll
    for (int jj = 0; jj < 4; ++jj)
#pragma unroll
        for (int k2 = 0; k2 < 2; ++k2) { av[jj][k2][0] = *(const f32x4*)(rp[jj] + 32 * k2); av[jj][k2][1] = *(const f32x4*)(rp[jj] + 32 * k2 + 4); }
}
DI void cmp_wload(const bf16_t* W1, int lane, int wave, bf16x8 (&wf)[4][2][4]) {
    const int nl = lane & 15, gq = lane >> 4;
    const bf16_t* wp = W1 + (size_t)nl * 2048 + (4 * wave) * 64 + 8 * gq;
#pragma unroll
    for (int jj = 0; jj < 4; ++jj)
#pragma unroll
        for (int k2 = 0; k2 < 2; ++k2)
#pragma unroll
            for (int nt = 0; nt < 4; ++nt) wf[jj][k2][nt] = *(const bf16x8*)(wp + (size_t)(16 * nt) * 2048 + jj * 64 + 32 * k2);
}
DI void cmp_mfma(const bf16x8 (&wf)[4][2][4], const f32x4 (&av)[4][2][2], f32x4 (&acc)[4]) {
#pragma unroll
    for (int nt = 0; nt < 4; ++nt) acc[nt] = (f32x4){0.f, 0.f, 0.f, 0.f};
#pragma unroll
    for (int jj = 0; jj < 4; ++jj)
#pragma unroll
        for (int k2 = 0; k2 < 2; ++k2) { const bf16x8 af = pack8v(av[jj][k2][0], av[jj][k2][1]);
#pragma unroll
            for (int nt = 0; nt < 4; ++nt) acc[nt] = MFMA16(af, wf[jj][k2][nt], acc[nt]); }
}
DI void cmp_tail(const CmpArgs& A, LAS unsigned char* lds, int item, int tid, int lane, int wave, const f32x4 (&acc)[4]) {
    const bool sample = item < 2048; const int it2 = sample ? item : item - 2048;
    const int bb = it2 >> 4, g = (it2 >> 3) & 1, kv = (it2 >> 2) & 1, rt = it2 & 3;
    const int nl = lane & 15, gq = lane >> 4;
    LAS float* part = (LAS float*)(lds + C_PART); LAS float* hb = (LAS float*)(lds + C_HB);
    __syncthreads();
#pragma unroll
    for (int nt = 0; nt < 4; ++nt)
#pragma unroll
        for (int r = 0; r < 4; ++r) part[wave * 1024 + (4 * gq + r) * 64 + 16 * nt + nl] = acc[nt][r];
    __syncthreads();
    const int row = tid >> 5, e2 = (tid & 31) * 2;
    { float h0 = 0.f, h1 = 0.f;
#pragma unroll
      for (int w2 = 0; w2 < 8; ++w2) { const f32x2 v = *(const LAS f32x2*)(part + w2 * 1024 + row * 64 + e2); h0 += v.x; h1 += v.y; }
      hb[row * 64 + e2] = gelu_tanh(h0); hb[row * 64 + e2 + 1] = gelu_tanh(h1); }
    __syncthreads();
    const LAS float* w2 = (const LAS float*)(lds + C_W2) + kv * 4096;
    float o0 = 0.f, o1 = 0.f;
#pragma unroll 16
    for (int e = 0; e < 64; ++e) { const float hv = hb[row * 64 + e]; const f32x2 w = *(const LAS f32x2*)(w2 + e * 64 + e2); o0 += hv * w.x; o1 += hv * w.y; }
    if (kv == 0) { float ss = o0 * o0 + o1 * o1;
        ss = x16_sum(row16_sum(ss));
        const LAS float* kgl = (const LAS float*)(lds + C_W2) + 8192;
        const float rs = 1.f / sqrtf(ss * (1.f / 64.f) + EPS); o0 *= rs * kgl[e2]; o1 *= rs * kgl[e2 + 1]; }
    const int nn = 16 * rt + row;
    if (sample) { float* dst = (kv ? A.CVS : A.CKS) + ((size_t)(bb * 2 + g) * 64 + nn) * 64 + e2; *(f32x2*)dst = (f32x2){o0, o1}; }
    else { bf16_t* dst = (kv ? A.CVP : A.CKP) + ((size_t)(bb * 2 + g) * 64 + nn) * 64 + e2; *(unsigned*)dst = pk2(o0, o1); }
}
DI int cmp_item_id(int kv, int q) {
    const int sample = q < 1024; const int r = sample ? q : q - 1024;
    const int it2 = ((r >> 3) << 4) | (((r >> 2) & 1) << 3) | (kv << 2) | (r & 3);
    return sample ? it2 : 2048 + it2;
}
DI void compress_phase(const CmpArgs& A, LAS unsigned char* lds, int w, int W, int q0, int q1, int tid, int lane, int wave) {
    __syncthreads();
    { LAS float* w2l = (LAS float*)(lds + C_W2);
      for (int e = tid; e < 4096; e += NTHREADS) { w2l[e] = A.w2k[e]; w2l[4096 + e] = A.w2v[e]; }
      if (tid < 64) w2l[8192 + tid] = A.kg0[tid]; }
    const int kv = w & 1, step = W >> 1;
    int q = q0 + (w >> 1);
    if (q >= q1 || step < 1) return;
    bf16x8 wf[4][2][4];
    cmp_wload(kv ? A.W1V : A.W1K, lane, wave, wf);
    f32x4 av[4][2][2]; const float* rp[4];
    int item = cmp_item_id(kv, q);
    cmp_rows(A, item, lane, wave, rp);
    cmp_load(rp, av);
    for (;;) {
        const int qn = q + step; const bool more = qn < q1; const int next = more ? cmp_item_id(kv, qn) : 0;
        if (more) cmp_rows(A, next, lane, wave, rp);
        f32x4 acc[4];
        cmp_mfma(wf, av, acc);
        asm volatile("" ::: "memory"); __builtin_amdgcn_sched_barrier(0);
        if (more) cmp_load(rp, av);
        asm volatile("" ::: "memory");
        cmp_tail(A, lds, item, tid, lane, wave, acc);
        if (!more) break;
        item = next; q = qn;
    }
}
constexpr int CMP_EARLY_Q = 159;
DI bool cmp_early(int G, int lo, int& rem, int& W) { const int nunits = (MPAD / 256) * (NIN / 256); rem = nunits % G; W = (G - rem) & ~1; return lo == 0 && rem > 0 && W >= 2 && (2 * CMP_EARLY_Q + W - 1) / W <= 3; }

struct HsArgs { const float *S0, *GL, *hgn; const bf16_t *HQ, *HI, *HGT; bf16_t* OHG; float* out; };
DI void hgrn_sample_unit(const HsArgs& A, LAS unsigned char* lds, int unit, int tid, int lane, int wave) {
    const int bs = unit >> 2, h = unit & 3; const size_t row = (size_t)MP + bs;
    const int vq = tid & 31, kg = tid >> 5;
    const float* S0 = A.S0 + (size_t)unit * 16384; float* S1 = A.out + OFF_HGS + (size_t)unit * 16384;
    const f32x4 vv = ld_bf4(A.HI + row * HGW + h * 128 + 4 * vq);
    f32x4 o = (f32x4){0.f, 0.f, 0.f, 0.f};
    f32x4 s[8];
#pragma unroll
    for (int i2 = 0; i2 < 8; ++i2) s[i2] = *(const f32x4*)(S0 + (size_t)(kg + 16 * i2) * 128 + 4 * vq);
#pragma unroll
    for (int i2 = 0; i2 < 8; ++i2) { const int k = kg + 16 * i2;
        const float f = __expf(A.GL[row * HGW + h * 128 + k]), qk = bf2f(A.HQ[row * HGW + h * 128 + k]);
        const f32x4 sn = s[i2] * f + vv * (1.f - f);
        *(f32x4*)(S1 + (size_t)k * 128 + 4 * vq) = sn; o += sn * qk; }
    LAS float* red = (LAS float*)lds; LAS float* ov = red + 16 * 128;
    __syncthreads();
    *(LAS f32x4*)(red + kg * 128 + 4 * vq) = o;
    __syncthreads();
    if (tid < 128) { float t = 0.f;
#pragma unroll
        for (int k2 = 0; k2 < 16; ++k2) t += red[k2 * 128 + tid];
        ov[tid] = t; }
    __syncthreads();
    if (wave == 0) { const float a = ov[lane], b2 = ov[lane + 64]; const float ss = wave_sum(a * a + b2 * b2); const float rs = 1.f / sqrtf(ss * (1.f / 128.f) + EPS);
        const size_t idx = row * HGW + h * 128;
        A.OHG[idx + lane] = (bf16_t)f2bf(a * rs * A.hgn[lane] * siluf_(bf2f(A.HGT[idx + lane])));
        A.OHG[idx + lane + 64] = (bf16_t)f2bf(b2 * rs * A.hgn[lane + 64] * siluf_(bf2f(A.HGT[idx + lane + 64]))); }
}

constexpr int D_SC = 0;
constexpr int D_LUT = D_SC + 4 * 1024 * 4;
constexpr int D_RED = D_LUT + 4 * 132 * 4;
constexpr int D_MISC = D_RED + 32 * 256 * 4;
constexpr int D_OUT = D_MISC + 256;
struct DecArgs { const bf16_t* Q; const float *GATES, *rel_table, *cache, *skw, *CKS, *CVS; const int* page_table; float* out; bf16_t* ONSA; };

#define DEC_BLOAD(dst, k0v, n, RS, OFF) do { _Pragma("unroll") for (int u_ = 0; u_ < 8; ++u_) { const int kk = (k0v) + 32 * u_ + ks; \
        if (kk < (n)) dst[u_] = __builtin_bit_cast(f32x4, __builtin_amdgcn_raw_buffer_load_b128(RS, (unsigned)(OFF) + 16u * l16, 0, 0)); else dst[u_] = (f32x4){0.f, 0.f, 0.f, 0.f}; } } while (0)
#define DEC_SCORE_ROW(kvu_, kk, live, DIST, COPYK) do { \
        float d_[4]; _Pragma("unroll") for (int r_ = 0; r_ < 4; ++r_) { const f32x4 p_ = kvu_ * qv[r_]; d_[r_] = (p_[0] + p_[1]) + (p_[2] + p_[3]); } \
        _Pragma("unroll") for (int r_ = 0; r_ < 4; ++r_) d_[r_] = row16_sum(d_[r_]); \
        if (live) { COPYK; if (l16 < 4) { const int dd_ = (DIST); SC[l16 * 1024 + kk] = d_[l16 == 0 ? 0 : (l16 == 1 ? 1 : (l16 == 2 ? 2 : 3))] + LUT[l16 * 132 + (dd_ > 128 ? 128 : dd_)]; } } } while (0)
#define DEC_KLOAD(dst, k0v, n, RS, OFF) do { _Pragma("unroll") for (int t_ = 0; t_ < 2; ++t_) { const int kb_t_ = (k0v) + 32 * wave + 16 * t_; const int kk = kb_t_ + l16; \
        if (kb_t_ < (n)) { const unsigned o_ = (unsigned)(OFF) + 16u * q4; _Pragma("unroll") for (int j_ = 0; j_ < 4; ++j_) dst[4 * t_ + j_] = __builtin_bit_cast(f32x4, __builtin_amdgcn_raw_buffer_load_b128(RS, o_ + 64u * j_, 0, 0)); } \
        else { _Pragma("unroll") for (int j_ = 0; j_ < 4; ++j_) dst[4 * t_ + j_] = (f32x4){0.f, 0.f, 0.f, 0.f}; } } } while (0)
#define DEC_KSCORE(src, k0v, n, DIST, COPYK) do { _Pragma("unroll") for (int t_ = 0; t_ < 2; ++t_) { const int kb_t_ = (k0v) + 32 * wave + 16 * t_; const int kk = kb_t_ + l16; \
        if (kb_t_ < (n)) { const f32x4 k0_v = src[4 * t_], k1_v = src[4 * t_ + 1], k2_v = src[4 * t_ + 2], k3_v = src[4 * t_ + 3]; \
            f32x4 sc_ = MFMA16(qa[0], pack8v(k0_v, k1_v), ((f32x4){0.f, 0.f, 0.f, 0.f})); sc_ = MFMA16(qa[1], pack8v(k2_v, k3_v), sc_); \
            COPYK; \
            if (lane < 16) { const int dd_ = (DIST); const int di_ = dd_ > 128 ? 128 : dd_; \
                _Pragma("unroll") for (int r_ = 0; r_ < 4; ++r_) SC[r_ * 1024 + kk] = sc_[r_] + LUT[r_ * 132 + di_]; } } } } while (0)
#define DEC_SCORE_PASS(n, RS, OFF, DIST, COPYK, PRELOADED) do { if (!(PRELOADED)) DEC_KLOAD(ka_, 0, n, RS, OFF); \
    _Pragma("nounroll") for (int k0_ = 0; ; k0_ += 512) { \
        if (k0_ + 256 < (n)) DEC_KLOAD(kb_, k0_ + 256, n, RS, OFF); \
        DEC_KSCORE(ka_, k0_, n, DIST, COPYK); \
        if (k0_ + 256 >= (n)) break; \
        if (k0_ + 512 < (n)) DEC_KLOAD(ka_, k0_ + 512, n, RS, OFF); \
        DEC_KSCORE(kb_, k0_ + 256, n, DIST, COPYK); \
        if (k0_ + 512 >= (n)) break; } } while (0)
#define DEC_SCORE_ONE(kidx, PTR, DISTV) do { const f32x4 kone_ = (ks == 0) ? *(const f32x4*)((PTR) + 4 * l16) : (f32x4){0.f, 0.f, 0.f, 0.f}; const int kk = (kidx); \
        DEC_SCORE_ROW(kone_, kk, ks == 0, DISTV, (void)0); } while (0)
#define DEC_SOFTMAX(nkeys) do { __syncthreads(); if (wave < 4) { float m_ = -INFINITY; for (int kk = lane; kk < (nkeys); kk += 64) m_ = fmaxf(m_, SC[wave * 1024 + kk]); \
        m_ = wave_max(m_); float s_ = 0.f; \
        for (int kk = lane; kk < (nkeys); kk += 64) { const float e_ = ex2(SC[wave * 1024 + kk] - m_); SC[wave * 1024 + kk] = e_; s_ += e_; } \
        s_ = wave_sum(s_); if (lane == 0) MISCF[wave] = s_; } __syncthreads(); } while (0)
#define DEC_PV_BODY(src, k0v, n, COPYV) do { _Pragma("unroll") for (int u_ = 0; u_ < 8; ++u_) { const int kk = (k0v) + 32 * u_ + ks; const f32x4 vvu_ = src[u_]; \
        if (kk < (n)) { COPYV; _Pragma("unroll") for (int r_ = 0; r_ < 4; ++r_) oa_[r_] += vvu_ * SC[r_ * 1024 + kk]; } } } while (0)
#define DEC_PV_PASS(n, ntot, RS, OFF, COPYV, GATE, MIDDLE, TAILHOOK, HAS1, PTR1) do { f32x4 oa_[4]; _Pragma("unroll") for (int r_ = 0; r_ < 4; ++r_) oa_[r_] = (f32x4){0.f, 0.f, 0.f, 0.f}; \
    { f32x4 va_[8], vb_[8]; DEC_BLOAD(va_, 0, n, RS, OFF);        \
    f32x4 vone_ = (f32x4){0.f, 0.f, 0.f, 0.f}; if ((HAS1) && ks == 0) vone_ = *(const f32x4*)((PTR1) + 4 * l16); \
    DEC_SOFTMAX(ntot); MIDDLE; \
    if ((HAS1) && ks == 0) { _Pragma("unroll") for (int r_ = 0; r_ < 4; ++r_) oa_[r_] += vone_ * SC[r_ * 1024 + (n)]; } \
    _Pragma("nounroll") for (int k0_ = 0; ; k0_ += 512) { \
        if (k0_ + 256 < (n)) DEC_BLOAD(vb_, k0_ + 256, n, RS, OFF); \
        DEC_PV_BODY(va_, k0_, n, COPYV); \
        if (k0_ + 256 >= (n)) break; \
        if (k0_ + 512 < (n)) DEC_BLOAD(va_, k0_ + 512, n, RS, OFF); \
        DEC_PV_BODY(vb_, k0_ + 256, n, COPYV); \
        if (k0_ + 512 >= (n)) break; } } \
    _Pragma("unroll") for (int r_ = 0; r_ < 4; ++r_) *(LAS f32x4*)(RED + (ks * 4 + r_) * 64 + 4 * l16) = oa_[r_]; \
    __syncthreads(); \
    TAILHOOK;        \
    if (tid < 256) { const int r_ = tid >> 6, d_ = tid & 63; float t_ = 0.f; _Pragma("unroll 8") for (int s_ = 0; s_ < 32; ++s_) t_ += RED[(s_ * 4 + r_) * 64 + d_]; \
        const float L_ = MISCF[r_]; OUTB[tid] += (L_ > 0.f ? (GATE) / L_ : 0.f) * t_; } \
    __syncthreads(); } while (0)

DI void decode_unit(const DecArgs& A, LAS unsigned char* lds, int unit, int tid, int lane, int wave) {
    const int bs = unit >> 1, g = unit & 1; const size_t row = (size_t)MP + bs;
    asm volatile("" : "+v"(tid));
    const int l16 = tid & 15, ks = tid >> 4, q4 = lane >> 4;
    LAS float* SC = (LAS float*)(lds + D_SC); LAS float* LUT = (LAS float*)(lds + D_LUT); LAS float* RED = (LAS float*)(lds + D_RED);
    LAS float* MISCF = (LAS float*)(lds + D_MISC); LAS int* SELB = (LAS int*)(lds + D_MISC + 64); LAS float* OUTB = (LAS float*)(lds + D_OUT);
    __syncthreads();
    build_lut(LUT, A.rel_table, g, tid);
    f32x4 ka_[8], kb_[8];
    f32x4 qv[4];
#pragma unroll
    for (int r = 0; r < 4; ++r) qv[r] = ld_bf4(A.Q + row * NSAW + (4 * g + r) * 64 + 4 * l16);
    bf16x8 qa[2];
#pragma unroll
    for (int s2 = 0; s2 < 2; ++s2) { const bf16_t* qp = A.Q + row * NSAW + (4 * g + (l16 & 3)) * 64 + 32 * s2 + 4 * q4;
        const s16x4 z4 = {0, 0, 0, 0}; qa[s2] = (l16 < 4) ? cat44(*(const s16x4*)qp, *(const s16x4*)(qp + 16)) : cat44(z4, z4); }
    float gate0 = 0.f, gate1 = 0.f, gate2 = 0.f;
    if (tid < 256) { const int r = tid >> 6; const float* gp = A.GATES + row * 24 + (4 * g + r) * 3;
        gate0 = gp[0]; gate1 = gp[1]; gate2 = gp[2];
        OUTB[tid] = 0.f; }
    if (tid < NPAGES) ((LAS int*)(lds + D_MISC + 128))[tid] = A.page_table[bs * NPAGES + tid];
    __syncthreads();
    const auto rs_ck = __builtin_amdgcn_make_buffer_rsrc((void*)A.CKS, 0, BS * 2 * 4096 * 4, 0x00020000);
    const auto rs_cv = __builtin_amdgcn_make_buffer_rsrc((void*)A.CVS, 0, BS * 2 * 4096 * 4, 0x00020000);
    const auto rs_cache = __builtin_amdgcn_make_buffer_rsrc((void*)A.cache, 0, 2560u * PAGE * 512u * 4u, 0x00020000);
    const auto rs_win = __builtin_amdgcn_make_buffer_rsrc((void*)A.skw, 0, (unsigned)BS * WIN * 256 * 4, 0x00020000);
    const LAS int* pt = (const LAS int*)(lds + D_MISC + 128);
    const float* snewk = A.out + OFF_KV + (row * 4 + 2) * 128 + g * 64; const float* snewv = A.out + OFF_KV + (row * 4 + 3) * 128 + g * 64;
    float* wo = A.out + OFF_WINS + (size_t)bs * WIN * 256 + g * 64;
    const float* wnewk = wo + (size_t)(WIN - 1) * 256; const float* wnewv = wnewk + 128;
    const unsigned ckoff = (unsigned)(bs * 2 + g) * 4096u * 4u, wkoff = ((unsigned)bs * WIN * 256u + g * 64u) * 4u;
#define SEL_T(kk) (64 * SELB[(kk) >> 6] + ((kk) & 63))
#define SEL_OFF(kk, slot) ((((unsigned)pt[SEL_T(kk) >> 7] * PAGE + (SEL_T(kk) & 127)) * 512u + (slot) * 128u + g * 64u) * 4u)
    DEC_SCORE_PASS(64, rs_ck, ckoff + kk * 256u, PAST - (32 * kk + 31), (void)0, 0);
#define DEC_CMP_MIDDLE \
      if (wave == 0) { float imp = 0.f; \
          if (lane < 32) { _Pragma("unroll") for (int r = 0; r < 4; ++r) imp += (SC[r * 1024 + 2 * lane] + SC[r * 1024 + 2 * lane + 1]) / MISCF[r]; } \
          const bool cand = lane >= 1 && lane <= 30; int cnt = 0; \
          for (int j2 = 1; j2 <= 30; ++j2) { const float o2 = __shfl(imp, j2); cnt += (cand && (o2 > imp || (o2 == imp && j2 < lane))) ? 1 : 0; } \
          const bool sel = (lane == 0) || (lane == 31) || (cand && cnt < 13); \
          const unsigned long long bal = __ballot(sel); \
          if (sel) SELB[__builtin_popcountll(bal & ((1ull << lane) - 1ull))] = lane; }
    DEC_PV_PASS(64, 64, rs_cv, ckoff + kk * 256u, (void)0, gate0, DEC_CMP_MIDDLE, DEC_KLOAD(ka_, 0, 960, rs_cache, SEL_OFF(kk, 2)), 0, snewv);
#undef DEC_CMP_MIDDLE
    DEC_SCORE_PASS(960, rs_cache, SEL_OFF(kk, 2), PAST - SEL_T(kk), (void)0, 1);
    DEC_SCORE_ONE(960, snewk, 0);
    DEC_PV_PASS(960, 961, rs_cache, SEL_OFF(kk, 3), (void)0, gate1, (void)0, DEC_KLOAD(ka_, 0, 512, rs_win, wkoff + kk * 1024u), 1, snewv);
    DEC_SCORE_PASS(512, rs_win, wkoff + kk * 1024u, (WIN - (kk)), { if (kk >= 1) { float* wr_ = wo + (size_t)(kk - 1) * 256 + 4 * q4; *(f32x4*)wr_ = k0_v; *(f32x4*)(wr_ + 16) = k1_v; *(f32x4*)(wr_ + 32) = k2_v; *(f32x4*)(wr_ + 48) = k3_v; } }, 1);
    DEC_SCORE_ONE(512, wnewk, 0);
    DEC_PV_PASS(512, 513, rs_win, wkoff + 512u + kk * 1024u, { if (kk >= 1) *(f32x4*)(wo + (size_t)(kk - 1) * 256 + 128 + 4 * l16) = vvu_; }, gate2, (void)0, (void)0, 1, wnewv);
#undef SEL_T
#undef SEL_OFF
    if (tid < 256) A.ONSA[row * NSAW + (4 * g) * 64 + tid] = (bf16_t)f2bf(OUTB[tid]);
}

DI void phase_2a(const KParams& P, LAS unsigned char* lds, int vcu, int G, int tid, int lane, int wave) {
    unsigned char* ws = P.ws;
    { CmpArgs A{P.in[2], P.out + OFF_KV, P.page_table, (const bf16_t*)(ws + WS_W1K), (const bf16_t*)(ws + WS_W1V), P.in[14], P.in[16], P.in[12],
                (float*)(ws + WS_CKS), (float*)(ws + WS_CVS), (bf16_t*)(ws + WS_CKP), (bf16_t*)(ws + WS_CVP)};
#ifndef NO_CMP
      int rem_, W_; const bool early_ = cmp_early(G, P.ph_lo, rem_, W_);
      REP_LOOP(16) compress_phase(A, lds, vcu, G, early_ ? CMP_EARLY_Q : 0, 1024 + 64, tid, lane, wave);
#endif
    }
    __syncthreads();
    { HgArgs A{(const bf16_t*)(ws + WS_HQ), (const bf16_t*)(ws + WS_HI), (const bf16_t*)(ws + WS_HGT), (const float*)(ws + WS_GL), P.in[17],
               (float*)(ws + WS_SLOC), (float*)(ws + WS_GD), (bf16_t*)(ws + WS_OHG), P.out};
#ifndef NO_HG1
      REP_LOOP(17) for (int u = vcu; u < 256; u += G) hgrn_unit<false>(A, lds, u, tid, lane, wave);
#endif
    }
    __syncthreads();
    { HsArgs A{P.in[5], (const float*)(ws + WS_GL), P.in[17], (const bf16_t*)(ws + WS_HQ), (const bf16_t*)(ws + WS_HI), (const bf16_t*)(ws + WS_HGT), (bf16_t*)(ws + WS_OHG), P.out};
#ifndef NO_HGS
      REP_LOOP(18) for (int u = vcu; u < 512; u += G) hgrn_sample_unit(A, lds, u, tid, lane, wave);
#endif
    }
}
DI void phase_2b(const KParams& P, LAS unsigned char* lds, int vcu, int G, int tid0, int lane0, int wave0) {
    unsigned char* ws = P.ws;
#define IDS2() int tid = threadIdx.x; asm volatile("" : "+v"(tid)); const int lane = tid & 63, wave = __builtin_amdgcn_readfirstlane(tid >> 6)
    { IDS2(); AttnArgs A{(const bf16_t*)(ws + WS_Q), (const bf16_t*)(ws + WS_KVB), (const bf16_t*)(ws + WS_CKP), (const bf16_t*)(ws + WS_CVP), (const float*)(ws + WS_GATES), P.in[7], (bf16_t*)(ws + WS_ONSA)};
#ifndef NO_ATT
      __syncthreads();
      if (wave == 0) { int l2 = lane; asm volatile("" : "+v"(l2)); const float cb_ = score_bound(P.in[11], P.in[12], P.in[7], l2); if (l2 == 0) *(LAS float*)(lds + A_CSH) = cb_; }
      REP_LOOP(19) for (int pu = vcu; pu < 256; pu += G) { const int b = pu >> 5, g = (pu >> 4) & 1, i0 = pu & 15;
          __syncthreads();
          build_lut((LAS float*)(lds + A_LUT), A.rel_table, g, tid, *(const LAS float*)(lds + A_CSH));
          __syncthreads();
          attn_prompt_unit(A, lds, b, g, 31 - i0, tid, lane, wave);
          attn_prompt_unit(A, lds, b, g, i0, tid, lane, wave); }
#endif
    }
    __syncthreads();
    { IDS2(); HgArgs A{(const bf16_t*)(ws + WS_HQ), (const bf16_t*)(ws + WS_HI), (const bf16_t*)(ws + WS_HGT), (const float*)(ws + WS_GL), P.in[17],
               (float*)(ws + WS_SLOC), (float*)(ws + WS_GD), (bf16_t*)(ws + WS_OHG), P.out};
#ifndef NO_HG3
      REP_LOOP(20) for (int u = vcu; u < 256; u += G) hgrn_unit<true>(A, lds, u, tid, lane, wave);
#endif
    }
    __syncthreads();
    { IDS2(); DecArgs A{(const bf16_t*)(ws + WS_Q), (const float*)(ws + WS_GATES), P.in[7], P.in[2], P.in[4], (const float*)(ws + WS_CKS), (const float*)(ws + WS_CVS), P.page_table, P.out, (bf16_t*)(ws + WS_ONSA)};
#ifndef NO_DEC
      REP_LOOP(21) for (int u = vcu; u < 256; u += G) decode_unit(A, lds, u, tid, lane, wave);
#endif
    }
}

#ifndef MK_SINGLE
#define MK_SINGLE 1
#endif
constexpr int N_PHASES = 9;
__global__ void __launch_bounds__(NTHREADS, 2) hybrid_fwd(KParams P) {
    extern __shared__ __attribute__((aligned(16))) unsigned char lds_raw[];
    LAS unsigned char* lds = (LAS unsigned char*)lds_raw;
    volatile LAS unsigned* MISC = (volatile LAS unsigned*)(lds + MISC_OFF);
    const int G = gridDim.x, bx = blockIdx.x;
    const int vcu = (G % 8 == 0) ? (bx % 8) * (G / 8) + bx / 8 : bx;
    unsigned char* ws = P.ws;
    if (threadIdx.x < 64) MISC[threadIdx.x] = 0u;
    __syncthreads();
    XcdBarrier bar; bar.bar = (unsigned*)(ws + WS_CTL) + CW_BAR; bar.x = 0; bar.st = nullptr;
    const int lo = P.ph_lo, hi = P.ph_hi;
    if (hi - lo > 1) bar = xcd_barrier_post((unsigned*)(ws + WS_CTL) + CW_BAR, MISC + 8);
#define IN(k) (lo <= (k) && (k) < hi)
#define SEAM(k) do { if (IN(k) && IN((k) + 1)) xcd_barrier(bar); } while (0)
    float* out = P.out;
#define WSP(T_, off) ((T_*)(ws + (off)))
#define FRESH_IDS() int tid = threadIdx.x; asm volatile("" : "+v"(tid)); const int lane = tid & 63, wave = __builtin_amdgcn_readfirstlane(tid >> 6); (void)lane; (void)wave
    if (IN(0)) REP_LOOP(0) { FRESH_IDS();
        P0Args a{P.in[10], P.in[18], P.in[19], P.in[20], P.in[22], P.in[23], P.in[26], P.in[13], P.in[15], P.in[0], P.in[1], P.in[9], P.in[21],
                 WSP(bf16_t, WS_WIN), WSP(bf16_t, WS_WA), WSP(bf16_t, WS_WB), WSP(bf16_t, WS_WO), WSP(bf16_t, WS_WG), WSP(bf16_t, WS_WU), WSP(bf16_t, WS_WD), WSP(bf16_t, WS_W1K), WSP(bf16_t, WS_W1V), WSP(bf16_t, WS_XN)};
        p0_prologue(a, lds, vcu * NWAVES + wave, G * NWAVES, lane, wave);
    }
    SEAM(0);
    if (IN(1)) REP_LOOP(1) {
        pg8::Gemm g{WSP(bf16_t, WS_XN), WSP(bf16_t, WS_WIN), MPAD, NIN, DM}; pg8::StaticOrder S; S.init(MPAD, NIN, G, bx);
        EpiInProj E{WSP(bf16_t, WS_Q), WSP(bf16_t, WS_KVB), WSP(bf16_t, WS_HQ), WSP(bf16_t, WS_HI), WSP(bf16_t, WS_HGT), WSP(bf16_t, WS_MG), WSP(float, WS_GL), WSP(float, WS_GATES), out, P.in[11], P.in[12], P.in[8]};
#ifndef NO_GEMM
        pg8::gemm_phase<EpiInProj, pg8::StaticOrder, true, true>(lds, g, S, E);
#endif
        { int rem, W;
          if (cmp_early(G, lo, rem, W) && bx >= rem && bx - rem < W) { FRESH_IDS();
              CmpArgs A{P.in[2], P.out + OFF_KV, P.page_table, WSP(bf16_t, WS_W1K), WSP(bf16_t, WS_W1V), P.in[14], P.in[16], P.in[12],
                        WSP(float, WS_CKS), WSP(float, WS_CVS), WSP(bf16_t, WS_CKP), WSP(bf16_t, WS_CVP)};
              compress_phase(A, lds, bx - rem, W, 0, CMP_EARLY_Q, tid, lane, wave); } }
    }
    SEAM(1);
    if (IN(2)) { FRESH_IDS(); phase_2a(P, lds, vcu, G, tid, lane, wave); }
    SEAM(2);
    if (IN(3)) { FRESH_IDS(); phase_2b(P, lds, vcu, G, tid, lane, wave); }
    SEAM(3);
    if (IN(4)) REP_LOOP(4) {
        { static_assert(HGW == NSAW, "the two operand pairs share one row stride");
          pg8::Gemm2 g{WSP(bf16_t, WS_OHG), WSP(bf16_t, WS_WB), WSP(bf16_t, WS_ONSA), WSP(bf16_t, WS_WA), MP, DM, HGW}; pg8::StaticOrder S; S.init(MP, DM, G, bx);
          HookMerge H{WSP(bf16_t, WS_MG)}; EpiMergeF E{WSP(bf16_t, WS_MG), WSP(bf16_t, WS_MB)};
#ifndef NO_GEMM
          pg8::gemm_phase_dual<EpiMergeF, HookMerge, pg8::StaticOrder, true, true>(lds, g, S, H, E);
#endif
        }
        FRESH_IDS();
        skinny_gemm<2>(WSP(bf16_t, WS_OHG) + (size_t)MP * HGW, WSP(bf16_t, WS_WB), HGW, WSP(bf16_t, WS_ONSA) + (size_t)MP * NSAW, WSP(bf16_t, WS_WA), NSAW, lds, bx, G, lane, wave,
            SkMerge{WSP(bf16_t, WS_MG), WSP(bf16_t, WS_MB)});
    }
    SEAM(4);
    if (IN(5)) REP_LOOP(5) {
        pg8::Gemm g{WSP(bf16_t, WS_MB), WSP(bf16_t, WS_WO), MP, DM, DM}; pg8::StaticOrder S; S.init(MP, DM, G, bx);
        EpiWo E{P.in[0], P.in[1], WSP(bf16_t, WS_T + 33 * MiB), WSP(float, WS_SSQ)};
#ifndef NO_GEMM
        pg8::gemm_phase<EpiWo, pg8::StaticOrder, true, true>(lds, g, S, E);
#endif
        FRESH_IDS();
        skinny_gemm<1>(WSP(bf16_t, WS_MB) + (size_t)MP * DM, WSP(bf16_t, WS_WO), DM, nullptr, nullptr, 0, lds, bx, G, lane, wave,
            SkWo{P.in[1], WSP(bf16_t, WS_T + 33 * MiB), WSP(float, WS_SSQ) + SSQS_OFF});
    }
    SEAM(5);
    if (IN(6)) REP_LOOP(6) { FRESH_IDS();
        for (int r_ = bx * NTHREADS + tid; r_ < MROWS; r_ += G * NTHREADS) WSP(float, WS_SSQ)[RSTD_OFF + r_] = row_rstd(WSP(float, WS_SSQ), r_);
        halo_gemm(WSP(bf16_t, WS_T + 33 * MiB), WSP(bf16_t, WS_WG), WSP(float, WS_SSQ), WSP(float, WS_G), lds, bx, G, lane, wave);
    }
    SEAM(6);
    if (IN(7)) REP_LOOP(7) {
        pg8::Gemm g{WSP(bf16_t, WS_T + 33 * MiB), WSP(bf16_t, WS_WG), MPAD, 2 * DFF, DM}; pg8::StaticOrder S; S.init(MPAD, 2 * DFF, G, bx);
        EpiGU E{WSP(float, WS_SSQ), WSP(float, WS_G), WSP(bf16_t, WS_H), out, P.in[6], P.in[24], P.in[25], lds};
#ifndef NO_GEMM
        pg8::gemm_phase<EpiGU, pg8::StaticOrder, true, true>(lds, g, S, E);
#endif
    }
    SEAM(7);
    if (IN(8)) REP_LOOP(8) {
        pg8::Gemm g{WSP(bf16_t, WS_H), WSP(bf16_t, WS_WD), MP, DM, DFF}; pg8::StaticOrder S; S.init(MP, DM, G, bx);
        EpiDown E{WSP(bf16_t, WS_T + 33 * MiB), out + OFF_Y};
#ifndef NO_GEMM
        pg8::gemm_phase<EpiDown, pg8::StaticOrder, true, true>(lds, g, S, E);
#endif
        FRESH_IDS();
        skinny_gemm<1>(WSP(bf16_t, WS_H) + (size_t)MP * DFF, WSP(bf16_t, WS_WD), DFF, nullptr, nullptr, 0, lds, bx, G, lane, wave,
            SkDown{WSP(bf16_t, WS_T + 33 * MiB), out + OFF_Y});
    }
#ifdef MK_EXTRA_BARRIERS
    if (hi - lo > 1) for (int eb_ = 0; eb_ < MK_EXTRA_BARRIERS; ++eb_) xcd_barrier(bar);
#endif
#ifdef MK_EXTRA_PHASE
    if (IN(13)) { pg8::Gemm g{WSP(bf16_t, WS_XN), WSP(bf16_t, WS_WIN), MPAD, NIN, DM}; pg8::StaticOrder S; S.init(MPAD, NIN, G, bx); EpiNull E{WSP(float, WS_G) + 4000000};
        pg8::gemm_phase<EpiNull, pg8::StaticOrder, true, true>(lds, g, S, E); }
    if (IN(10)) { pg8::Gemm g{WSP(bf16_t, WS_OHG), WSP(bf16_t, WS_WB), MP, DM, HGW}; pg8::StaticOrder S; S.init(MP, DM, G, bx); EpiMergeB E{WSP(bf16_t, WS_MG), WSP(bf16_t, WS_T)};
        pg8::gemm_phase<EpiMergeB, pg8::StaticOrder, true, true>(lds, g, S, E); }
    if (IN(11)) { pg8::Gemm g{WSP(bf16_t, WS_ONSA), WSP(bf16_t, WS_WA), MP, DM, NSAW}; pg8::StaticOrder S; S.init(MP, DM, G, bx); EpiMergeA E{WSP(bf16_t, WS_MG), WSP(bf16_t, WS_T), WSP(bf16_t, WS_MB)};
        pg8::gemm_phase<EpiMergeA, pg8::StaticOrder, true, true>(lds, g, S, E); }
    if (IN(12)) { FRESH_IDS();
        skinny_gemm<2>(WSP(bf16_t, WS_OHG) + (size_t)MP * HGW, WSP(bf16_t, WS_WB), HGW, WSP(bf16_t, WS_ONSA) + (size_t)MP * NSAW, WSP(bf16_t, WS_WA), NSAW, lds, bx, G, lane, wave,
            SkMerge{WSP(bf16_t, WS_MG), WSP(bf16_t, WS_MB)}); }
#endif
#undef IN
#undef SEAM
}

extern "C" void kernel_launch(void* const* d_in, const int* in_sizes, int n_in, void* d_out, int out_size, void* d_ws, size_t ws_size, hipStream_t stream) {
    static int grid = 0;
    if (grid == 0) {
        if (n_in != 27 || (size_t)out_size != OUT_TOTAL || ws_size < WS_END) {
            fprintf(stderr, "kernel_launch: unexpected problem: n_in %d out %d ws %zu (need %zu)\n", n_in, out_size, ws_size, (size_t)WS_END); grid = -1; return; }
        int dev = 0, cus = 0, per_cu = 0;
        if (hipGetDevice(&dev) != hipSuccess || hipDeviceGetAttribute(&cus, hipDeviceAttributeMultiprocessorCount, dev) != hipSuccess) { grid = -1; return; }
        if (hipFuncSetAttribute((const void*)hybrid_fwd, hipFuncAttributeMaxDynamicSharedMemorySize, LDS_BYTES) != hipSuccess) { fprintf(stderr, "kernel_launch: hipFuncSetAttribute failed\n"); grid = -1; return; }
        if (hipOccupancyMaxActiveBlocksPerMultiprocessor(&per_cu, (const void*)hybrid_fwd, NTHREADS, LDS_BYTES) != hipSuccess || per_cu < 1) {
            fprintf(stderr, "kernel_launch: occupancy query reports %d workgroups per CU\n", per_cu); }
        (void)hipGetLastError();
        grid = cus;
    }
    if (grid < 0) return;
    (void)hipMemsetAsync((char*)d_ws + WS_CTL, 0, CTL_ZERO_BYTES, stream);
    KParams p{};
    for (int i = 0; i < 27; ++i) p.in[i] = (const float*)d_in[i];
    p.page_table = (const int*)d_in[3]; p.out = (float*)d_out; p.ws = (unsigned char*)d_ws;
#if MK_SINGLE
    p.ph_lo = 0; p.ph_hi = N_PHASES; p.rep = MK_REP;
    hipLaunchKernelGGL(hybrid_fwd, dim3(grid), dim3(NTHREADS), LDS_BYTES, stream, p);
#ifdef MK_EXTRA_PHASE
    p.ph_lo = MK_EXTRA_PHASE; p.ph_hi = MK_EXTRA_PHASE + 1;
    hipLaunchKernelGGL(hybrid_fwd, dim3(grid), dim3(NTHREADS), LDS_BYTES, stream, p);
#endif
#else
    for (int k = 0; k < N_PHASES; ++k) { p.ph_lo = k; p.ph_hi = k + 1; hipLaunchKernelGGL(hybrid_fwd, dim3(grid), dim3(NTHREADS), LDS_BYTES, stream, p); }
#endif
}
```
